# Optimizing an MI355X kernel written in HIP

```python
import math
import jax
import jax.numpy as jnp
from jax import lax
import numpy as np

D_MODEL = 1024
BATCH = 4
SEQ = 8192
DEPTH = 1

N_META = 16
CHUNK = 64
EPS = 1e-6
HG_HEADS = 4
HG_DIM = 128
HG_WIDTH = HG_HEADS * HG_DIM
GD_HEADS = 4
GD_DK = 128
GD_DV = 128
CONV_W = 4
N_GROUPS = 4
EXPERTS_PER_GROUP = 8
N_EXPERTS = N_GROUPS * EXPERTS_PER_GROUP
TOP_K_FINE = 2
D_FF_EXPERT = 512
MOE_BLOCK = 128
PROJ_SIZES = (HG_WIDTH, HG_WIDTH, HG_WIDTH, HG_WIDTH,
              GD_HEADS * GD_DK, GD_HEADS * GD_DK, GD_HEADS * GD_DV, GD_HEADS * GD_DV,
              GD_HEADS, GD_HEADS, D_MODEL, D_MODEL)
D_PROJ = sum(PROJ_SIZES)

kernel_name = 'hybrid_hgrn2_gdn_hmoe_block'


def rmsnorm(x, g):
    xf = x.astype(jnp.float32)
    y = xf * lax.rsqrt(jnp.mean(xf * xf, axis=-1, keepdims=True) + EPS) * g.astype(jnp.float32)
    return y.astype(x.dtype)


def head_rmsnorm(o, g):
    return o * lax.rsqrt(jnp.mean(o * o, axis=-1, keepdims=True) + EPS) * g.astype(jnp.float32)


def l2norm(t):
    return t * lax.rsqrt(jnp.sum(t * t, axis=-1, keepdims=True) + EPS)


def causal_depthwise_conv(x, w):
    return lax.conv_general_dilated(
        x, w[:, None, :].astype(x.dtype), window_strides=(1,), padding=[(CONV_W - 1, 0)],
        dimension_numbers=('NWC', 'WIO', 'NWC'), feature_group_count=x.shape[-1])


def run_chunked(step, state0, seqs):
    bsz, length = seqs[0].shape[:2]
    n_chunks = (length - N_META) // CHUNK
    state, out_meta = step(state0, tuple(s[:, :N_META] for s in seqs))
    real = tuple(jnp.moveaxis(s[:, N_META:].reshape(bsz, n_chunks, CHUNK, *s.shape[2:]), 1, 0) for s in seqs)
    _, out_real = lax.scan(step, state, real)
    out_real = jnp.moveaxis(out_real, 0, 1).reshape(bsz, n_chunks * CHUNK, *out_real.shape[3:])
    return jnp.concatenate([out_meta, out_real], axis=1)


def hgrn2_chunk(S, inp):
    q, k, v, logf = inp
    C = q.shape[1]
    b = jnp.cumsum(logf, axis=1)
    incl = jnp.tril(jnp.ones((C, C), dtype=bool))
    decay = jnp.exp(jnp.where(incl[None, :, :, None, None], b[:, :, None] - b[:, None, :], -jnp.inf))
    attn = jnp.einsum('bthk,bshk,btshk->bhts', q, k, decay)
    o = jnp.einsum('bthk,bhkv->bthv', q * jnp.exp(b), S) + jnp.einsum('bhts,bshv->bthv', attn, v)
    b_end = b[:, -1:]
    S_new = jnp.exp(b_end[:, 0])[..., None] * S + jnp.einsum('bshk,bshv->bhkv', k * jnp.exp(b_end - b), v)
    return S_new, o


def gdn_chunk(S, inp):
    q, k, v, beta, g = inp
    C = q.shape[1]
    q, k, v = (t.transpose(0, 2, 1, 3) for t in (q, k, v))
    beta = beta.transpose(0, 2, 1)
    G = jnp.cumsum(g, axis=1).transpose(0, 2, 1)
    incl = jnp.tril(jnp.ones((C, C), dtype=bool))
    strict = jnp.tril(jnp.ones((C, C), dtype=bool), -1)
    ratio = jnp.exp(jnp.where(incl, G[..., :, None] - G[..., None, :], -jnp.inf))
    L = jnp.where(strict, beta[..., :, None] * ratio * jnp.einsum('bhtk,bhsk->bhts', k, k), 0.0)
    rhs = jnp.concatenate([beta[..., None] * v, (beta * jnp.exp(G))[..., None] * k], axis=-1)
    sol = lax.linalg.triangular_solve(jnp.eye(C, dtype=L.dtype) + L, rhs,
                                      left_side=True, lower=True, unit_diagonal=True)
    u0, w = sol[..., :GD_DV], sol[..., GD_DV:]
    u = u0 - jnp.einsum('bhtk,bhkv->bhtv', w, S)
    attn = jnp.einsum('bhtk,bhsk->bhts', q, k) * ratio
    o = jnp.exp(G)[..., None] * jnp.einsum('bhtk,bhkv->bhtv', q, S) + jnp.einsum('bhts,bhsv->bhtv', attn, u)
    G_end = G[..., -1:]
    S_new = jnp.exp(G_end)[..., None] * S + jnp.einsum('bhsk,bhsv->bhkv', k * jnp.exp(G_end - G)[..., None], u)
    return S_new, o.transpose(0, 2, 1, 3)


def token_mixer(h, lb, w_in, conv_w, A_log, dt_bias, hg_norm_g, gd_norm_g, hg_up, gd_up, w_out):
    f32 = jnp.float32
    bsz, length, _ = h.shape
    idx = []
    acc = 0
    for s in PROJ_SIZES[:-1]:
        acc += s
        idx.append(acc)
    proj = h @ w_in.astype(h.dtype)
    hq, hf, hi, hg, gq, gk, gv, gz, gbeta, ga, pre_ga, pre_gb = jnp.split(proj, idx, axis=-1)

    def heads(t, n_h, d):
        return t.reshape(bsz, length, n_h, d)
    fgate = lb + (1.0 - lb) * jax.nn.sigmoid(hf.astype(f32))
    q_a = heads(jax.nn.silu(hq.astype(f32)), HG_HEADS, HG_DIM)
    k_a = heads(1.0 - fgate, HG_HEADS, HG_DIM)
    logf = heads(jnp.log(fgate), HG_HEADS, HG_DIM)
    v_a = heads(hi.astype(f32), HG_HEADS, HG_DIM)
    S0a = jnp.zeros((bsz, HG_HEADS, HG_DIM, HG_DIM), f32)
    o_a = run_chunked(hgrn2_chunk, S0a, (q_a, k_a, logf and v_a, logf) if False else (q_a, k_a, v_a, logf))
    o_a = head_rmsnorm(o_a, hg_norm_g) * jax.nn.silu(heads(hg.astype(f32), HG_HEADS, HG_DIM))
    o_a = o_a.reshape(bsz, length, HG_WIDTH).astype(h.dtype)

    qkv = jax.nn.silu(causal_depthwise_conv(jnp.concatenate([gq, gk, gv], axis=-1), conv_w)).astype(f32)
    cq, ck, cv = jnp.split(qkv, [GD_HEADS * GD_DK, 2 * GD_HEADS * GD_DK], axis=-1)
    q_b = l2norm(heads(cq, GD_HEADS, GD_DK)) * (GD_DK ** -0.5)
    k_b = l2norm(heads(ck, GD_HEADS, GD_DK))
    v_b = heads(cv, GD_HEADS, GD_DV)
    beta = jax.nn.sigmoid(gbeta.astype(f32))
    g = -jnp.exp(A_log.astype(f32)) * jax.nn.softplus(ga.astype(f32) + dt_bias.astype(f32))
    S0b = jnp.zeros((bsz, GD_HEADS, GD_DK, GD_DV), f32)
    o_b = run_chunked(gdn_chunk, S0b, (q_b, k_b, v_b, beta, g))
    o_b = head_rmsnorm(o_b, gd_norm_g) * jax.nn.silu(heads(gz.astype(f32), GD_HEADS, GD_DV))
    o_b = o_b.reshape(bsz, length, GD_HEADS * GD_DV).astype(h.dtype)

    merged = (jax.nn.sigmoid(pre_ga) * (o_a @ hg_up.astype(h.dtype))
              + jax.nn.sigmoid(pre_gb) * (o_b @ gd_up.astype(h.dtype)))
    return merged @ w_out.astype(h.dtype)


def hierarchical_moe(h, rg_w, rg_b, re_w, re_b, w_gate, w_up, w_down):
    bsz, length, d = h.shape
    T = bsz * length
    xf = h.reshape(T, d)
    g_logits = (xf @ rg_w.astype(h.dtype)).astype(jnp.float32) + rg_b.astype(jnp.float32)
    g_prob = jax.nn.softmax(g_logits, axis=-1)
    grp = jnp.argmax(g_logits, axis=-1)
    p_grp = jnp.take_along_axis(g_prob, grp[:, None], axis=-1)
    e_logits = ((xf @ re_w.astype(h.dtype)).astype(jnp.float32) + re_b.astype(jnp.float32))
    e_logits = e_logits.reshape(T, N_GROUPS, EXPERTS_PER_GROUP)
    sel = jnp.take_along_axis(e_logits, grp[:, None, None], axis=1)[:, 0]
    top_p, top_i = lax.top_k(jax.nn.softmax(sel, axis=-1), TOP_K_FINE)
    weights = p_grp * top_p / jnp.sum(top_p, axis=-1, keepdims=True)
    expert_ids = grp[:, None] * EXPERTS_PER_GROUP + top_i

    A = T * TOP_K_FINE
    e_flat = expert_ids.reshape(A).astype(jnp.int32)
    tok_flat = jnp.repeat(jnp.arange(T, dtype=jnp.int32), TOP_K_FINE)
    w_flat = weights.reshape(A)
    order = jnp.argsort(e_flat)
    e_s, tok_s, w_s = e_flat[order], tok_flat[order], w_flat[order]
    counts = jnp.bincount(e_flat, length=N_EXPERTS)
    start = jnp.cumsum(counts) - counts
    padded = ((counts + MOE_BLOCK - 1) // MOE_BLOCK) * MOE_BLOCK
    pend = jnp.cumsum(padded)
    pstart = pend - padded
    dest = pstart[e_s] + (jnp.arange(A, dtype=jnp.int32) - start[e_s])
    n_blocks = -(-A // MOE_BLOCK) + N_EXPERTS
    P = n_blocks * MOE_BLOCK
    row_tok = jnp.full((P,), T, dtype=jnp.int32).at[dest].set(tok_s)
    x_ext = jnp.concatenate([xf, jnp.zeros((1, d), xf.dtype)], axis=0)
    x_buf = x_ext[row_tok].reshape(n_blocks, MOE_BLOCK, d)
    blk_expert = jnp.clip(jnp.searchsorted(pend, jnp.arange(n_blocks) * MOE_BLOCK, side='right'), 0, N_EXPERTS - 1)

    def expert_block(args):
        xb, e = args
        a = xb @ w_gate[e].astype(xb.dtype)
        u = xb @ w_up[e].astype(xb.dtype)
        return (jax.nn.silu(a) * u) @ w_down[e].astype(xb.dtype)

    y_buf = lax.map(expert_block, (x_buf, blk_expert)).reshape(P, d)
    y_s = (y_buf[dest].astype(jnp.float32) * w_s[:, None]).astype(h.dtype)
    out = jnp.zeros((T, d), h.dtype).at[tok_s].add(y_s)
    return out.reshape(bsz, length, d)


def setup_inputs(seed: int = 0) -> dict:
    key = jax.random.key(seed)
    ks = jax.random.split(key, 24)
    f32 = jnp.float32
    nrm = lambda k, shape, scale: jax.random.normal(k, shape, f32) * scale
    dt = jnp.exp(jax.random.uniform(ks[7], (DEPTH, GD_HEADS), f32, math.log(1e-3), math.log(1e-1)))
    return {
        'x': nrm(ks[0], (BATCH, SEQ, D_MODEL), 1.0),
        'meta_tokens': nrm(ks[1], (N_META, D_MODEL), 1.0),
        'hg_lb_logits': nrm(ks[2], (DEPTH + 1, HG_WIDTH), 0.5),
        'norm_mix_g': 1.0 + nrm(ks[3], (DEPTH, D_MODEL), 0.01),
        'w_in': nrm(ks[4], (DEPTH, D_MODEL, D_PROJ), D_MODEL ** -0.5),
        'gd_conv_w': nrm(ks[5], (DEPTH, CONV_W, 2 * GD_HEADS * GD_DK + GD_HEADS * GD_DV), CONV_W ** -0.5),
        'gd_A_log': jnp.log(jax.random.uniform(ks[6], (DEPTH, GD_HEADS), f32, 1.0, 16.0)),
        'gd_dt_bias': dt + jnp.log(-jnp.expm1(-dt)),
        'hg_norm_g': 1.0 + nrm(ks[8], (DEPTH, HG_DIM), 0.01),
        'gd_norm_g': 1.0 + nrm(ks[9], (DEPTH, GD_DV), 0.01),
        'hg_up': nrm(ks[10], (DEPTH, HG_WIDTH, D_MODEL), HG_WIDTH ** -0.5),
        'gd_up': nrm(ks[11], (DEPTH, GD_HEADS * GD_DV, D_MODEL), (GD_HEADS * GD_DV) ** -0.5),
        'w_out': nrm(ks[12], (DEPTH, D_MODEL, D_MODEL), D_MODEL ** -0.5),
        'norm_ffn_g': 1.0 + nrm(ks[13], (DEPTH, D_MODEL), 0.01),
        'router_group_w': nrm(ks[14], (DEPTH, D_MODEL, N_GROUPS), D_MODEL ** -0.5),
        'router_group_b': nrm(ks[15], (DEPTH, N_GROUPS), 0.01),
        'router_expert_w': nrm(ks[16], (DEPTH, D_MODEL, N_EXPERTS), D_MODEL ** -0.5),
        'router_expert_b': nrm(ks[17], (DEPTH, N_EXPERTS), 0.01),
        'w_gate': nrm(ks[18], (DEPTH, N_EXPERTS, D_MODEL, D_FF_EXPERT), D_MODEL ** -0.5),
        'w_up': nrm(ks[19], (DEPTH, N_EXPERTS, D_MODEL, D_FF_EXPERT), D_MODEL ** -0.5),
        'w_down': nrm(ks[20], (DEPTH, N_EXPERTS, D_FF_EXPERT, D_MODEL), D_FF_EXPERT ** -0.5),
        'final_norm_g': 1.0 + nrm(ks[21], (D_MODEL,), 0.01),
    }


def reference(x, meta_tokens, hg_lb_logits, norm_mix_g, w_in, gd_conv_w, gd_A_log, gd_dt_bias,
              hg_norm_g, gd_norm_g, hg_up, gd_up, w_out, norm_ffn_g, router_group_w, router_group_b,
              router_expert_w, router_expert_b, w_gate, w_up, w_down, final_norm_g):
    bsz = x.shape[0]
    meta = jnp.broadcast_to(meta_tokens[None].astype(x.dtype), (bsz, N_META, x.shape[-1]))
    h = jnp.concatenate([meta, x], axis=1)
    lb_table = jnp.cumsum(jax.nn.softmax(hg_lb_logits.astype(jnp.float32), axis=0), axis=0)
    for l in range(DEPTH):
        h = h + token_mixer(rmsnorm(h, norm_mix_g[l]), lb_table[l], w_in[l], gd_conv_w[l], gd_A_log[l],
                            gd_dt_bias[l], hg_norm_g[l], gd_norm_g[l], hg_up[l], gd_up[l], w_out[l])
        h = h + hierarchical_moe(rmsnorm(h, norm_ffn_g[l]), router_group_w[l], router_group_b[l],
                                 router_expert_w[l], router_expert_b[l], w_gate[l], w_up[l], w_down[l])
    h = rmsnorm(h, final_norm_g)
    return h[:, N_META:]
```

```cpp
#include <hip/hip_runtime.h>
#include <cstdio>
#include <cstdint>

#define LAS __attribute__((address_space(3)))
typedef unsigned short bf16_t;
typedef short bf16x8 __attribute__((ext_vector_type(8)));
typedef float f32x4 __attribute__((ext_vector_type(4)));
typedef unsigned u32x4 __attribute__((ext_vector_type(4)));
typedef unsigned u32x2 __attribute__((ext_vector_type(2)));

constexpr int D = 1024, NB = 4, SEQ = 8192, NMETA = 16, T = NB * SEQ;
constexpr int LP = 8256;
constexpr int TP = NB * LP;
constexpr int NPROJ = 6144;
constexpr int WIN_LD = 6152;
constexpr float EPS = 1e-6f;
constexpr int NEXP = 32, ECAP = 32768, HROWS = 73728;
constexpr int C_QA = 0, C_LF = 512, C_VA = 1024, C_HG = 1536, C_GQ = 2048, C_GK = 2560, C_GV = 3072, C_GZ = 3584, C_PA = 4096, C_PB = 5120;

constexpr size_t OFF_PROJ = 0;
constexpr size_t SZ_PROJ = (size_t)TP * NPROJ * 2;
constexpr size_t OFF_WIN = OFF_PROJ + SZ_PROJ;
constexpr size_t OFF_WHG = OFF_WIN + (size_t)NPROJ * D * 2;
constexpr size_t OFF_WGD = OFF_WHG + (size_t)1024 * 512 * 2;
constexpr size_t OFF_WOUT = OFF_WGD + (size_t)1024 * 512 * 2;
constexpr size_t OFF_GBF = OFF_WOUT + (size_t)1024 * 1024 * 2;
constexpr size_t OFF_MISC = OFF_GBF + (size_t)TP * 8 * 4;
constexpr size_t OFF_QKVN = OFF_MISC + 8192;
constexpr size_t WS_END = OFF_QKVN + (size_t)TP * 1536 * 2;
constexpr size_t OFF_TMP = OFF_QKVN;
constexpr size_t OFF_XN = 0;
constexpr size_t OFF_WE1 = OFF_XN + (size_t)T * D * 2;
constexpr size_t OFF_WE2 = OFF_WE1 + (size_t)NEXP * 1024 * 1024 * 2;
constexpr size_t OFF_H = OFF_WE2 + (size_t)NEXP * 1024 * 512 * 2;
constexpr size_t OFF_Y = OFF_H + (size_t)HROWS * 512 * 2;
constexpr size_t OFF_LIST = OFF_Y + (size_t)HROWS * 1024 * 2;
constexpr size_t OFF_ASG = OFF_LIST + (size_t)NEXP * ECAP * 4;
constexpr size_t MOE_END = OFF_ASG + (size_t)T * 2 * 12;
static_assert(MOE_END <= SZ_PROJ, "moe scratch must fit in the dead proj region");
constexpr size_t MISC_LBT = 0, MISC_CNT = 4096;

__device__ __forceinline__ unsigned cvt_pk_bf16(float lo, float hi) { unsigned r; asm volatile("v_cvt_pk_bf16_f32 %0, %1, %2" : "=v"(r) : "v"(lo), "v"(hi)); return r; }
__device__ __forceinline__ float bf_lo(unsigned w) { return __uint_as_float(w << 16); }
__device__ __forceinline__ float bf_hi(unsigned w) { return __uint_as_float(w & 0xffff0000u); }
__device__ __forceinline__ float bf2f(bf16_t b) { return __uint_as_float(((unsigned)b) << 16); }
__device__ __forceinline__ bf16_t f2bf(float f) { return (bf16_t)(cvt_pk_bf16(f, 0.f) & 0xffffu); }
__device__ __forceinline__ float sigmoidf_(float x) { return 1.0f / (1.0f + __expf(-x)); }
__device__ __forceinline__ float siluf_(float x) { return x / (1.0f + __expf(-x)); }
__device__ __forceinline__ float wave_sum(float v) {
#pragma unroll
    for (int o = 32; o >= 1; o >>= 1) v += __shfl_xor(v, o);
    return v;
}
__device__ __forceinline__ int prow_of(int r) { return (r >> 13) * LP + 64 + (r & 8191); }

namespace pg8 {
constexpr int BM = 256, BK = 64, HALF = 128, HTB = HALF * BK * 2, STAGE_BYTES = 8 * HTB, NXCD = 8, WGM = 8;
__host__ __device__ __forceinline__ int lds_byte(int r, int c) { const int st = (r >> 4) * 2 + (c >> 5), rr = r & 15, cc = c & 31, ob = rr * 64 + cc * 2; return st * 1024 + (ob ^ (((ob >> 9) & 1) << 5)); }
__host__ __device__ __forceinline__ void stage_rc(int b, int& R, int& C) { const int st = b / 1024, sb = b % 1024, swz = sb ^ (((sb >> 9) & 1) << 5); R = (st >> 1) * 16 + swz / 64; C = (st & 1) * 32 + (swz % 64) / 2; }
__host__ __device__ __forceinline__ int perm32(int rho) { const int n = rho >> 4, i = rho & 15; return 8 * (i >> 2) + 4 * n + (i & 3); }

struct Unit { int pm, pn, e, t; };

struct StaticOrder {
    int nM, nN, nwg, G, c;
    __device__ void init(int M, int N, int G_, int c_) { nM = M / BM; nN = N / BM; nwg = nM * nN; G = G_; c = c_; }
    __device__ bool next(int i, Unit& u) const {
        const long L = (long)i * G + c; if (L >= nwg) return false;
        int wgid = (int)L; { const int q = nwg / NXCD, r = nwg % NXCD, xcd = wgid % NXCD, off = wgid / NXCD; wgid = (xcd < r ? xcd * (q + 1) : r * (q + 1) + (xcd - r) * q) + off; }
        const int nig = WGM * nN, gid = wgid / nig, fm = gid * WGM, gsz = (nM - fm) < WGM ? (nM - fm) : WGM;
        u.pm = fm + ((wgid % nig) % gsz); u.pn = (wgid % nig) / gsz; u.e = 0; u.t = 0; return true;
    }
};

template <class Epi, class Sched>
__device__ __forceinline__ void gemm_phase(LAS unsigned char* lds, const Sched& S, const Epi& E) {
    const int tid = threadIdx.x, wid = __builtin_amdgcn_readfirstlane(tid >> 6), lane = tid & 63, wr = wid >> 2, wc = wid & 3, fr = lane & 15, fq = lane >> 4;
    const int K = S.K, nt = K / BK;
    int Rr[2]; unsigned ccA[2], voffB[2];
#pragma unroll
    for (int i = 0; i < 2; ++i) { int R, C; stage_rc(tid * 16 + i * 8192, R, C); const int Rb = Epi::PERM ? ((R & ~31) + perm32(R & 31)) : R;
        Rr[i] = R; ccA[i] = (unsigned)C * 2u; voffB[i] = (unsigned)(Rb * K + C) * 2u; }
    const size_t kstep = (size_t)(BK * 2);
    const size_t hstepB = (size_t)HALF * K * 2;
    const unsigned ldsw = (unsigned)wid * 1024u;
    const int aoff = lds_byte(wr * 64 + fr, fq * 8), boff = lds_byte(wc * 32 + fr, fq * 8);
#define PG8_SA(b, h) (((b) * 2 + (h)) * HTB)
#define PG8_SB(b, h) ((4 + (b) * 2 + (h)) * HTB)
#define PG8_STAGE(bufoff, gbase, voff) do { _Pragma("unroll") for (int _i = 0; _i < 2; ++_i) \
        __builtin_amdgcn_global_load_lds((const unsigned*)((const char*)(gbase) + (voff)[_i]), (LAS unsigned*)(lds + (bufoff) + ldsw + _i * 8192), 16, 0, 0); } while (0)
#define PG8_LDA(dst, b, h) do { _Pragma("unroll") for (int m = 0; m < 4; ++m) _Pragma("unroll") for (int k = 0; k < 2; ++k) dst[m][k] = *(const LAS bf16x8*)(lds + PG8_SA(b, h) + aoff + m * 2048 + k * 1024); } while (0)
#define PG8_LDB(dst, b, h) do { _Pragma("unroll") for (int n = 0; n < 2; ++n) _Pragma("unroll") for (int k = 0; k < 2; ++k) dst[n][k] = *(const LAS bf16x8*)(lds + PG8_SB(b, h) + boff + n * 2048 + k * 1024); } while (0)
#define PG8_MMA(ai, bj, At, Bt) do { __builtin_amdgcn_s_setprio(1); _Pragma("unroll") for (int m = 0; m < 4; ++m) _Pragma("unroll") for (int n = 0; n < 2; ++n) _Pragma("unroll") for (int k = 0; k < 2; ++k) \
        acc[ai][bj][m][n] = __builtin_amdgcn_mfma_f32_16x16x32_bf16(Bt[n][k], At[m][k], acc[ai][bj][m][n], 0, 0, 0); __builtin_amdgcn_s_setprio(0); } while (0)
#define PG8_WAIT_V(n) asm volatile("s_waitcnt vmcnt(" #n ")" ::: "memory")
#define PG8_WAIT_L(n) asm volatile("s_waitcnt lgkmcnt(" #n ")" ::: "memory")
#define PG8_BAR __builtin_amdgcn_s_barrier()
#define PG8_SCHED __builtin_amdgcn_sched_barrier(0)
    Unit cur, nxt; int ui = 0;
    if (!S.next(0, cur)) return;
    f32x4 acc[2][2][4][2];
#pragma unroll
    for (int a = 0; a < 2; ++a)
#pragma unroll
        for (int b = 0; b < 2; ++b)
#pragma unroll
            for (int m = 0; m < 4; ++m)
#pragma unroll
                for (int n = 0; n < 2; ++n) acc[a][b][m][n] = (f32x4){0.f, 0.f, 0.f, 0.f};
    bf16x8 At[4][2], B0[2][2], B1[2][2];
    unsigned vAc[2][2], vAn[2][2];
#pragma unroll
    for (int h = 0; h < 2; ++h)
#pragma unroll
        for (int i = 0; i < 2; ++i) vAc[h][i] = S.a_off(cur, Rr[i] + HALF * h) + ccA[i];
    const char* gA = S.a_base();
    const char* cB = S.b_ptr(cur);
    PG8_STAGE(PG8_SB(0, 0), cB, voffB); PG8_STAGE(PG8_SB(0, 1), cB + hstepB, voffB); PG8_STAGE(PG8_SA(0, 0), gA, vAc[0]); PG8_STAGE(PG8_SA(0, 1), gA, vAc[1]);
    if (wr == 1) PG8_BAR;
    PG8_WAIT_V(2); PG8_BAR;
    PG8_STAGE(PG8_SB(1, 0), cB + kstep, voffB); PG8_STAGE(PG8_SA(1, 0), gA + kstep, vAc[0]); PG8_STAGE(PG8_SB(1, 1), cB + hstepB + kstep, voffB);
    PG8_WAIT_V(6); PG8_BAR;
    for (;;) {
        const bool has_next = S.next(ui + 1, nxt);
        const char* nB = has_next ? S.b_ptr(nxt) : cB;
#pragma unroll
        for (int h = 0; h < 2; ++h)
#pragma unroll
            for (int i = 0; i < 2; ++i) vAn[h][i] = has_next ? (S.a_off(nxt, Rr[i] + HALF * h) + ccA[i]) : vAc[h][i];
        for (int t = 0; t < nt; t += 2) {
            const bool last = (t == nt - 2);
            const char* a1 = gA + (size_t)(t + 1) * kstep;
            const char* a2 = last ? gA : gA + (size_t)(t + 2) * kstep; const char* b2 = last ? nB : cB + (size_t)(t + 2) * kstep;
            const char* a3 = a2 + kstep; const char* b3 = b2 + kstep;
            unsigned w0[2], w1[2];
#pragma unroll
            for (int i = 0; i < 2; ++i) { w0[i] = last ? vAn[0][i] : vAc[0][i]; w1[i] = last ? vAn[1][i] : vAc[1][i]; }
            PG8_LDB(B0, 0, 0); PG8_LDB(B1, 0, 1); PG8_SCHED; PG8_LDA(At, 0, 0); PG8_STAGE(PG8_SA(1, 1), a1, vAc[1]);
            PG8_WAIT_V(8); PG8_WAIT_L(0); PG8_BAR; PG8_MMA(0, 0, At, B0); PG8_MMA(0, 1, At, B1); PG8_BAR; PG8_SCHED;
            PG8_LDA(At, 0, 1); PG8_STAGE(PG8_SB(0, 0), b2, voffB); PG8_STAGE(PG8_SB(0, 1), b2 + hstepB, voffB); PG8_STAGE(PG8_SA(0, 0), a2, w0);
            PG8_WAIT_V(8); PG8_WAIT_L(0); PG8_BAR; PG8_MMA(1, 0, At, B0); PG8_MMA(1, 1, At, B1); PG8_BAR; PG8_SCHED;
            PG8_LDB(B0, 1, 0); PG8_LDB(B1, 1, 1); PG8_SCHED; PG8_LDA(At, 1, 0); PG8_STAGE(PG8_SA(0, 1), a2, w1);
            PG8_WAIT_V(8); PG8_WAIT_L(0); PG8_BAR; PG8_MMA(0, 0, At, B0); PG8_MMA(0, 1, At, B1); PG8_BAR; PG8_SCHED;
            PG8_LDA(At, 1, 1); PG8_STAGE(PG8_SB(1, 0), b3, voffB); PG8_STAGE(PG8_SB(1, 1), b3 + hstepB, voffB); PG8_STAGE(PG8_SA(1, 0), a3, w0);
            PG8_WAIT_V(8); PG8_WAIT_L(0); PG8_BAR; PG8_MMA(1, 0, At, B0); PG8_MMA(1, 1, At, B1); PG8_BAR; PG8_SCHED;
        }
        if (wr == 0) PG8_BAR;
        E(acc, cur, wr, wc, fr, fq);
        if (!has_next) break;
#pragma unroll
        for (int a = 0; a < 2; ++a)
#pragma unroll
            for (int b = 0; b < 2; ++b)
#pragma unroll
                for (int m = 0; m < 4; ++m)
#pragma unroll
                    for (int n = 0; n < 2; ++n) acc[a][b][m][n] = (f32x4){0.f, 0.f, 0.f, 0.f};
        cur = nxt; cB = nB; ++ui;
#pragma unroll
        for (int h = 0; h < 2; ++h)
#pragma unroll
            for (int i = 0; i < 2; ++i) vAc[h][i] = vAn[h][i];
        if (wr == 1) PG8_BAR;
    }
    PG8_WAIT_V(0);
    PG8_BAR;
#undef PG8_SA
#undef PG8_SB
#undef PG8_STAGE
#undef PG8_LDA
#undef PG8_LDB
#undef PG8_MMA
#undef PG8_WAIT_V
#undef PG8_WAIT_L
#undef PG8_BAR
#undef PG8_SCHED
}
}

struct SchedDense {
    pg8::StaticOrder so; const char* A; unsigned lda2; int K; const char* Bt; int rowmap;
    __device__ bool next(int i, pg8::Unit& u) const { return so.next(i, u); }
    __device__ const char* a_base() const { return A; }
    __device__ unsigned a_off(const pg8::Unit& u, int r) const { const int row = u.pm * 256 + r; return (unsigned)(rowmap ? prow_of(row) : row) * lda2; }
    __device__ const char* b_ptr(const pg8::Unit& u) const { return Bt + (size_t)u.pn * 256 * K * 2; }
};
struct SchedMoe {
    const int* cnt; const int* list; LAS const int* pref;
    const char* A; unsigned lda2; int K; const char* Bt; size_t bstride; int gather; int G, c;
    __device__ bool next(int i, pg8::Unit& u) const {
        const int L = i * G + c; const int total = pref[NEXP] * 4; if (L >= total) return false;
        int e = 0;
#pragma unroll 1
        for (int j = 1; j < NEXP; ++j) if (L >= pref[j] * 4) e = j;
        const int q = L - pref[e] * 4, nte = pref[e + 1] - pref[e];
        u.e = e; u.pn = q / nte; u.t = q % nte; u.pm = pref[e] + u.t; return true;
    }
    __device__ const char* a_base() const { return A; }
    __device__ unsigned a_off(const pg8::Unit& u, int r) const {
        if (gather) { const int p = u.t * 256 + r; const int n = cnt[u.e]; const int tok = p < n ? list[u.e * ECAP + p] : 0; return (unsigned)tok * lda2; }
        return (unsigned)(u.pm * 256 + r) * lda2;
    }
    __device__ const char* b_ptr(const pg8::Unit& u) const { return Bt + (size_t)u.e * bstride + (size_t)u.pn * 256 * K * 2; }
};

struct EpiProj {
    static constexpr bool PERM = true;
    bf16_t* proj; const float* lbt;
    __device__ __forceinline__ void operator()(const f32x4 (&acc)[2][2][4][2], const pg8::Unit& u, int wr, int wc, int fr, int fq) const {
        const int seg = u.pn >> 1;
        const int row0 = prow_of(u.pm * 256) + wr * 64 + fr, col0 = u.pn * 256 + wc * 32 + 8 * fq;
        const int mode = (seg == 0 || seg == 3 || seg == 7) ? 1 : (seg == 1 ? 2 : 0);
        float lb[2][8];
#pragma unroll
        for (int bj = 0; bj < 2; ++bj)
#pragma unroll
            for (int j = 0; j < 8; ++j) lb[bj][j] = (mode == 2) ? lbt[col0 + bj * 128 + j - C_LF] : 0.f;
#pragma unroll
        for (int ai = 0; ai < 2; ++ai)
#pragma unroll
            for (int m = 0; m < 4; ++m) { bf16_t* rowp = proj + (size_t)(row0 + ai * 128 + m * 16) * NPROJ + col0;
#pragma unroll
                for (int bj = 0; bj < 2; ++bj) { float v[8];
#pragma unroll
                    for (int j = 0; j < 4; ++j) { v[j] = acc[ai][bj][m][0][j]; v[4 + j] = acc[ai][bj][m][1][j]; }
                    if (mode == 1) {
#pragma unroll
                        for (int j = 0; j < 8; ++j) v[j] = siluf_(v[j]);
                    } else if (mode == 2) {
#pragma unroll
                        for (int j = 0; j < 8; ++j) v[j] = __logf(lb[bj][j] + (1.0f - lb[bj][j]) * sigmoidf_(v[j]));
                    }
                    u32x4 w; w.x = cvt_pk_bf16(v[0], v[1]); w.y = cvt_pk_bf16(v[2], v[3]); w.z = cvt_pk_bf16(v[4], v[5]); w.w = cvt_pk_bf16(v[6], v[7]);
                    *(u32x4*)(rowp + bj * 128) = w; } }
    }
};
template <int SECOND> struct EpiGate {
    static constexpr bool PERM = true;
    const bf16_t* proj; bf16_t* tmp;
    __device__ __forceinline__ void operator()(const f32x4 (&acc)[2][2][4][2], const pg8::Unit& u, int wr, int wc, int fr, int fq) const {
        const int prow0 = prow_of(u.pm * 256) + wr * 64 + fr, row0 = u.pm * 256 + wr * 64 + fr, col0 = u.pn * 256 + wc * 32 + 8 * fq;
#pragma unroll
        for (int ai = 0; ai < 2; ++ai)
#pragma unroll
            for (int m = 0; m < 4; ++m) {
                const bf16_t* gp = proj + (size_t)(prow0 + ai * 128 + m * 16) * NPROJ + (SECOND ? C_PB : C_PA) + col0;
                bf16_t* tp = tmp + (size_t)(row0 + ai * 128 + m * 16) * D + col0;
#pragma unroll
                for (int bj = 0; bj < 2; ++bj) {
                    const u32x4 g = *(const u32x4*)(gp + bj * 128);
                    float v[8];
#pragma unroll
                    for (int j = 0; j < 4; ++j) { v[j] = acc[ai][bj][m][0][j]; v[4 + j] = acc[ai][bj][m][1][j]; }
                    const float gg[8] = {bf_lo(g.x), bf_hi(g.x), bf_lo(g.y), bf_hi(g.y), bf_lo(g.z), bf_hi(g.z), bf_lo(g.w), bf_hi(g.w)};
#pragma unroll
                    for (int j = 0; j < 8; ++j) v[j] *= sigmoidf_(gg[j]);
                    if (SECOND) { const u32x4 o = *(const u32x4*)(tp + bj * 128);
                        const float oo[8] = {bf_lo(o.x), bf_hi(o.x), bf_lo(o.y), bf_hi(o.y), bf_lo(o.z), bf_hi(o.z), bf_lo(o.w), bf_hi(o.w)};
#pragma unroll
                        for (int j = 0; j < 8; ++j) v[j] += oo[j]; }
                    u32x4 w; w.x = cvt_pk_bf16(v[0], v[1]); w.y = cvt_pk_bf16(v[2], v[3]); w.z = cvt_pk_bf16(v[4], v[5]); w.w = cvt_pk_bf16(v[6], v[7]);
                    *(u32x4*)(tp + bj * 128) = w; }
                asm volatile("" ::: "memory"); }
    }
};
struct EpiResid {
    static constexpr bool PERM = false;
    const float* x; float* h1;
    __device__ __forceinline__ void operator()(const f32x4 (&acc)[2][2][4][2], const pg8::Unit& u, int wr, int wc, int fr, int fq) const {
        const int row0 = u.pm * 256 + wr * 64 + fr, col0 = u.pn * 256 + wc * 32 + 4 * fq;
#pragma unroll
        for (int ai = 0; ai < 2; ++ai)
#pragma unroll
            for (int m = 0; m < 4; ++m) { const size_t off = (size_t)(row0 + ai * 128 + m * 16) * D + col0;
#pragma unroll
                for (int bj = 0; bj < 2; ++bj)
#pragma unroll
                    for (int n = 0; n < 2; ++n) { const f32x4 xv = *(const f32x4*)(x + off + bj * 128 + n * 16); *(f32x4*)(h1 + off + bj * 128 + n * 16) = xv + acc[ai][bj][m][n]; }
                asm volatile("" ::: "memory"); }
    }
};
struct EpiSwiglu {
    static constexpr bool PERM = false;
    bf16_t* H;
    __device__ __forceinline__ void operator()(const f32x4 (&acc)[2][2][4][2], const pg8::Unit& u, int wr, int wc, int fr, int fq) const {
        const int row0 = u.pm * 256 + wr * 64 + fr, col0 = u.pn * 128 + wc * 16 + 4 * fq;
#pragma unroll
        for (int ai = 0; ai < 2; ++ai)
#pragma unroll
            for (int m = 0; m < 4; ++m) { bf16_t* rowp = H + (size_t)(row0 + ai * 128 + m * 16) * 512 + col0;
#pragma unroll
                for (int bj = 0; bj < 2; ++bj) { const f32x4 g = acc[ai][bj][m][0], up = acc[ai][bj][m][1];
                    u32x2 w; w.x = cvt_pk_bf16(siluf_(g[0]) * up[0], siluf_(g[1]) * up[1]); w.y = cvt_pk_bf16(siluf_(g[2]) * up[2], siluf_(g[3]) * up[3]);
                    *(u32x2*)(rowp + bj * 64) = w; } }
    }
};
struct EpiY {
    static constexpr bool PERM = true;
    bf16_t* Y;
    __device__ __forceinline__ void operator()(const f32x4 (&acc)[2][2][4][2], const pg8::Unit& u, int wr, int wc, int fr, int fq) const {
        const int row0 = u.pm * 256 + wr * 64 + fr, col0 = u.pn * 256 + wc * 32 + 8 * fq;
#pragma unroll
        for (int ai = 0; ai < 2; ++ai)
#pragma unroll
            for (int m = 0; m < 4; ++m) { bf16_t* rowp = Y + (size_t)(row0 + ai * 128 + m * 16) * D + col0;
#pragma unroll
                for (int bj = 0; bj < 2; ++bj) { const f32x4 a = acc[ai][bj][m][0], b = acc[ai][bj][m][1];
                    u32x4 w; w.x = cvt_pk_bf16(a[0], a[1]); w.y = cvt_pk_bf16(a[2], a[3]); w.z = cvt_pk_bf16(b[0], b[1]); w.w = cvt_pk_bf16(b[2], b[3]);
                    *(u32x4*)(rowp + bj * 128) = w; } }
    }
};

constexpr int LDS_GEMM = pg8::STAGE_BYTES + 1024;
struct GemmArgs { const char* A; const char* Bt; void* o0; const void* i0; const void* i1; unsigned lda2; int K; int M; int N; int rowmap; int mode; };

template <class Epi> __device__ __forceinline__ void run_dense(LAS unsigned char* lds, const GemmArgs& g, const Epi& E) {
    SchedDense S; S.so.init(g.M, g.N, (int)gridDim.x, (int)blockIdx.x); S.A = g.A; S.lda2 = g.lda2; S.K = g.K; S.Bt = g.Bt; S.rowmap = g.rowmap;
    pg8::gemm_phase<Epi, SchedDense>(lds, S, E);
}
__global__ __launch_bounds__(512, 2) void k_gemm_dense(GemmArgs g) {
    extern __shared__ __attribute__((aligned(16))) unsigned char shm[];
    LAS unsigned char* lds = (LAS unsigned char*)shm;
    if (g.mode == 0) { EpiProj E{(bf16_t*)g.o0, (const float*)g.i0}; run_dense(lds, g, E); }
    else if (g.mode == 1) { EpiGate<0> E{(const bf16_t*)g.i0, (bf16_t*)g.o0}; run_dense(lds, g, E); }
    else if (g.mode == 2) { EpiGate<1> E{(const bf16_t*)g.i0, (bf16_t*)g.o0}; run_dense(lds, g, E); }
    else { EpiResid E{(const float*)g.i0, (float*)g.o0}; run_dense(lds, g, E); }
}
struct MoeArgs { const char* A; const char* Bt; void* out; const int* cnt; const int* list; size_t bstride; unsigned lda2; int K; int mode; int pad; };
__global__ __launch_bounds__(512, 2) void k_gemm_moe(MoeArgs g) {
    extern __shared__ __attribute__((aligned(16))) unsigned char shm[];
    LAS unsigned char* lds = (LAS unsigned char*)shm;
    LAS int* pref = (LAS int*)(lds + pg8::STAGE_BYTES);
    if (threadIdx.x == 0) { int s = 0; for (int e = 0; e < NEXP; ++e) { pref[e] = s; s += (g.cnt[e] + 255) >> 8; } pref[NEXP] = s; }
    __syncthreads();
    SchedMoe S; S.cnt = g.cnt; S.list = g.list; S.pref = pref; S.A = g.A; S.lda2 = g.lda2; S.K = g.K; S.Bt = g.Bt; S.bstride = g.bstride; S.gather = (g.mode == 0); S.G = (int)gridDim.x; S.c = (int)blockIdx.x;
    if (g.mode == 0) { EpiSwiglu E{(bf16_t*)g.out}; pg8::gemm_phase<EpiSwiglu, SchedMoe>(lds, S, E); }
    else { EpiY E{(bf16_t*)g.out}; pg8::gemm_phase<EpiY, SchedMoe>(lds, S, E); }
}

__global__ void k_misc(const float* lbl, float* lbt, int* cnt) {
    const int i = threadIdx.x;
    if (i < 512) { const float a = lbl[i], b = lbl[512 + i]; const float m = fmaxf(a, b); const float ea = __expf(a - m), eb = __expf(b - m); lbt[i] = ea / (ea + eb); }
    if (i < NEXP) cnt[i] = 0;
}
template <int MODE> __global__ __launch_bounds__(256) void k_tr(const float* s0, const float* s1, bf16_t* dst, int K, int ld, size_t sbatch, size_t dbatch) {
    __shared__ float tile[64][65];
    const int k0 = blockIdx.x * 64, n0 = blockIdx.y * 64, e = blockIdx.z;
    const float* a = s0 + (size_t)e * sbatch; const float* b = s1 ? s1 + (size_t)e * sbatch : nullptr;
    const int tx = threadIdx.x & 63, ty = threadIdx.x >> 6;
    const int n = n0 + tx;
    const float* colp;
    if (MODE == 0) colp = a + (n < 4096 ? n : n + 8);
    else if (MODE == 1) colp = a + n;
    else { const int grp = n >> 5, w = n & 31; colp = (w < 16 ? a : b) + grp * 16 + (w & 15); }
    for (int i = ty; i < 64; i += 4) tile[i][tx] = colp[(size_t)(k0 + i) * ld];
    __syncthreads();
    const int ni = threadIdx.x >> 2, kq = (threadIdx.x & 3) * 16;
    unsigned w[8];
#pragma unroll
    for (int j = 0; j < 8; ++j) w[j] = cvt_pk_bf16(tile[kq + 2 * j][ni], tile[kq + 2 * j + 1][ni]);
    bf16_t* d = dst + (size_t)e * dbatch + (size_t)(n0 + ni) * K + k0 + kq;
    *(u32x4*)d = (u32x4){w[0], w[1], w[2], w[3]}; *(u32x4*)(d + 8) = (u32x4){w[4], w[5], w[6], w[7]};
}
__device__ __forceinline__ float softplusf_(float x) { return x > 20.f ? x : log1pf(__expf(x)); }
__global__ __launch_bounds__(512) void k_prep_x(const float* x, const float* g1, const float* w_in, const float* A_log, const float* dt_bias, bf16_t* xb, float* gbf) {
    __shared__ float w8[8 * 1024];
    for (int i = threadIdx.x; i < 8192; i += 512) { const int j = i >> 10, k = i & 1023; w8[i] = w_in[(size_t)k * WIN_LD + 4096 + j]; }
    __syncthreads();
    const int wv = threadIdx.x >> 6, l = threadIdx.x & 63;
    for (int rr = 0; rr < 4; ++rr) {
        const int row = blockIdx.x * 32 + wv * 4 + rr;
        const f32x4* xr = (const f32x4*)(x + (size_t)row * D);
        f32x4 v[4]; float ss = 0.f;
#pragma unroll
        for (int i = 0; i < 4; ++i) { v[i] = xr[l + 64 * i]; ss += v[i][0] * v[i][0] + v[i][1] * v[i][1] + v[i][2] * v[i][2] + v[i][3] * v[i][3]; }
        ss = wave_sum(ss);
        const float rstd = rsqrtf(ss * (1.0f / D) + EPS);
        float acc[8] = {0.f, 0.f, 0.f, 0.f, 0.f, 0.f, 0.f, 0.f};
#pragma unroll
        for (int i = 0; i < 4; ++i) { const f32x4 gv = ((const f32x4*)g1)[l + 64 * i]; v[i] = v[i] * rstd * gv;
            u32x2 w; w.x = cvt_pk_bf16(v[i][0], v[i][1]); w.y = cvt_pk_bf16(v[i][2], v[i][3]);
            *(u32x2*)(xb + (size_t)row * D + 4 * (l + 64 * i)) = w;
#pragma unroll
            for (int j = 0; j < 8; ++j) { const f32x4 wj = *(const f32x4*)&w8[j * 1024 + 4 * (l + 64 * i)]; acc[j] += v[i][0] * wj[0] + v[i][1] * wj[1] + v[i][2] * wj[2] + v[i][3] * wj[3]; } }
#pragma unroll
        for (int j = 0; j < 8; ++j) acc[j] = wave_sum(acc[j]);
        if (l == 0) { float* o = gbf + (size_t)prow_of(row) * 8;
#pragma unroll
            for (int j = 0; j < 4; ++j) o[j] = sigmoidf_(acc[j]);
#pragma unroll
            for (int j = 0; j < 4; ++j) o[4 + j] = -__expf(A_log[j]) * softplusf_(acc[4 + j] + dt_bias[j]); }
    }
}
__global__ __launch_bounds__(256) void k_meta(const float* meta, const float* g1, const float* w_in, const float* lbt, const float* A_log, const float* dt_bias, bf16_t* proj, float* gbf) {
    __shared__ float hn[1024 * 16];
    const int wv = threadIdx.x >> 6, l = threadIdx.x & 63;
    for (int r = wv; r < 16; r += 4) {
        const f32x4* xr = (const f32x4*)(meta + (size_t)r * D);
        f32x4 v[4]; float ss = 0.f;
#pragma unroll
        for (int i = 0; i < 4; ++i) { v[i] = xr[l + 64 * i]; ss += v[i][0] * v[i][0] + v[i][1] * v[i][1] + v[i][2] * v[i][2] + v[i][3] * v[i][3]; }
        ss = wave_sum(ss);
        const float rstd = rsqrtf(ss * (1.0f / D) + EPS);
#pragma unroll
        for (int i = 0; i < 4; ++i) { const f32x4 gv = ((const f32x4*)g1)[l + 64 * i];
#pragma unroll
            for (int c = 0; c < 4; ++c) hn[(4 * (l + 64 * i) + c) * 16 + r] = v[i][c] * rstd * gv[c]; }
    }
    __syncthreads();
    const int n = blockIdx.x * 256 + threadIdx.x;
    if (n < WIN_LD) {
        float acc[16];
#pragma unroll
        for (int i = 0; i < 16; ++i) acc[i] = 0.f;
        for (int k = 0; k < 1024; ++k) { const float w = w_in[(size_t)k * WIN_LD + n];
#pragma unroll
            for (int i4 = 0; i4 < 4; ++i4) { const f32x4 h = *(const f32x4*)&hn[k * 16 + 4 * i4]; acc[4 * i4] += w * h[0]; acc[4 * i4 + 1] += w * h[1]; acc[4 * i4 + 2] += w * h[2]; acc[4 * i4 + 3] += w * h[3]; } }
        if (n < 4096 || n >= 4104) {
            const int pc = n < 4096 ? n : n - 8, seg = pc >> 9;
            const float lb = (seg == 1) ? lbt[pc - C_LF] : 0.f;
#pragma unroll
            for (int i = 0; i < 16; ++i) { float v = acc[i];
                if (seg == 0 || seg == 3 || seg == 7) v = siluf_(v); else if (seg == 1) v = __logf(lb + (1.0f - lb) * sigmoidf_(v));
                const bf16_t o = f2bf(v);
                for (int b = 0; b < NB; ++b) proj[(size_t)(b * LP + 48 + i) * NPROJ + pc] = o; }
        } else {
            const int j = n - 4096;
#pragma unroll
            for (int i = 0; i < 16; ++i) { const float v = j < 4 ? sigmoidf_(acc[i]) : -__expf(A_log[j - 4]) * softplusf_(acc[i] + dt_bias[j - 4]);
                for (int b = 0; b < NB; ++b) gbf[(size_t)(b * LP + 48 + i) * 8 + j] = v; }
        }
    }
    for (size_t i = (size_t)blockIdx.x * 256 + threadIdx.x; i < (size_t)NB * 48 * (NPROJ / 8); i += (size_t)gridDim.x * 256) {
        const int b = (int)(i / (48 * (NPROJ / 8))), rem = (int)(i % (48 * (NPROJ / 8))), r = rem / (NPROJ / 8), c8 = rem % (NPROJ / 8);
        *(u32x4*)(proj + (size_t)(b * LP + r) * NPROJ + c8 * 8) = (u32x4){0u, 0u, 0u, 0u};
    }
    for (int i = blockIdx.x * 256 + threadIdx.x; i < NB * 48 * 8; i += gridDim.x * 256) { const int b = i / (48 * 8), rem = i % (48 * 8); gbf[(size_t)(b * LP) * 8 + rem] = 0.f; }
}

__global__ __launch_bounds__(256) void k_conv(const bf16_t* proj, const float* cw, bf16_t* qkvn) {
    const int row = blockIdx.x, b = row / LP, p = row % LP;
    const int wv = threadIdx.x >> 6, l = threadIdx.x & 63;
    for (int sec = wv; sec < 12; sec += 4) {
        const int ch = sec * 128 + 2 * l;
        float a0 = 0.f, a1 = 0.f;
#pragma unroll
        for (int j = 0; j < 4; ++j) { const int pp = p - 3 + j;
            if (pp >= 48) { const unsigned xw = *(const unsigned*)(proj + (size_t)(b * LP + pp) * NPROJ + C_GQ + ch); a0 += cw[j * 1536 + ch] * bf_lo(xw); a1 += cw[j * 1536 + ch + 1] * bf_hi(xw); } }
        float y0 = siluf_(a0), y1 = siluf_(a1);
        if (sec < 8) { const float ss = wave_sum(y0 * y0 + y1 * y1); const float sc = rsqrtf(ss + EPS) * (sec < 4 ? 0.08838834764831845f : 1.0f); y0 *= sc; y1 *= sc; }
        *(unsigned*)(qkvn + (size_t)row * 1536 + ch) = cvt_pk_bf16(y0, y1);
    }
}
__global__ __launch_bounds__(128) void k_rec_naive(bf16_t* proj, const bf16_t* qkvn, const float* gbf, const float* hg_norm_g, const float* gd_norm_g) {
    __shared__ float qs[32][128], fs[32][128], vs[32][128];
    float (*os)[128] = vs;
    __shared__ float as_[32], bs_[32];
    const int br = blockIdx.x >> 4, b = (blockIdx.x >> 2) & 3, h = blockIdx.x & 3, tid = threadIdx.x, wv = tid >> 6, l = tid & 63;
    float S[128];
#pragma unroll
    for (int k = 0; k < 128; ++k) S[k] = 0.f;
    const float* gn = br == 0 ? hg_norm_g : gd_norm_g;
    const float gn0 = gn[l], gn1 = gn[l + 64];
    for (int blk = 1; blk < LP / 32; ++blk) {
        const int r0 = b * LP + blk * 32;
        if (br == 0) {
            for (int i = 0; i < 32; ++i) { const bf16_t* rp = proj + (size_t)(r0 + i) * NPROJ + h * 128 + tid;
                qs[i][tid] = bf2f(rp[C_QA]); fs[i][tid] = __expf(bf2f(rp[C_LF])); vs[i][tid] = bf2f(rp[C_VA]); }
        } else {
            for (int i = 0; i < 32; ++i) { const bf16_t* rp = qkvn + (size_t)(r0 + i) * 1536 + h * 128 + tid;
                qs[i][tid] = bf2f(rp[0]); fs[i][tid] = bf2f(rp[512]); vs[i][tid] = bf2f(rp[1024]); }
            if (tid < 32) { bs_[tid] = gbf[(size_t)(r0 + tid) * 8 + h]; as_[tid] = __expf(gbf[(size_t)(r0 + tid) * 8 + 4 + h]); }
        }
        __syncthreads();
        for (int i = 0; i < 32; ++i) {
            const float vown = vs[i][tid]; float o = 0.f;
            if (br == 0) {
#pragma unroll
                for (int k = 0; k < 128; k += 4) { const f32x4 f4 = *(const f32x4*)&fs[i][k], q4 = *(const f32x4*)&qs[i][k];
#pragma unroll
                    for (int c = 0; c < 4; ++c) { S[k + c] = f4[c] * S[k + c] + (1.0f - f4[c]) * vown; o += S[k + c] * q4[c]; } }
            } else {
                const float a = as_[i], be = bs_[i]; float kS = 0.f;
#pragma unroll
                for (int k = 0; k < 128; k += 4) { const f32x4 k4 = *(const f32x4*)&fs[i][k];
#pragma unroll
                    for (int c = 0; c < 4; ++c) kS += k4[c] * S[k + c]; }
                const float coef = be * (vown - a * kS);
#pragma unroll
                for (int k = 0; k < 128; k += 4) { const f32x4 k4 = *(const f32x4*)&fs[i][k], q4 = *(const f32x4*)&qs[i][k];
#pragma unroll
                    for (int c = 0; c < 4; ++c) { S[k + c] = a * S[k + c] + k4[c] * coef; o += S[k + c] * q4[c]; } }
            }
            os[i][tid] = o;
        }
        __syncthreads();
        for (int i = wv; i < 32; i += 2) {
            const float a = os[i][l], c = os[i][l + 64];
            const float ss = wave_sum(a * a + c * c);
            const float rstd = rsqrtf(ss * (1.0f / 128.0f) + EPS);
            bf16_t* rp = proj + (size_t)(r0 + i) * NPROJ + h * 128;
            const int cg = br == 0 ? C_HG : C_GZ, co = br == 0 ? C_QA : C_GQ;
            const float g0 = bf2f(rp[cg + l]), g1v = bf2f(rp[cg + l + 64]);
            rp[co + l] = f2bf(a * rstd * gn0 * g0); rp[co + l + 64] = f2bf(c * rstd * gn1 * g1v);
        }
        __syncthreads();
    }
}

__global__ __launch_bounds__(512) void k_router(const float* h1, const float* g2, const float* rgw, const float* rgb, const float* rew, const float* reb, bf16_t* xn, int* cnt, int* list, int* asg) {
    extern __shared__ __attribute__((aligned(16))) unsigned char shm[];
    float* wrt = (float*)shm;
    for (int i = threadIdx.x; i < 36 * 1024; i += 512) { const int c = i >> 10, k = i & 1023; wrt[i] = c < 4 ? rgw[k * 4 + c] : rew[k * 32 + (c - 4)]; }
    __syncthreads();
    const int wv = threadIdx.x >> 6, l = threadIdx.x & 63;
    for (int rr = 0; rr < 4; ++rr) {
        const int row = blockIdx.x * 32 + wv * 4 + rr;
        const f32x4* xr = (const f32x4*)(h1 + (size_t)row * D);
        f32x4 v[4]; float ss = 0.f;
#pragma unroll
        for (int i = 0; i < 4; ++i) { v[i] = xr[l + 64 * i]; ss += v[i][0] * v[i][0] + v[i][1] * v[i][1] + v[i][2] * v[i][2] + v[i][3] * v[i][3]; }
        ss = wave_sum(ss);
        const float rstd = rsqrtf(ss * (1.0f / D) + EPS);
#pragma unroll
        for (int i = 0; i < 4; ++i) { const f32x4 gv = ((const f32x4*)g2)[l + 64 * i]; v[i] = v[i] * rstd * gv;
            u32x2 w; w.x = cvt_pk_bf16(v[i][0], v[i][1]); w.y = cvt_pk_bf16(v[i][2], v[i][3]);
            *(u32x2*)(xn + (size_t)row * D + 4 * (l + 64 * i)) = w; }
        float gl[4];
#pragma unroll
        for (int c = 0; c < 4; ++c) { float p = 0.f;
#pragma unroll
            for (int i = 0; i < 4; ++i) { const f32x4 wj = *(const f32x4*)&wrt[c * 1024 + 4 * (l + 64 * i)]; p += v[i][0] * wj[0] + v[i][1] * wj[1] + v[i][2] * wj[2] + v[i][3] * wj[3]; }
            gl[c] = wave_sum(p) + rgb[c]; }
        int grp = 0; float gm = gl[0];
#pragma unroll
        for (int i = 1; i < 4; ++i) if (gl[i] > gm) { gm = gl[i]; grp = i; }
        float gs = 0.f;
#pragma unroll
        for (int i = 0; i < 4; ++i) gs += __expf(gl[i] - gm);
        const float pg = 1.0f / gs;
        float el[8];
#pragma unroll
        for (int j = 0; j < 8; ++j) { float p = 0.f; const float* wc_ = wrt + (4 + grp * 8 + j) * 1024;
#pragma unroll
            for (int i = 0; i < 4; ++i) { const f32x4 wj = *(const f32x4*)&wc_[4 * (l + 64 * i)]; p += v[i][0] * wj[0] + v[i][1] * wj[1] + v[i][2] * wj[2] + v[i][3] * wj[3]; }
            el[j] = wave_sum(p) + reb[grp * 8 + j]; }
        if (l == 0) {
            int i1 = 0; float m1 = el[0];
#pragma unroll
            for (int j = 1; j < 8; ++j) if (el[j] > m1) { m1 = el[j]; i1 = j; }
            int i2 = -1; float m2 = -3.0e38f;
#pragma unroll
            for (int j = 0; j < 8; ++j) if (j != i1 && el[j] > m2) { m2 = el[j]; i2 = j; }
            const float p1 = 1.0f, p2 = __expf(m2 - m1);
            const float w1 = pg * p1 / (p1 + p2), w2 = pg * p2 / (p1 + p2);
            const int e1 = grp * 8 + i1, e2 = grp * 8 + i2;
            const int pos1 = atomicAdd(&cnt[e1], 1), pos2 = atomicAdd(&cnt[e2], 1);
            list[e1 * ECAP + pos1] = row; list[e2 * ECAP + pos2] = row;
            int* a = asg + (size_t)row * 6;
            a[0] = e1; a[1] = pos1; a[2] = __float_as_int(w1); a[3] = e2; a[4] = pos2; a[5] = __float_as_int(w2);
        }
    }
}
__global__ __launch_bounds__(512) void k_final(float* h1, const bf16_t* Y, const int* cnt, const int* asg, const float* gf) {
    __shared__ int offr[NEXP];
    if (threadIdx.x == 0) { int s = 0; for (int e = 0; e < NEXP; ++e) { offr[e] = s * 256; s += (cnt[e] + 255) >> 8; } }
    __syncthreads();
    const int wv = threadIdx.x >> 6, l = threadIdx.x & 63;
    for (int rr = 0; rr < 4; ++rr) {
        const int row = blockIdx.x * 32 + wv * 4 + rr;
        const int* a = asg + (size_t)row * 6;
        const int s1 = offr[a[0]] + a[1], s2 = offr[a[3]] + a[4]; const float w1 = __int_as_float(a[2]), w2 = __int_as_float(a[5]);
        f32x4* xr = (f32x4*)(h1 + (size_t)row * D);
        f32x4 v[4]; float ss = 0.f;
#pragma unroll
        for (int i = 0; i < 4; ++i) { v[i] = xr[l + 64 * i];
            const u32x2 y1 = *(const u32x2*)(Y + (size_t)s1 * D + 4 * (l + 64 * i)), y2 = *(const u32x2*)(Y + (size_t)s2 * D + 4 * (l + 64 * i));
            v[i][0] += w1 * bf_lo(y1.x) + w2 * bf_lo(y2.x); v[i][1] += w1 * bf_hi(y1.x) + w2 * bf_hi(y2.x);
            v[i][2] += w1 * bf_lo(y1.y) + w2 * bf_lo(y2.y); v[i][3] += w1 * bf_hi(y1.y) + w2 * bf_hi(y2.y);
            ss += v[i][0] * v[i][0] + v[i][1] * v[i][1] + v[i][2] * v[i][2] + v[i][3] * v[i][3]; }
        ss = wave_sum(ss);
        const float rstd = rsqrtf(ss * (1.0f / D) + EPS);
#pragma unroll
        for (int i = 0; i < 4; ++i) { const f32x4 gv = ((const f32x4*)gf)[l + 64 * i]; xr[l + 64 * i] = v[i] * rstd * gv; }
    }
}

extern "C" void kernel_launch(void* const* d_in, const int* in_sizes, int n_in, void* d_out, int out_size, void* d_ws, size_t ws_size, hipStream_t stream) {
    static int init = 0;
    if (init == 0) {
        init = 1;
        if (n_in != 22 || in_sizes[0] != T * D || out_size != T * D || ws_size < WS_END) { fprintf(stderr, "kernel_launch: unexpected shapes (n_in %d in0 %d out %d ws %zu need %zu)\n", n_in, n_in > 0 ? in_sizes[0] : -1, out_size, ws_size, (size_t)WS_END); init = -1; }
        else {
            if (hipFuncSetAttribute((const void*)k_gemm_dense, hipFuncAttributeMaxDynamicSharedMemorySize, LDS_GEMM) != hipSuccess) init = -1;
            if (hipFuncSetAttribute((const void*)k_gemm_moe, hipFuncAttributeMaxDynamicSharedMemorySize, LDS_GEMM) != hipSuccess) init = -1;
            if (hipFuncSetAttribute((const void*)k_router, hipFuncAttributeMaxDynamicSharedMemorySize, 36 * 1024 * 4) != hipSuccess) init = -1;
            if (init < 0) fprintf(stderr, "kernel_launch: hipFuncSetAttribute failed\n");
        }
    }
    if (init < 0) return;
    const float* x = (const float*)d_in[0]; const float* meta = (const float*)d_in[1]; const float* lbl = (const float*)d_in[2]; const float* g1 = (const float*)d_in[3];
    const float* w_in = (const float*)d_in[4]; const float* convw = (const float*)d_in[5]; const float* A_log = (const float*)d_in[6]; const float* dt_bias = (const float*)d_in[7];
    const float* hg_ng = (const float*)d_in[8]; const float* gd_ng = (const float*)d_in[9]; const float* hg_up = (const float*)d_in[10]; const float* gd_up = (const float*)d_in[11];
    const float* w_out = (const float*)d_in[12]; const float* g2 = (const float*)d_in[13]; const float* rgw = (const float*)d_in[14]; const float* rgb = (const float*)d_in[15];
    const float* rew = (const float*)d_in[16]; const float* reb = (const float*)d_in[17]; const float* w_gate = (const float*)d_in[18]; const float* w_up = (const float*)d_in[19];
    const float* w_down = (const float*)d_in[20]; const float* gf = (const float*)d_in[21];
    char* ws = (char*)d_ws; float* out = (float*)d_out;
    bf16_t* proj = (bf16_t*)(ws + OFF_PROJ); bf16_t* Win = (bf16_t*)(ws + OFF_WIN); bf16_t* Whg = (bf16_t*)(ws + OFF_WHG); bf16_t* Wgd = (bf16_t*)(ws + OFF_WGD); bf16_t* Wout = (bf16_t*)(ws + OFF_WOUT);
    float* gbf = (float*)(ws + OFF_GBF); float* lbt = (float*)(ws + OFF_MISC + MISC_LBT); int* cnt = (int*)(ws + OFF_MISC + MISC_CNT);
    bf16_t* qkvn = (bf16_t*)(ws + OFF_QKVN); bf16_t* tmp = (bf16_t*)(ws + OFF_TMP);
    bf16_t* xb = (bf16_t*)d_out;
    bf16_t* xn = (bf16_t*)(ws + OFF_XN); bf16_t* We1 = (bf16_t*)(ws + OFF_WE1); bf16_t* We2 = (bf16_t*)(ws + OFF_WE2); bf16_t* Hb = (bf16_t*)(ws + OFF_H); bf16_t* Yb = (bf16_t*)(ws + OFF_Y);
    int* list = (int*)(ws + OFF_LIST); int* asg = (int*)(ws + OFF_ASG);

    k_misc<<<1, 512, 0, stream>>>(lbl, lbt, cnt);
    k_tr<0><<<dim3(16, 96, 1), 256, 0, stream>>>(w_in, nullptr, Win, 1024, WIN_LD, 0, 0);
    k_tr<1><<<dim3(8, 16, 1), 256, 0, stream>>>(hg_up, nullptr, Whg, 512, 1024, 0, 0);
    k_tr<1><<<dim3(8, 16, 1), 256, 0, stream>>>(gd_up, nullptr, Wgd, 512, 1024, 0, 0);
    k_tr<1><<<dim3(16, 16, 1), 256, 0, stream>>>(w_out, nullptr, Wout, 1024, 1024, 0, 0);
    k_prep_x<<<T / 32, 512, 0, stream>>>(x, g1, w_in, A_log, dt_bias, xb, gbf);
    k_meta<<<25, 256, 0, stream>>>(meta, g1, w_in, lbt, A_log, dt_bias, proj, gbf);
    { GemmArgs g{}; g.A = (const char*)xb; g.Bt = (const char*)Win; g.o0 = proj; g.i0 = lbt; g.i1 = nullptr; g.lda2 = D * 2; g.K = 1024; g.M = T; g.N = NPROJ; g.rowmap = 0; g.mode = 0;
      k_gemm_dense<<<256, 512, LDS_GEMM, stream>>>(g); }
    k_conv<<<TP, 256, 0, stream>>>(proj, convw, qkvn);
    k_rec_naive<<<32, 128, 0, stream>>>(proj, qkvn, gbf, hg_ng, gd_ng);
    { GemmArgs g{}; g.A = (const char*)(proj + C_QA); g.Bt = (const char*)Whg; g.o0 = tmp; g.i0 = proj; g.i1 = nullptr; g.lda2 = NPROJ * 2; g.K = 512; g.M = T; g.N = 1024; g.rowmap = 1; g.mode = 1;
      k_gemm_dense<<<256, 512, LDS_GEMM, stream>>>(g); }
    { GemmArgs g{}; g.A = (const char*)(proj + C_GQ); g.Bt = (const char*)Wgd; g.o0 = tmp; g.i0 = proj; g.i1 = nullptr; g.lda2 = NPROJ * 2; g.K = 512; g.M = T; g.N = 1024; g.rowmap = 1; g.mode = 2;
      k_gemm_dense<<<256, 512, LDS_GEMM, stream>>>(g); }
    { GemmArgs g{}; g.A = (const char*)tmp; g.Bt = (const char*)Wout; g.o0 = out; g.i0 = x; g.i1 = nullptr; g.lda2 = D * 2; g.K = 1024; g.M = T; g.N = 1024; g.rowmap = 0; g.mode = 3;
      k_gemm_dense<<<256, 512, LDS_GEMM, stream>>>(g); }
    k_tr<2><<<dim3(16, 16, NEXP), 256, 0, stream>>>(w_gate, w_up, We1, 1024, 512, (size_t)1024 * 512, (size_t)1024 * 1024);
    k_tr<1><<<dim3(8, 16, NEXP), 256, 0, stream>>>(w_down, nullptr, We2, 512, 1024, (size_t)512 * 1024, (size_t)1024 * 512);
    k_router<<<T / 32, 512, 36 * 1024 * 4, stream>>>(out, g2, rgw, rgb, rew, reb, xn, cnt, list, asg);
    { MoeArgs g{}; g.A = (const char*)xn; g.Bt = (const char*)We1; g.out = Hb; g.cnt = cnt; g.list = list; g.lda2 = D * 2; g.K = 1024; g.mode = 0; g.bstride = (size_t)1024 * 1024 * 2;
      k_gemm_moe<<<256, 512, LDS_GEMM, stream>>>(g); }
    { MoeArgs g{}; g.A = (const char*)Hb; g.Bt = (const char*)We2; g.out = Yb; g.cnt = cnt; g.list = list; g.lda2 = 512 * 2; g.K = 512; g.mode = 1; g.bstride = (size_t)1024 * 512 * 2;
      k_gemm_moe<<<256, 512, LDS_GEMM, stream>>>(g); }
    k_final<<<T / 32, 512, 0, stream>>>(out, Yb, cnt, asg, gf);
}
```

```cpp
#include <hip/hip_runtime.h>
#include <hip/hip_cooperative_groups.h>
namespace cg = cooperative_groups;
#include <cstdio>
#include <cstdint>

#define LAS __attribute__((address_space(3)))
typedef unsigned short bf16_t;
typedef short bf16x8 __attribute__((ext_vector_type(8)));
typedef float f32x4 __attribute__((ext_vector_type(4)));
typedef unsigned u32x4 __attribute__((ext_vector_type(4)));
typedef unsigned u32x2 __attribute__((ext_vector_type(2)));

constexpr int D = 1024, NB = 4, SEQ = 8192, NMETA = 16, T = NB * SEQ;
constexpr int LP = 8256;
constexpr int TP = NB * LP;
constexpr int NPROJ = 6144;
constexpr int WIN_LD = 6152;
constexpr float EPS = 1e-6f;
constexpr int NEXP = 32, ECAP = 32768, HROWS = 73728;
constexpr int C_QA = 0, C_LF = 512, C_VA = 1024, C_HG = 1536, C_GQ = 2048, C_GK = 2560, C_GV = 3072, C_GZ = 3584, C_PA = 4096, C_PB = 5120;

constexpr size_t OFF_PROJ = 0;
constexpr size_t SZ_PROJ = (size_t)TP * NPROJ * 2;
constexpr size_t OFF_WIN = OFF_PROJ + SZ_PROJ;
constexpr size_t OFF_WHG = OFF_WIN + (size_t)NPROJ * D * 2;
constexpr size_t OFF_WGD = OFF_WHG + (size_t)1024 * 512 * 2;
constexpr size_t OFF_WOUT = OFF_WGD + (size_t)1024 * 512 * 2;
constexpr size_t OFF_GBF = OFF_WOUT + (size_t)1024 * 1024 * 2;
constexpr size_t OFF_MISC = OFF_GBF + (size_t)TP * 8 * 4;
constexpr size_t OFF_QKVN = OFF_MISC + 8192;
constexpr size_t WS_END = OFF_QKVN + (size_t)TP * 1536 * 2;
constexpr size_t OFF_TMP = OFF_QKVN;
constexpr size_t OFF_XN = 0;
constexpr size_t OFF_WE1 = OFF_XN + (size_t)T * D * 2;
constexpr size_t OFF_WE2 = OFF_WE1 + (size_t)NEXP * 1024 * 1024 * 2;
constexpr size_t OFF_H = OFF_WE2 + (size_t)NEXP * 1024 * 512 * 2;
constexpr size_t OFF_Y = OFF_H + (size_t)HROWS * 512 * 2;
constexpr size_t OFF_LIST = OFF_Y + (size_t)HROWS * 1024 * 2;
constexpr size_t OFF_ASG = OFF_LIST + (size_t)NEXP * ECAP * 4;
constexpr size_t MOE_END = OFF_ASG + (size_t)T * 2 * 12;
static_assert(MOE_END <= SZ_PROJ, "moe scratch must fit in the dead proj region");
constexpr size_t MISC_LBT = 0, MISC_CNT = 4096;

__device__ __forceinline__ unsigned cvt_pk_bf16(float lo, float hi) { unsigned r; asm volatile("v_cvt_pk_bf16_f32 %0, %1, %2" : "=v"(r) : "v"(lo), "v"(hi)); return r; }
__device__ __forceinline__ float bf_lo(unsigned w) { return __uint_as_float(w << 16); }
__device__ __forceinline__ float bf_hi(unsigned w) { return __uint_as_float(w & 0xffff0000u); }
__device__ __forceinline__ float bf2f(bf16_t b) { return __uint_as_float(((unsigned)b) << 16); }
__device__ __forceinline__ bf16_t f2bf(float f) { return (bf16_t)(cvt_pk_bf16(f, 0.f) & 0xffffu); }
__device__ __forceinline__ float sigmoidf_(float x) { return 1.0f / (1.0f + __expf(-x)); }
__device__ __forceinline__ float siluf_(float x) { return x / (1.0f + __expf(-x)); }
__device__ __forceinline__ float wave_sum(float v) {
#pragma unroll
    for (int o = 32; o >= 1; o >>= 1) v += __shfl_xor(v, o);
    return v;
}
__device__ __forceinline__ int prow_of(int r) { return (r >> 13) * LP + 64 + (r & 8191); }

namespace pg8 {
constexpr int BM = 256, BK = 64, HALF = 128, HTB = HALF * BK * 2, STAGE_BYTES = 8 * HTB, NXCD = 8, WGM = 8;
__host__ __device__ __forceinline__ int lds_byte(int r, int c) { const int st = (r >> 4) * 2 + (c >> 5), rr = r & 15, cc = c & 31, ob = rr * 64 + cc * 2; return st * 1024 + (ob ^ (((ob >> 9) & 1) << 5)); }
__host__ __device__ __forceinline__ void stage_rc(int b, int& R, int& C) { const int st = b / 1024, sb = b % 1024, swz = sb ^ (((sb >> 9) & 1) << 5); R = (st >> 1) * 16 + swz / 64; C = (st & 1) * 32 + (swz % 64) / 2; }
__host__ __device__ __forceinline__ int perm32(int rho) { const int n = rho >> 4, i = rho & 15; return 8 * (i >> 2) + 4 * n + (i & 3); }

struct Unit { int pm, pn, e, t; };

struct StaticOrder {
    int nM, nN, nwg, G, c;
    __device__ void init(int M, int N, int G_, int c_) { nM = M / BM; nN = N / BM; nwg = nM * nN; G = G_; c = c_; }
    __device__ bool next(int i, Unit& u) const {
        const long L = (long)i * G + c; if (L >= nwg) return false;
        int wgid = (int)L; { const int q = nwg / NXCD, r = nwg % NXCD, xcd = wgid % NXCD, off = wgid / NXCD; wgid = (xcd < r ? xcd * (q + 1) : r * (q + 1) + (xcd - r) * q) + off; }
        const int nig = WGM * nN, gid = wgid / nig, fm = gid * WGM, gsz = (nM - fm) < WGM ? (nM - fm) : WGM;
        u.pm = fm + ((wgid % nig) % gsz); u.pn = (wgid % nig) / gsz; u.e = 0; u.t = 0; return true;
    }
};

template <class Epi, class Sched>
__device__ __forceinline__ void gemm_phase(LAS unsigned char* lds, const Sched& S, const Epi& E) {
    const int tid = threadIdx.x, wid = __builtin_amdgcn_readfirstlane(tid >> 6), lane = tid & 63, wr = wid >> 2, wc = wid & 3, fr = lane & 15, fq = lane >> 4;
    const int K = S.K, nt = K / BK;
    int Rr[2]; unsigned ccA[2], voffB[2];
#pragma unroll
    for (int i = 0; i < 2; ++i) { int R, C; stage_rc(tid * 16 + i * 8192, R, C); const int Rb = Epi::PERM ? ((R & ~31) + perm32(R & 31)) : R;
        Rr[i] = R; ccA[i] = (unsigned)C * 2u; voffB[i] = (unsigned)(Rb * K + C) * 2u; }
    const size_t kstep = (size_t)(BK * 2);
    const size_t hstepB = (size_t)HALF * K * 2;
    const unsigned ldsw = (unsigned)wid * 1024u;
    const int aoff = lds_byte(wr * 64 + fr, fq * 8), boff = lds_byte(wc * 32 + fr, fq * 8);
#define PG8_SA(b, h) (((b) * 2 + (h)) * HTB)
#define PG8_SB(b, h) ((4 + (b) * 2 + (h)) * HTB)
#define PG8_STAGE(bufoff, gbase, voff) do { _Pragma("unroll") for (int _i = 0; _i < 2; ++_i) \
        __builtin_amdgcn_global_load_lds((const unsigned*)((const char*)(gbase) + (voff)[_i]), (LAS unsigned*)(lds + (bufoff) + ldsw + _i * 8192), 16, 0, 0); } while (0)
#define PG8_LDA(dst, b, h) do { _Pragma("unroll") for (int m = 0; m < 4; ++m) _Pragma("unroll") for (int k = 0; k < 2; ++k) dst[m][k] = *(const LAS bf16x8*)(lds + PG8_SA(b, h) + aoff + m * 2048 + k * 1024); } while (0)
#define PG8_LDB(dst, b, h) do { _Pragma("unroll") for (int n = 0; n < 2; ++n) _Pragma("unroll") for (int k = 0; k < 2; ++k) dst[n][k] = *(const LAS bf16x8*)(lds + PG8_SB(b, h) + boff + n * 2048 + k * 1024); } while (0)
#define PG8_MMA(ai, bj, At, Bt) do { __builtin_amdgcn_s_setprio(1); _Pragma("unroll") for (int m = 0; m < 4; ++m) _Pragma("unroll") for (int n = 0; n < 2; ++n) _Pragma("unroll") for (int k = 0; k < 2; ++k) \
        acc[ai][bj][m][n] = __builtin_amdgcn_mfma_f32_16x16x32_bf16(Bt[n][k], At[m][k], acc[ai][bj][m][n], 0, 0, 0); __builtin_amdgcn_s_setprio(0); } while (0)
#define PG8_WAIT_V(n) asm volatile("s_waitcnt vmcnt(" #n ")" ::: "memory")
#define PG8_WAIT_L(n) asm volatile("s_waitcnt lgkmcnt(" #n ")" ::: "memory")
#define PG8_BAR __builtin_amdgcn_s_barrier()
#define PG8_SCHED __builtin_amdgcn_sched_barrier(0)
    Unit cur, nxt; int ui = 0;
    if (!S.next(0, cur)) return;
    f32x4 acc[2][2][4][2];
#pragma unroll
    for (int a = 0; a < 2; ++a)
#pragma unroll
        for (int b = 0; b < 2; ++b)
#pragma unroll
            for (int m = 0; m < 4; ++m)
#pragma unroll
                for (int n = 0; n < 2; ++n) acc[a][b][m][n] = (f32x4){0.f, 0.f, 0.f, 0.f};
    bf16x8 At[4][2], B0[2][2], B1[2][2];
    unsigned vAc[2][2], vAn[2][2];
#pragma unroll
    for (int h = 0; h < 2; ++h)
#pragma unroll
        for (int i = 0; i < 2; ++i) vAc[h][i] = S.a_off(cur, Rr[i] + HALF * h) + ccA[i];
    const char* gA = S.a_base();
    const char* cB = S.b_ptr(cur);
    PG8_STAGE(PG8_SB(0, 0), cB, voffB); PG8_STAGE(PG8_SB(0, 1), cB + hstepB, voffB); PG8_STAGE(PG8_SA(0, 0), gA, vAc[0]); PG8_STAGE(PG8_SA(0, 1), gA, vAc[1]);
    if (wr == 1) PG8_BAR;
    PG8_WAIT_V(2); PG8_BAR;
    PG8_STAGE(PG8_SB(1, 0), cB + kstep, voffB); PG8_STAGE(PG8_SA(1, 0), gA + kstep, vAc[0]); PG8_STAGE(PG8_SB(1, 1), cB + hstepB + kstep, voffB);
    PG8_WAIT_V(6); PG8_BAR;
    for (;;) {
        const bool has_next = S.next(ui + 1, nxt);
        const char* nB = has_next ? S.b_ptr(nxt) : cB;
#pragma unroll
        for (int h = 0; h < 2; ++h)
#pragma unroll
            for (int i = 0; i < 2; ++i) vAn[h][i] = has_next ? (S.a_off(nxt, Rr[i] + HALF * h) + ccA[i]) : vAc[h][i];
        for (int t = 0; t < nt; t += 2) {
            const bool last = (t == nt - 2);
            const char* a1 = gA + (size_t)(t + 1) * kstep;
            const char* a2 = last ? gA : gA + (size_t)(t + 2) * kstep; const char* b2 = last ? nB : cB + (size_t)(t + 2) * kstep;
            const char* a3 = a2 + kstep; const char* b3 = b2 + kstep;
            unsigned w0[2], w1[2];
#pragma unroll
            for (int i = 0; i < 2; ++i) { w0[i] = last ? vAn[0][i] : vAc[0][i]; w1[i] = last ? vAn[1][i] : vAc[1][i]; }
            PG8_LDB(B0, 0, 0); PG8_LDB(B1, 0, 1); PG8_SCHED; PG8_LDA(At, 0, 0); PG8_STAGE(PG8_SA(1, 1), a1, vAc[1]);
            PG8_WAIT_V(8); PG8_WAIT_L(0); PG8_BAR; PG8_MMA(0, 0, At, B0); PG8_MMA(0, 1, At, B1); PG8_BAR; PG8_SCHED;
            PG8_LDA(At, 0, 1); PG8_STAGE(PG8_SB(0, 0), b2, voffB); PG8_STAGE(PG8_SB(0, 1), b2 + hstepB, voffB); PG8_STAGE(PG8_SA(0, 0), a2, w0);
            PG8_WAIT_V(8); PG8_WAIT_L(0); PG8_BAR; PG8_MMA(1, 0, At, B0); PG8_MMA(1, 1, At, B1); PG8_BAR; PG8_SCHED;
            PG8_LDB(B0, 1, 0); PG8_LDB(B1, 1, 1); PG8_SCHED; PG8_LDA(At, 1, 0); PG8_STAGE(PG8_SA(0, 1), a2, w1);
            PG8_WAIT_V(8); PG8_WAIT_L(0); PG8_BAR; PG8_MMA(0, 0, At, B0); PG8_MMA(0, 1, At, B1); PG8_BAR; PG8_SCHED;
            PG8_LDA(At, 1, 1); PG8_STAGE(PG8_SB(1, 0), b3, voffB); PG8_STAGE(PG8_SB(1, 1), b3 + hstepB, voffB); PG8_STAGE(PG8_SA(1, 0), a3, w0);
            PG8_WAIT_V(8); PG8_WAIT_L(0); PG8_BAR; PG8_MMA(1, 0, At, B0); PG8_MMA(1, 1, At, B1); PG8_BAR; PG8_SCHED;
        }
        if (wr == 0) PG8_BAR;
        E(acc, cur, wr, wc, fr, fq);
        if (!has_next) break;
#pragma unroll
        for (int a = 0; a < 2; ++a)
#pragma unroll
            for (int b = 0; b < 2; ++b)
#pragma unroll
                for (int m = 0; m < 4; ++m)
#pragma unroll
                    for (int n = 0; n < 2; ++n) acc[a][b][m][n] = (f32x4){0.f, 0.f, 0.f, 0.f};
        cur = nxt; cB = nB; ++ui;
#pragma unroll
        for (int h = 0; h < 2; ++h)
#pragma unroll
            for (int i = 0; i < 2; ++i) vAc[h][i] = vAn[h][i];
        if (wr == 1) PG8_BAR;
    }
    PG8_WAIT_V(0);
    PG8_BAR;
#undef PG8_SA
#undef PG8_SB
#undef PG8_STAGE
#undef PG8_LDA
#undef PG8_LDB
#undef PG8_MMA
#undef PG8_WAIT_V
#undef PG8_WAIT_L
#undef PG8_BAR
#undef PG8_SCHED
}
}

struct SchedDense {
    pg8::StaticOrder so; const char* A; unsigned lda2; int K; const char* Bt; int rowmap;
    __device__ bool next(int i, pg8::Unit& u) const { return so.next(i, u); }
    __device__ const char* a_base() const { return A; }
    __device__ unsigned a_off(const pg8::Unit& u, int r) const { const int row = u.pm * 256 + r; return (unsigned)(rowmap ? prow_of(row) : row) * lda2; }
    __device__ const char* b_ptr(const pg8::Unit& u) const { return Bt + (size_t)u.pn * 256 * K * 2; }
};
struct SchedMoe {
    const int* cnt; const int* list; LAS const int* pref;
    const char* A; unsigned lda2; int K; const char* Bt; size_t bstride; int gather; int G, c;
    __device__ bool next(int i, pg8::Unit& u) const {
        const int L = i * G + c; const int total = pref[NEXP] * 4; if (L >= total) return false;
        int e = 0;
#pragma unroll 1
        for (int j = 1; j < NEXP; ++j) if (L >= pref[j] * 4) e = j;
        const int q = L - pref[e] * 4, nte = pref[e + 1] - pref[e];
        u.e = e; u.pn = q / nte; u.t = q % nte; u.pm = pref[e] + u.t; return true;
    }
    __device__ const char* a_base() const { return A; }
    __device__ unsigned a_off(const pg8::Unit& u, int r) const {
        if (gather) { const int p = u.t * 256 + r; const int n = cnt[u.e]; const int tok = p < n ? list[u.e * ECAP + p] : 0; return (unsigned)tok * lda2; }
        return (unsigned)(u.pm * 256 + r) * lda2;
    }
    __device__ const char* b_ptr(const pg8::Unit& u) const { return Bt + (size_t)u.e * bstride + (size_t)u.pn * 256 * K * 2; }
};

struct EpiProj {
    static constexpr bool PERM = true;
    bf16_t* proj; const float* lbt;
    __device__ __forceinline__ void operator()(const f32x4 (&acc)[2][2][4][2], const pg8::Unit& u, int wr, int wc, int fr, int fq) const {
        const int seg = u.pn >> 1;
        const int row0 = prow_of(u.pm * 256) + wr * 64 + fr, col0 = u.pn * 256 + wc * 32 + 8 * fq;
        const int mode = (seg == 0 || seg == 3 || seg == 7) ? 1 : (seg == 1 ? 2 : 0);
        float lb[2][8];
#pragma unroll
        for (int bj = 0; bj < 2; ++bj)
#pragma unroll
            for (int j = 0; j < 8; ++j) lb[bj][j] = (mode == 2) ? lbt[col0 + bj * 128 + j - C_LF] : 0.f;
#pragma unroll
        for (int ai = 0; ai < 2; ++ai)
#pragma unroll
            for (int m = 0; m < 4; ++m) { bf16_t* rowp = proj + (size_t)(row0 + ai * 128 + m * 16) * NPROJ + col0;
#pragma unroll
                for (int bj = 0; bj < 2; ++bj) { float v[8];
#pragma unroll
                    for (int j = 0; j < 4; ++j) { v[j] = acc[ai][bj][m][0][j]; v[4 + j] = acc[ai][bj][m][1][j]; }
                    if (mode == 1) {
#pragma unroll
                        for (int j = 0; j < 8; ++j) v[j] = siluf_(v[j]);
                    } else if (mode == 2) {
#pragma unroll
                        for (int j = 0; j < 8; ++j) v[j] = __logf(lb[bj][j] + (1.0f - lb[bj][j]) * sigmoidf_(v[j]));
                    }
                    u32x4 w; w.x = cvt_pk_bf16(v[0], v[1]); w.y = cvt_pk_bf16(v[2], v[3]); w.z = cvt_pk_bf16(v[4], v[5]); w.w = cvt_pk_bf16(v[6], v[7]);
                    *(u32x4*)(rowp + bj * 128) = w; } }
    }
};
template <int SECOND> struct EpiGate {
    static constexpr bool PERM = true;
    const bf16_t* proj; bf16_t* tmp;
    __device__ __forceinline__ void operator()(const f32x4 (&acc)[2][2][4][2], const pg8::Unit& u, int wr, int wc, int fr, int fq) const {
        const int prow0 = prow_of(u.pm * 256) + wr * 64 + fr, row0 = u.pm * 256 + wr * 64 + fr, col0 = u.pn * 256 + wc * 32 + 8 * fq;
#pragma unroll
        for (int ai = 0; ai < 2; ++ai)
#pragma unroll
            for (int m = 0; m < 4; ++m) {
                const bf16_t* gp = proj + (size_t)(prow0 + ai * 128 + m * 16) * NPROJ + (SECOND ? C_PB : C_PA) + col0;
                bf16_t* tp = tmp + (size_t)(row0 + ai * 128 + m * 16) * D + col0;
#pragma unroll
                for (int bj = 0; bj < 2; ++bj) {
                    const u32x4 g = *(const u32x4*)(gp + bj * 128);
                    float v[8];
#pragma unroll
                    for (int j = 0; j < 4; ++j) { v[j] = acc[ai][bj][m][0][j]; v[4 + j] = acc[ai][bj][m][1][j]; }
                    const float gg[8] = {bf_lo(g.x), bf_hi(g.x), bf_lo(g.y), bf_hi(g.y), bf_lo(g.z), bf_hi(g.z), bf_lo(g.w), bf_hi(g.w)};
#pragma unroll
                    for (int j = 0; j < 8; ++j) v[j] *= sigmoidf_(gg[j]);
                    if (SECOND) { const u32x4 o = *(const u32x4*)(tp + bj * 128);
                        const float oo[8] = {bf_lo(o.x), bf_hi(o.x), bf_lo(o.y), bf_hi(o.y), bf_lo(o.z), bf_hi(o.z), bf_lo(o.w), bf_hi(o.w)};
#pragma unroll
                        for (int j = 0; j < 8; ++j) v[j] += oo[j]; }
                    u32x4 w; w.x = cvt_pk_bf16(v[0], v[1]); w.y = cvt_pk_bf16(v[2], v[3]); w.z = cvt_pk_bf16(v[4], v[5]); w.w = cvt_pk_bf16(v[6], v[7]);
                    *(u32x4*)(tp + bj * 128) = w; }
                asm volatile("" ::: "memory"); }
    }
};
struct EpiResid {
    static constexpr bool PERM = false;
    const float* x; float* h1;
    __device__ __forceinline__ void operator()(const f32x4 (&acc)[2][2][4][2], const pg8::Unit& u, int wr, int wc, int fr, int fq) const {
        const int row0 = u.pm * 256 + wr * 64 + fr, col0 = u.pn * 256 + wc * 32 + 4 * fq;
#pragma unroll
        for (int ai = 0; ai < 2; ++ai)
#pragma unroll
            for (int m = 0; m < 4; ++m) { const size_t off = (size_t)(row0 + ai * 128 + m * 16) * D + col0;
#pragma unroll
                for (int bj = 0; bj < 2; ++bj)
#pragma unroll
                    for (int n = 0; n < 2; ++n) { const f32x4 xv = *(const f32x4*)(x + off + bj * 128 + n * 16); *(f32x4*)(h1 + off + bj * 128 + n * 16) = xv + acc[ai][bj][m][n]; }
                asm volatile("" ::: "memory"); }
    }
};
struct EpiSwiglu {
    static constexpr bool PERM = false;
    bf16_t* H;
    __device__ __forceinline__ void operator()(const f32x4 (&acc)[2][2][4][2], const pg8::Unit& u, int wr, int wc, int fr, int fq) const {
        const int row0 = u.pm * 256 + wr * 64 + fr, col0 = u.pn * 128 + wc * 16 + 4 * fq;
#pragma unroll
        for (int ai = 0; ai < 2; ++ai)
#pragma unroll
            for (int m = 0; m < 4; ++m) { bf16_t* rowp = H + (size_t)(row0 + ai * 128 + m * 16) * 512 + col0;
#pragma unroll
                for (int bj = 0; bj < 2; ++bj) { const f32x4 g = acc[ai][bj][m][0], up = acc[ai][bj][m][1];
                    u32x2 w; w.x = cvt_pk_bf16(siluf_(g[0]) * up[0], siluf_(g[1]) * up[1]); w.y = cvt_pk_bf16(siluf_(g[2]) * up[2], siluf_(g[3]) * up[3]);
                    *(u32x2*)(rowp + bj * 64) = w; } }
    }
};
struct EpiY {
    static constexpr bool PERM = true;
    bf16_t* Y;
    __device__ __forceinline__ void operator()(const f32x4 (&acc)[2][2][4][2], const pg8::Unit& u, int wr, int wc, int fr, int fq) const {
        const int row0 = u.pm * 256 + wr * 64 + fr, col0 = u.pn * 256 + wc * 32 + 8 * fq;
#pragma unroll
        for (int ai = 0; ai < 2; ++ai)
#pragma unroll
            for (int m = 0; m < 4; ++m) { bf16_t* rowp = Y + (size_t)(row0 + ai * 128 + m * 16) * D + col0;
#pragma unroll
                for (int bj = 0; bj < 2; ++bj) { const f32x4 a = acc[ai][bj][m][0], b = acc[ai][bj][m][1];
                    u32x4 w; w.x = cvt_pk_bf16(a[0], a[1]); w.y = cvt_pk_bf16(a[2], a[3]); w.z = cvt_pk_bf16(b[0], b[1]); w.w = cvt_pk_bf16(b[2], b[3]);
                    *(u32x4*)(rowp + bj * 128) = w; } }
    }
};


constexpr int LDS_BYTES = 150 * 1024;
constexpr int NTHR = 512;
struct Args {
    const float* in[22]; float* out; char* ws; int ph_lo, ph_hi;
};

__device__ __forceinline__ void tr_tile(LAS float* tile  , const float* colp_base, int mode, const float* a, const float* b, int ld, int k0, int n0, bf16_t* dst, int K) {
    const int tid = threadIdx.x, tx = tid & 63, ty = tid >> 6;
    const int n = n0 + tx;
    const float* colp;
    if (mode == 0) colp = a + (n < 4096 ? n : n + 8);
    else if (mode == 1) colp = a + n;
    else { const int grp = n >> 5, w = n & 31; colp = (w < 16 ? a : b) + grp * 16 + (w & 15); }
    __syncthreads();
#pragma unroll
    for (int i = 0; i < 8; ++i) tile[(ty + 8 * i) * 65 + tx] = colp[(size_t)(k0 + ty + 8 * i) * ld];
    __syncthreads();
    const int ni = tid >> 3, kq = (tid & 7) * 8;
    unsigned w[4];
#pragma unroll
    for (int j = 0; j < 4; ++j) w[j] = cvt_pk_bf16(tile[(kq + 2 * j) * 65 + ni], tile[(kq + 2 * j + 1) * 65 + ni]);
    *(u32x4*)(dst + (size_t)(n0 + ni) * K + k0 + kq) = (u32x4){w[0], w[1], w[2], w[3]};
}
struct TrJob { const float* s0; const float* s1; bf16_t* dst; int mode, K, ld, ndst, nb; size_t sbatch, dbatch; };
__device__ __forceinline__ void run_tr(LAS unsigned char* lds, const TrJob& j) {
    const int tk = j.K / 64, tn = j.ndst / 64, per = tk * tn, total = per * j.nb;
    for (int t = blockIdx.x; t < total; t += gridDim.x) {
        const int e = t / per, r = t % per, kt = r % tk, ntile = r / tk;
        tr_tile((LAS float*)lds, nullptr, j.mode, j.s0 + (size_t)e * j.sbatch, j.s1 ? j.s1 + (size_t)e * j.sbatch : nullptr, j.ld, kt * 64, ntile * 64, j.dst + (size_t)e * j.dbatch, j.K);
    }
    __syncthreads();
}
__device__ __forceinline__ float softplusf_(float x) { return x > 20.f ? x : log1pf(__expf(x)); }

__device__ __forceinline__ void p0_prep_x(LAS unsigned char* lds, const float* x, const float* g1, const float* w_in, const float* A_log, const float* dt_bias, bf16_t* xb, float* gbf) {
    LAS float* w8 = (LAS float*)lds;
    __syncthreads();
    for (int i = threadIdx.x; i < 8192; i += NTHR) { const int j = i >> 10, k = i & 1023; w8[i] = w_in[(size_t)k * WIN_LD + 4096 + j]; }
    __syncthreads();
    const int wv = threadIdx.x >> 6, l = threadIdx.x & 63;
    for (int row = blockIdx.x * 8 + wv; row < T; row += gridDim.x * 8) {
        const f32x4* xr = (const f32x4*)(x + (size_t)row * D);
        f32x4 v[4]; float ss = 0.f;
#pragma unroll
        for (int i = 0; i < 4; ++i) { v[i] = xr[l + 64 * i]; ss += v[i][0] * v[i][0] + v[i][1] * v[i][1] + v[i][2] * v[i][2] + v[i][3] * v[i][3]; }
        ss = wave_sum(ss);
        const float rstd = rsqrtf(ss * (1.0f / D) + EPS);
        float acc[8] = {0.f, 0.f, 0.f, 0.f, 0.f, 0.f, 0.f, 0.f};
#pragma unroll
        for (int i = 0; i < 4; ++i) { const f32x4 gv = ((const f32x4*)g1)[l + 64 * i]; v[i] = v[i] * rstd * gv;
            u32x2 w; w.x = cvt_pk_bf16(v[i][0], v[i][1]); w.y = cvt_pk_bf16(v[i][2], v[i][3]);
            *(u32x2*)(xb + (size_t)row * D + 4 * (l + 64 * i)) = w;
#pragma unroll
            for (int j = 0; j < 8; ++j) { const f32x4 wj = *(const LAS f32x4*)&w8[j * 1024 + 4 * (l + 64 * i)]; acc[j] += v[i][0] * wj[0] + v[i][1] * wj[1] + v[i][2] * wj[2] + v[i][3] * wj[3]; } }
#pragma unroll
        for (int j = 0; j < 8; ++j) acc[j] = wave_sum(acc[j]);
        if (l == 0) { float* o = gbf + (size_t)prow_of(row) * 8;
#pragma unroll
            for (int j = 0; j < 4; ++j) o[j] = sigmoidf_(acc[j]);
#pragma unroll
            for (int j = 0; j < 4; ++j) o[4 + j] = -__expf(A_log[j]) * softplusf_(acc[4 + j] + dt_bias[j]); }
    }
    __syncthreads();
}
__device__ __forceinline__ void p0_meta(LAS unsigned char* lds, const float* meta, const float* g1, const float* w_in, const float* lbl, const float* A_log, const float* dt_bias, bf16_t* proj, float* gbf) {
    LAS float* hn = (LAS float*)lds;
    const int wv = threadIdx.x >> 6, l = threadIdx.x & 63;
    if (blockIdx.x < 13) {
        __syncthreads();
        for (int r = wv; r < 16; r += 8) {
            const f32x4* xr = (const f32x4*)(meta + (size_t)r * D);
            f32x4 v[4]; float ss = 0.f;
#pragma unroll
            for (int i = 0; i < 4; ++i) { v[i] = xr[l + 64 * i]; ss += v[i][0] * v[i][0] + v[i][1] * v[i][1] + v[i][2] * v[i][2] + v[i][3] * v[i][3]; }
            ss = wave_sum(ss);
            const float rstd = rsqrtf(ss * (1.0f / D) + EPS);
#pragma unroll
            for (int i = 0; i < 4; ++i) { const f32x4 gv = ((const f32x4*)g1)[l + 64 * i];
#pragma unroll
                for (int c = 0; c < 4; ++c) hn[(4 * (l + 64 * i) + c) * 16 + r] = v[i][c] * rstd * gv[c]; }
        }
        __syncthreads();
        const int n = blockIdx.x * NTHR + threadIdx.x;
        if (n < WIN_LD) {
            float acc[16];
#pragma unroll
            for (int i = 0; i < 16; ++i) acc[i] = 0.f;
            for (int k = 0; k < 1024; ++k) { const float w = w_in[(size_t)k * WIN_LD + n];
#pragma unroll
                for (int i4 = 0; i4 < 4; ++i4) { const f32x4 h = *(const LAS f32x4*)&hn[k * 16 + 4 * i4]; acc[4 * i4] += w * h[0]; acc[4 * i4 + 1] += w * h[1]; acc[4 * i4 + 2] += w * h[2]; acc[4 * i4 + 3] += w * h[3]; } }
            if (n < 4096 || n >= 4104) {
                const int pc = n < 4096 ? n : n - 8, seg = pc >> 9;
                float lb = 0.f;
                if (seg == 1) { const float a = lbl[pc - C_LF], b = lbl[512 + pc - C_LF]; const float m = fmaxf(a, b); const float ea = __expf(a - m), eb = __expf(b - m); lb = ea / (ea + eb); }
#pragma unroll
                for (int i = 0; i < 16; ++i) { float v = acc[i];
                    if (seg == 0 || seg == 3 || seg == 7) v = siluf_(v); else if (seg == 1) v = __logf(lb + (1.0f - lb) * sigmoidf_(v));
                    const bf16_t o = f2bf(v);
                    for (int b = 0; b < NB; ++b) proj[(size_t)(b * LP + 48 + i) * NPROJ + pc] = o; }
            } else {
                const int j = n - 4096;
#pragma unroll
                for (int i = 0; i < 16; ++i) { const float v = j < 4 ? sigmoidf_(acc[i]) : -__expf(A_log[j - 4]) * softplusf_(acc[i] + dt_bias[j - 4]);
                    for (int b = 0; b < NB; ++b) gbf[(size_t)(b * LP + 48 + i) * 8 + j] = v; }
            }
        }
        __syncthreads();
    }
    for (size_t i = (size_t)blockIdx.x * NTHR + threadIdx.x; i < (size_t)NB * 48 * (NPROJ / 8); i += (size_t)gridDim.x * NTHR) {
        const int b = (int)(i / (48 * (NPROJ / 8))), rem = (int)(i % (48 * (NPROJ / 8))), r = rem / (NPROJ / 8), c8 = rem % (NPROJ / 8);
        *(u32x4*)(proj + (size_t)(b * LP + r) * NPROJ + c8 * 8) = (u32x4){0u, 0u, 0u, 0u};
    }
    for (int i = blockIdx.x * NTHR + threadIdx.x; i < NB * 48 * 8; i += gridDim.x * NTHR) { const int b = i / (48 * 8), rem = i % (48 * 8); gbf[(size_t)(b * LP) * 8 + rem] = 0.f; }
}

__device__ __forceinline__ void p_conv(const bf16_t* proj, const float* cw, bf16_t* qkvn) {
    const int wv = threadIdx.x >> 6, l = threadIdx.x & 63;
    for (int row = blockIdx.x * 8 + wv; row < TP; row += gridDim.x * 8) {
        const int b = row / LP, p = row % LP;
        for (int sec = 0; sec < 12; ++sec) {
            const int ch = sec * 128 + 2 * l;
            float a0 = 0.f, a1 = 0.f;
#pragma unroll
            for (int j = 0; j < 4; ++j) { const int pp = p - 3 + j;
                if (pp >= 48) { const unsigned xw = *(const unsigned*)(proj + (size_t)(b * LP + pp) * NPROJ + C_GQ + ch); a0 += cw[j * 1536 + ch] * bf_lo(xw); a1 += cw[j * 1536 + ch + 1] * bf_hi(xw); } }
            float y0 = siluf_(a0), y1 = siluf_(a1);
            if (sec < 8) { const float ss = wave_sum(y0 * y0 + y1 * y1); const float sc = rsqrtf(ss + EPS) * (sec < 4 ? 0.08838834764831845f : 1.0f); y0 *= sc; y1 *= sc; }
            *(unsigned*)(qkvn + (size_t)row * 1536 + ch) = cvt_pk_bf16(y0, y1);
        }
    }
}
__device__ __forceinline__ void p_rec_naive(LAS unsigned char* lds, bf16_t* proj, const bf16_t* qkvn, const float* gbf, const float* hg_norm_g, const float* gd_norm_g) {
    if (blockIdx.x >= 32) return;
    LAS float* qs = (LAS float*)lds; LAS float* fs = qs + 32 * 128; LAS float* vs = fs + 32 * 128; LAS float* as_ = vs + 32 * 128; LAS float* bs_ = as_ + 32;
    const int br = blockIdx.x >> 4, b = (blockIdx.x >> 2) & 3, h = blockIdx.x & 3, tid = threadIdx.x, wv = tid >> 6, l = tid & 63;
    const int vcol = (tid >> 1) & 127, kh = (tid & 1) * 64;
    const bool act = tid < 256;
    float S[64];
#pragma unroll
    for (int k = 0; k < 64; ++k) S[k] = 0.f;
    const float* gn = br == 0 ? hg_norm_g : gd_norm_g;
    const float gn0 = gn[l], gn1 = gn[l + 64];
    for (int blk = 1; blk < LP / 32; ++blk) {
        const int r0 = b * LP + blk * 32;
        __syncthreads();
        for (int e = tid; e < 32 * 128; e += NTHR) { const int i = e >> 7, c = e & 127;
            if (br == 0) { const bf16_t* rp = proj + (size_t)(r0 + i) * NPROJ + h * 128 + c; qs[e] = bf2f(rp[C_QA]); fs[e] = __expf(bf2f(rp[C_LF])); vs[e] = bf2f(rp[C_VA]); }
            else { const bf16_t* rp = qkvn + (size_t)(r0 + i) * 1536 + h * 128 + c; qs[e] = bf2f(rp[0]); fs[e] = bf2f(rp[512]); vs[e] = bf2f(rp[1024]); } }
        if (br == 1 && tid < 32) { bs_[tid] = gbf[(size_t)(r0 + tid) * 8 + h]; as_[tid] = __expf(gbf[(size_t)(r0 + tid) * 8 + 4 + h]); }
        __syncthreads();
        if (act) {
            for (int i = 0; i < 32; ++i) {
                const float vown = vs[i * 128 + vcol]; float o = 0.f;
                if (br == 0) {
#pragma unroll
                    for (int k = 0; k < 64; k += 4) { const f32x4 f4 = *(const LAS f32x4*)&fs[i * 128 + kh + k], q4 = *(const LAS f32x4*)&qs[i * 128 + kh + k];
#pragma unroll
                        for (int c = 0; c < 4; ++c) { S[k + c] = f4[c] * S[k + c] + (1.0f - f4[c]) * vown; o += S[k + c] * q4[c]; } }
                } else {
                    const float a = as_[i], be = bs_[i]; float kS = 0.f;
#pragma unroll
                    for (int k = 0; k < 64; k += 4) { const f32x4 k4 = *(const LAS f32x4*)&fs[i * 128 + kh + k];
#pragma unroll
                        for (int c = 0; c < 4; ++c) kS += k4[c] * S[k + c]; }
                    kS += __shfl_xor(kS, 1);
                    const float coef = be * (vown - a * kS);
#pragma unroll
                    for (int k = 0; k < 64; k += 4) { const f32x4 k4 = *(const LAS f32x4*)&fs[i * 128 + kh + k], q4 = *(const LAS f32x4*)&qs[i * 128 + kh + k];
#pragma unroll
                        for (int c = 0; c < 4; ++c) { S[k + c] = a * S[k + c] + k4[c] * coef; o += S[k + c] * q4[c]; } }
                }
                o += __shfl_xor(o, 1);
                if ((tid & 1) == 0) vs[i * 128 + vcol] = o;
            }
        }
        __syncthreads();
        for (int i = wv; i < 32; i += 8) {
            const float a = vs[i * 128 + l], c = vs[i * 128 + l + 64];
            const float ss = wave_sum(a * a + c * c);
            const float rstd = rsqrtf(ss * (1.0f / 128.0f) + EPS);
            bf16_t* rp = proj + (size_t)(r0 + i) * NPROJ + h * 128;
            const int cgc = br == 0 ? C_HG : C_GZ, co = br == 0 ? C_QA : C_GQ;
            const float g0 = bf2f(rp[cgc + l]), g1v = bf2f(rp[cgc + l + 64]);
            rp[co + l] = f2bf(a * rstd * gn0 * g0); rp[co + l + 64] = f2bf(c * rstd * gn1 * g1v);
        }
    }
    __syncthreads();
}

__device__ __forceinline__ void p_router(LAS unsigned char* lds, const float* h1, const float* g2, const float* rgw, const float* rgb, const float* rew, const float* reb, bf16_t* xn, int* cnt, int* list, int* asg) {
    LAS float* wrt = (LAS float*)lds;
    __syncthreads();
    for (int i = threadIdx.x; i < 36 * 1024; i += NTHR) { const int c = i >> 10, k = i & 1023; wrt[i] = c < 4 ? rgw[k * 4 + c] : rew[k * 32 + (c - 4)]; }
    __syncthreads();
    const int wv = threadIdx.x >> 6, l = threadIdx.x & 63;
    for (int row = blockIdx.x * 8 + wv; row < T; row += gridDim.x * 8) {
        const f32x4* xr = (const f32x4*)(h1 + (size_t)row * D);
        f32x4 v[4]; float ss = 0.f;
#pragma unroll
        for (int i = 0; i < 4; ++i) { v[i] = xr[l + 64 * i]; ss += v[i][0] * v[i][0] + v[i][1] * v[i][1] + v[i][2] * v[i][2] + v[i][3] * v[i][3]; }
        ss = wave_sum(ss);
        const float rstd = rsqrtf(ss * (1.0f / D) + EPS);
#pragma unroll
        for (int i = 0; i < 4; ++i) { const f32x4 gv = ((const f32x4*)g2)[l + 64 * i]; v[i] = v[i] * rstd * gv;
            u32x2 w; w.x = cvt_pk_bf16(v[i][0], v[i][1]); w.y = cvt_pk_bf16(v[i][2], v[i][3]);
            *(u32x2*)(xn + (size_t)row * D + 4 * (l + 64 * i)) = w; }
        float gl[4];
#pragma unroll
        for (int c = 0; c < 4; ++c) { float p = 0.f;
#pragma unroll
            for (int i = 0; i < 4; ++i) { const f32x4 wj = *(const LAS f32x4*)&wrt[c * 1024 + 4 * (l + 64 * i)]; p += v[i][0] * wj[0] + v[i][1] * wj[1] + v[i][2] * wj[2] + v[i][3] * wj[3]; }
            gl[c] = wave_sum(p) + rgb[c]; }
        int grp = 0; float gm = gl[0];
#pragma unroll
        for (int i = 1; i < 4; ++i) if (gl[i] > gm) { gm = gl[i]; grp = i; }
        float gs = 0.f;
#pragma unroll
        for (int i = 0; i < 4; ++i) gs += __expf(gl[i] - gm);
        const float pg = 1.0f / gs;
        float el[8];
#pragma unroll
        for (int j = 0; j < 8; ++j) { float p = 0.f; const LAS float* wc_ = wrt + (4 + grp * 8 + j) * 1024;
#pragma unroll
            for (int i = 0; i < 4; ++i) { const f32x4 wj = *(const LAS f32x4*)&wc_[4 * (l + 64 * i)]; p += v[i][0] * wj[0] + v[i][1] * wj[1] + v[i][2] * wj[2] + v[i][3] * wj[3]; }
            el[j] = wave_sum(p) + reb[grp * 8 + j]; }
        if (l == 0) {
            int i1 = 0; float m1 = el[0];
#pragma unroll
            for (int j = 1; j < 8; ++j) if (el[j] > m1) { m1 = el[j]; i1 = j; }
            int i2 = -1; float m2 = -3.0e38f;
#pragma unroll
            for (int j = 0; j < 8; ++j) if (j != i1 && el[j] > m2) { m2 = el[j]; i2 = j; }
            const float p2 = __expf(m2 - m1);
            const float w1 = pg / (1.0f + p2), w2 = pg * p2 / (1.0f + p2);
            const int e1 = grp * 8 + i1, e2 = grp * 8 + i2;
            const int pos1 = atomicAdd(&cnt[e1], 1), pos2 = atomicAdd(&cnt[e2], 1);
            list[e1 * ECAP + pos1] = row; list[e2 * ECAP + pos2] = row;
            int* a = asg + (size_t)row * 6;
            a[0] = e1; a[1] = pos1; a[2] = __float_as_int(w1); a[3] = e2; a[4] = pos2; a[5] = __float_as_int(w2);
        }
    }
    __syncthreads();
}
__device__ __forceinline__ void p_final(LAS unsigned char* lds, float* h1, const bf16_t* Y, const int* cnt, const int* asg, const float* gf) {
    LAS int* offr = (LAS int*)lds;
    __syncthreads();
    if (threadIdx.x == 0) { int s = 0; for (int e = 0; e < NEXP; ++e) { offr[e] = s * 256; s += (cnt[e] + 255) >> 8; } }
    __syncthreads();
    const int wv = threadIdx.x >> 6, l = threadIdx.x & 63;
    for (int row = blockIdx.x * 8 + wv; row < T; row += gridDim.x * 8) {
        const int* a = asg + (size_t)row * 6;
        const int s1 = offr[a[0]] + a[1], s2 = offr[a[3]] + a[4]; const float w1 = __int_as_float(a[2]), w2 = __int_as_float(a[5]);
        f32x4* xr = (f32x4*)(h1 + (size_t)row * D);
        f32x4 v[4]; float ss = 0.f;
#pragma unroll
        for (int i = 0; i < 4; ++i) { v[i] = xr[l + 64 * i];
            const u32x2 y1 = *(const u32x2*)(Y + (size_t)s1 * D + 4 * (l + 64 * i)), y2 = *(const u32x2*)(Y + (size_t)s2 * D + 4 * (l + 64 * i));
            v[i][0] += w1 * bf_lo(y1.x) + w2 * bf_lo(y2.x); v[i][1] += w1 * bf_hi(y1.x) + w2 * bf_hi(y2.x);
            v[i][2] += w1 * bf_lo(y1.y) + w2 * bf_lo(y2.y); v[i][3] += w1 * bf_hi(y1.y) + w2 * bf_hi(y2.y);
            ss += v[i][0] * v[i][0] + v[i][1] * v[i][1] + v[i][2] * v[i][2] + v[i][3] * v[i][3]; }
        ss = wave_sum(ss);
        const float rstd = rsqrtf(ss * (1.0f / D) + EPS);
#pragma unroll
        for (int i = 0; i < 4; ++i) { const f32x4 gv = ((const f32x4*)gf)[l + 64 * i]; xr[l + 64 * i] = v[i] * rstd * gv; }
    }
}

__device__ __forceinline__ void run_dense(LAS unsigned char* lds, const char* A, unsigned lda2, int K, const char* Bt, int M, int N, int rowmap, int mode, void* o0, const void* i0) {
    SchedDense S; S.so.init(M, N, (int)gridDim.x, (int)blockIdx.x); S.A = A; S.lda2 = lda2; S.K = K; S.Bt = Bt; S.rowmap = rowmap;
    if (mode == 0) { EpiProj E{(bf16_t*)o0, (const float*)i0}; pg8::gemm_phase<EpiProj, SchedDense>(lds, S, E); }
    else if (mode == 1) { EpiGate<0> E{(const bf16_t*)i0, (bf16_t*)o0}; pg8::gemm_phase<EpiGate<0>, SchedDense>(lds, S, E); }
    else if (mode == 2) { EpiGate<1> E{(const bf16_t*)i0, (bf16_t*)o0}; pg8::gemm_phase<EpiGate<1>, SchedDense>(lds, S, E); }
    else { EpiResid E{(const float*)i0, (float*)o0}; pg8::gemm_phase<EpiResid, SchedDense>(lds, S, E); }
}
__device__ __forceinline__ void run_moe(LAS unsigned char* lds, const char* A, unsigned lda2, int K, const char* Bt, size_t bstride, const int* cnt, const int* list, int mode, void* out) {
    LAS int* pref = (LAS int*)(lds + pg8::STAGE_BYTES);
    __syncthreads();
    if (threadIdx.x == 0) { int s = 0; for (int e = 0; e < NEXP; ++e) { pref[e] = s; s += (cnt[e] + 255) >> 8; } pref[NEXP] = s; }
    __syncthreads();
    SchedMoe S; S.cnt = cnt; S.list = list; S.pref = pref; S.A = A; S.lda2 = lda2; S.K = K; S.Bt = Bt; S.bstride = bstride; S.gather = (mode == 0); S.G = (int)gridDim.x; S.c = (int)blockIdx.x;
    if (mode == 0) { EpiSwiglu E{(bf16_t*)out}; pg8::gemm_phase<EpiSwiglu, SchedMoe>(lds, S, E); }
    else { EpiY E{(bf16_t*)out}; pg8::gemm_phase<EpiY, SchedMoe>(lds, S, E); }
}

__global__ void __launch_bounds__(NTHR, 2) mega(Args a) {
    extern __shared__ __attribute__((aligned(16))) unsigned char shm[];
    LAS unsigned char* lds = (LAS unsigned char*)shm;
    cg::grid_group grid = cg::this_grid();
    const float* x = a.in[0]; const float* meta = a.in[1]; const float* lbl = a.in[2]; const float* g1 = a.in[3];
    const float* w_in = a.in[4]; const float* convw = a.in[5]; const float* A_log = a.in[6]; const float* dt_bias = a.in[7];
    const float* hg_ng = a.in[8]; const float* gd_ng = a.in[9]; const float* hg_up = a.in[10]; const float* gd_up = a.in[11];
    const float* w_out = a.in[12]; const float* g2 = a.in[13]; const float* rgw = a.in[14]; const float* rgb = a.in[15];
    const float* rew = a.in[16]; const float* reb = a.in[17]; const float* w_gate = a.in[18]; const float* w_up = a.in[19];
    const float* w_down = a.in[20]; const float* gf = a.in[21];
    char* ws = a.ws; float* out = a.out;
    bf16_t* proj = (bf16_t*)(ws + OFF_PROJ); bf16_t* Win = (bf16_t*)(ws + OFF_WIN); bf16_t* Whg = (bf16_t*)(ws + OFF_WHG); bf16_t* Wgd = (bf16_t*)(ws + OFF_WGD); bf16_t* Wout = (bf16_t*)(ws + OFF_WOUT);
    float* gbf = (float*)(ws + OFF_GBF); float* lbt = (float*)(ws + OFF_MISC + MISC_LBT); int* cnt = (int*)(ws + OFF_MISC + MISC_CNT);
    bf16_t* qkvn = (bf16_t*)(ws + OFF_QKVN); bf16_t* tmp = (bf16_t*)(ws + OFF_TMP);
    bf16_t* xb = (bf16_t*)a.out;
    bf16_t* xn = (bf16_t*)(ws + OFF_XN); bf16_t* We1 = (bf16_t*)(ws + OFF_WE1); bf16_t* We2 = (bf16_t*)(ws + OFF_WE2); bf16_t* Hb = (bf16_t*)(ws + OFF_H); bf16_t* Yb = (bf16_t*)(ws + OFF_Y);
    int* list = (int*)(ws + OFF_LIST); int* asg = (int*)(ws + OFF_ASG);
    const int lo = a.ph_lo, hi = a.ph_hi;
#define IN(k) (lo <= (k) && (k) < hi)
#define SEAM(k) do { if (IN(k) && IN((k) + 1)) grid.sync(); } while (0)
    if (IN(0)) {
        if (blockIdx.x == 0) {
            const int i = threadIdx.x;
            { const float aa = lbl[i], bb = lbl[512 + i]; const float m = fmaxf(aa, bb); const float ea = __expf(aa - m), eb = __expf(bb - m); lbt[i] = ea / (ea + eb); }
            if (i < NEXP) cnt[i] = 0;
        }
        p0_meta(lds, meta, g1, w_in, lbl, A_log, dt_bias, proj, gbf);
        { TrJob j{w_in, nullptr, Win, 0, 1024, WIN_LD, NPROJ, 1, 0, 0}; run_tr(lds, j); }
        { TrJob j{hg_up, nullptr, Whg, 1, 512, 1024, 1024, 1, 0, 0}; run_tr(lds, j); }
        { TrJob j{gd_up, nullptr, Wgd, 1, 512, 1024, 1024, 1, 0, 0}; run_tr(lds, j); }
        { TrJob j{w_out, nullptr, Wout, 1, 1024, 1024, 1024, 1, 0, 0}; run_tr(lds, j); }
        p0_prep_x(lds, x, g1, w_in, A_log, dt_bias, xb, gbf);
    }
    SEAM(0);
    if (IN(1)) run_dense(lds, (const char*)xb, D * 2, 1024, (const char*)Win, T, NPROJ, 0, 0, proj, lbt);
    SEAM(1);
    if (IN(2)) p_conv(proj, convw, qkvn);
    SEAM(2);
    if (IN(3)) p_rec_naive(lds, proj, qkvn, gbf, hg_ng, gd_ng);
    SEAM(3);
    if (IN(4)) {
        run_dense(lds, (const char*)(proj + C_QA), NPROJ * 2, 512, (const char*)Whg, T, 1024, 1, 1, tmp, proj);
        run_dense(lds, (const char*)(proj + C_GQ), NPROJ * 2, 512, (const char*)Wgd, T, 1024, 1, 2, tmp, proj);
    }
    SEAM(4);
    if (IN(5)) run_dense(lds, (const char*)tmp, D * 2, 1024, (const char*)Wout, T, 1024, 0, 3, out, x);
    SEAM(5);
    if (IN(6)) {
        { TrJob j{w_gate, w_up, We1, 2, 1024, 512, 1024, NEXP, (size_t)1024 * 512, (size_t)1024 * 1024}; run_tr(lds, j); }
        { TrJob j{w_down, nullptr, We2, 1, 512, 1024, 1024, NEXP, (size_t)512 * 1024, (size_t)1024 * 512}; run_tr(lds, j); }
        p_router(lds, out, g2, rgw, rgb, rew, reb, xn, cnt, list, asg);
    }
    SEAM(6);
    if (IN(7)) run_moe(lds, (const char*)xn, D * 2, 1024, (const char*)We1, (size_t)1024 * 1024 * 2, cnt, list, 0, Hb);
    SEAM(7);
    if (IN(8)) run_moe(lds, (const char*)Hb, 512 * 2, 512, (const char*)We2, (size_t)1024 * 512 * 2, cnt, list, 1, Yb);
    SEAM(8);
    if (IN(9)) p_final(lds, out, Yb, cnt, asg, gf);
#undef IN
#undef SEAM
}

#ifndef N_LAUNCH_SPLIT
#define N_LAUNCH_SPLIT 0
#endif
constexpr int NPHASE = 10;
extern "C" void kernel_launch(void* const* d_in, const int* in_sizes, int n_in, void* d_out, int out_size, void* d_ws, size_t ws_size, hipStream_t stream) {
    static int grid = 0;
    if (grid == 0) {
        if (n_in != 22 || in_sizes[0] != T * D || out_size != T * D || ws_size < WS_END) { fprintf(stderr, "kernel_launch: unexpected shapes (n_in %d in0 %d out %d ws %zu need %zu)\n", n_in, n_in > 0 ? in_sizes[0] : -1, out_size, ws_size, (size_t)WS_END); grid = -1; }
        else {
            int dev = 0, cus = 0, per_cu = 0;
            if (hipGetDevice(&dev) != hipSuccess || hipDeviceGetAttribute(&cus, hipDeviceAttributeMultiprocessorCount, dev) != hipSuccess) grid = -1;
            else if (hipFuncSetAttribute((const void*)mega, hipFuncAttributeMaxDynamicSharedMemorySize, LDS_BYTES) != hipSuccess) { fprintf(stderr, "kernel_launch: hipFuncSetAttribute failed\n"); grid = -1; }
            else if (hipOccupancyMaxActiveBlocksPerMultiprocessor(&per_cu, (const void*)mega, NTHR, LDS_BYTES) != hipSuccess || per_cu < 1) { fprintf(stderr, "kernel_launch: occupancy query says %d\n", per_cu); grid = -1; }
            else grid = cus;
            (void)hipGetLastError();
        }
    }
    if (grid < 0) return;
    Args a{};
    for (int i = 0; i < 22; ++i) a.in[i] = (const float*)d_in[i];
    a.out = (float*)d_out; a.ws = (char*)d_ws;
#if N_LAUNCH_SPLIT
    for (int p = 0; p < NPHASE; ++p) { a.ph_lo = p; a.ph_hi = p + 1; hipLaunchKernelGGL(mega, dim3(grid), dim3(NTHR), LDS_BYTES, stream, a); }
#else
    a.ph_lo = 0; a.ph_hi = NPHASE;
    void* args[] = {&a};
    hipError_t e = hipLaunchCooperativeKernel((const void*)mega, dim3(grid), dim3(NTHR), args, LDS_BYTES, stream);
    if (e != hipSuccess) fprintf(stderr, "cooperative launch failed: %s (grid %d)\n", hipGetErrorString(e), grid);
#endif
}
```

```cpp
#include <hip/hip_runtime.h>
#include <hip/hip_cooperative_groups.h>
namespace cg = cooperative_groups;
#include <cstdio>
#include <cstdint>

#define LAS __attribute__((address_space(3)))
#ifndef PROBE_PH
#define PROBE_PH -1
#endif
#define PROBE_K 4
#ifndef PROBE_BLK
#define PROBE_BLK 0
#endif
typedef unsigned short bf16_t;
typedef short bf16x8 __attribute__((ext_vector_type(8)));
typedef float f32x4 __attribute__((ext_vector_type(4)));
typedef unsigned u32x4 __attribute__((ext_vector_type(4)));
typedef unsigned u32x2 __attribute__((ext_vector_type(2)));

constexpr int D = 1024, NB = 4, SEQ = 8192, NMETA = 16, T = NB * SEQ;
constexpr int LP = 8256;
constexpr int TP = NB * LP;
constexpr int NPROJ = 6144;
constexpr int WIN_LD = 6152;
constexpr float EPS = 1e-6f;
constexpr int NEXP = 32, ECAP = 32768, HROWS = 73728;
constexpr int C_QA = 0, C_LF = 512, C_VA = 1024, C_HG = 1536, C_GQ = 2048, C_GK = 2560, C_GV = 3072, C_GZ = 3584, C_PA = 4096, C_PB = 5120;

constexpr size_t OFF_PROJ = 0;
constexpr size_t SZ_PROJ = (size_t)TP * NPROJ * 2;
constexpr size_t OFF_WIN = OFF_PROJ + SZ_PROJ;
constexpr size_t OFF_WHG = OFF_WIN + (size_t)NPROJ * D * 2;
constexpr size_t OFF_WGD = OFF_WHG + (size_t)1024 * 512 * 2;
constexpr size_t OFF_WOUT = OFF_WGD + (size_t)1024 * 512 * 2;
constexpr size_t OFF_GBF = OFF_WOUT + (size_t)1024 * 1024 * 2;
constexpr size_t OFF_MISC = OFF_GBF + (size_t)TP * 8 * 4;
constexpr size_t OFF_QKVN = OFF_MISC + 8192;
constexpr size_t GD_SZ16 = (size_t)NB * 129 * 4 * 16384;
constexpr size_t OFF_KHT = OFF_QKVN, OFF_QT = OFF_KHT + GD_SZ16, OFF_AT = OFF_QT + GD_SZ16, OFF_GEND = OFF_AT + GD_SZ16 / 2;
constexpr size_t OFF_BAR = OFF_GEND + 16384;
constexpr size_t OFF_RSX = OFF_BAR + 16384;
constexpr size_t WS_END = OFF_RSX + (size_t)T * 4;
static_assert(WS_END <= ((size_t)512 << 20), "workspace");
constexpr size_t OFF_TMP = OFF_QKVN;
constexpr size_t DO_WP = 0, DO_U0T = GD_SZ16, DO_ARUN = (size_t)68 << 20, DO_OA = (size_t)90 << 20, DO_OB = 0;
constexpr size_t OFF_MG = OFF_QKVN;
constexpr size_t OFF_XN = 0;
constexpr size_t OFF_WE1 = OFF_XN + (size_t)T * D * 2;
constexpr size_t OFF_WE2 = OFF_WE1 + (size_t)NEXP * 1024 * 1024 * 2;
constexpr size_t OFF_H = OFF_WE2 + (size_t)NEXP * 1024 * 512 * 2;
constexpr size_t OFF_Y = OFF_H + (size_t)HROWS * 512 * 2;
constexpr size_t OFF_LIST = OFF_Y + (size_t)HROWS * 1024 * 2;
constexpr size_t OFF_ASG = OFF_LIST + (size_t)NEXP * ECAP * 4;
constexpr size_t OFF_RS = OFF_ASG + (size_t)T * 2 * 12;
constexpr size_t MOE_END = OFF_RS + (size_t)NEXP * ECAP * 4;
static_assert(MOE_END <= SZ_PROJ, "moe scratch must fit in the dead proj region");
constexpr size_t MISC_LBT = 0, MISC_CNT = 4096;

typedef __bf16 bf16x2_t __attribute__((ext_vector_type(2)));
typedef float f32x2_t __attribute__((ext_vector_type(2)));
__device__ __forceinline__ unsigned cvt_pk_bf16(float lo, float hi) { const f32x2_t f = {lo, hi}; const bf16x2_t b = __builtin_convertvector(f, bf16x2_t); return __builtin_bit_cast(unsigned, b); }
__device__ __forceinline__ float bf_lo(unsigned w) { return __uint_as_float(w << 16); }
__device__ __forceinline__ float bf_hi(unsigned w) { return __uint_as_float(w & 0xffff0000u); }
__device__ __forceinline__ float bf2f(bf16_t b) { return __uint_as_float(((unsigned)b) << 16); }
__device__ __forceinline__ bf16_t f2bf(float f) { return (bf16_t)(cvt_pk_bf16(f, 0.f) & 0xffffu); }
__device__ __forceinline__ float sigmoidf_(float x) { return __builtin_amdgcn_rcpf(1.0f + __expf(-x)); }
__device__ __forceinline__ float siluf_(float x) { return x * __builtin_amdgcn_rcpf(1.0f + __expf(-x)); }
__device__ __forceinline__ float wave_sum(float v) {
    v += __builtin_bit_cast(float, __builtin_amdgcn_update_dpp(0, __builtin_bit_cast(int, v), 0xB1, 0xF, 0xF, true));
    v += __builtin_bit_cast(float, __builtin_amdgcn_update_dpp(0, __builtin_bit_cast(int, v), 0x4E, 0xF, 0xF, true));
    v += __builtin_bit_cast(float, __builtin_amdgcn_update_dpp(0, __builtin_bit_cast(int, v), 0x141, 0xF, 0xF, true));
    v += __builtin_bit_cast(float, __builtin_amdgcn_update_dpp(0, __builtin_bit_cast(int, v), 0x140, 0xF, 0xF, true));
    const int vi = __builtin_bit_cast(int, v);
    const float r0 = __builtin_bit_cast(float, __builtin_amdgcn_readlane(vi, 0)), r1 = __builtin_bit_cast(float, __builtin_amdgcn_readlane(vi, 16));
    const float r2 = __builtin_bit_cast(float, __builtin_amdgcn_readlane(vi, 32)), r3 = __builtin_bit_cast(float, __builtin_amdgcn_readlane(vi, 48));
    return (r0 + r1) + (r2 + r3);
}
__device__ __forceinline__ int prow_of(int r) { return (r >> 13) * LP + 64 + (r & 8191); }

namespace pg8 {
constexpr int BM = 256, BK = 64, HALF = 128, HTB = HALF * BK * 2, STAGE_BYTES = 8 * HTB, NXCD = 8, WGM = 4;
__host__ __device__ __forceinline__ int lds_byte(int r, int c) { const int st = (r >> 4) * 2 + (c >> 5), rr = r & 15, cc = c & 31, ob = rr * 64 + cc * 2; return st * 1024 + (ob ^ (((ob >> 9) & 1) << 5)); }
__host__ __device__ __forceinline__ void stage_rc(int b, int& R, int& C) { const int st = b / 1024, sb = b % 1024, swz = sb ^ (((sb >> 9) & 1) << 5); R = (st >> 1) * 16 + swz / 64; C = (st & 1) * 32 + (swz % 64) / 2; }
__host__ __device__ __forceinline__ int perm32(int rho) { const int n = rho >> 4, i = rho & 15; return 8 * (i >> 2) + 4 * n + (i & 3); }

struct Unit { int pm, pn, e, t; };

struct StaticOrder {
    int nM, nN, nwg, G, c;
    __device__ void init(int M, int N, int G_, int c_) { nM = M / BM; nN = N / BM; nwg = nM * nN; G = G_; c = c_; }
    __device__ bool next(int i, Unit& u) const {
        const long L = (long)i * G + c; if (L >= nwg) return false;
        int wgid = (int)L; { const int q = nwg / NXCD, r = nwg % NXCD, xcd = wgid % NXCD, off = wgid / NXCD; wgid = (xcd < r ? xcd * (q + 1) : r * (q + 1) + (xcd - r) * q) + off; }
        const int nig = WGM * nN, gid = wgid / nig, fm = gid * WGM, gsz = (nM - fm) < WGM ? (nM - fm) : WGM;
        u.pm = fm + ((wgid % nig) % gsz); u.pn = (wgid % nig) / gsz; u.e = 0; u.t = 0; return true;
    }
};

template <class Epi, class Sched>
__device__ __forceinline__ void gemm_phase(LAS unsigned char* lds, const Sched& S, const Epi& E) {
    const int tid = threadIdx.x, wid = __builtin_amdgcn_readfirstlane(tid >> 6), lane = tid & 63, wr = wid >> 2, wc = wid & 3, fr = lane & 15, fq = lane >> 4;
    const int K = S.K, nt = K / BK;
    int Rr[2]; unsigned ccA[2], voffB[2];
#pragma unroll
    for (int i = 0; i < 2; ++i) { int R, C; stage_rc(tid * 16 + i * 8192, R, C); const int Rb = Epi::PERM ? ((R & ~31) + perm32(R & 31)) : R;
        Rr[i] = R; ccA[i] = (unsigned)C * 2u; voffB[i] = (unsigned)(Rb * K + C) * 2u; }
    const size_t kstep = (size_t)(BK * 2);
    const size_t hstepB = (size_t)HALF * K * 2;
    const unsigned ldsw = (unsigned)wid * 1024u;
    const int aoff = lds_byte(wr * 64 + fr, fq * 8), boff = lds_byte(wc * 32 + fr, fq * 8);
#define PG8_SA(b, h) (((b) * 2 + (h)) * HTB)
#define PG8_SB(b, h) ((4 + (b) * 2 + (h)) * HTB)
#define PG8_STAGE(bufoff, gbase, voff) do { _Pragma("unroll") for (int _i = 0; _i < 2; ++_i) \
        __builtin_amdgcn_global_load_lds((const unsigned*)((const char*)(gbase) + (voff)[_i]), (LAS unsigned*)(lds + (bufoff) + ldsw + _i * 8192), 16, 0, 0); } while (0)
#define PG8_LDA(dst, b, h) do { _Pragma("unroll") for (int m = 0; m < 4; ++m) _Pragma("unroll") for (int k = 0; k < 2; ++k) dst[m][k] = *(const LAS bf16x8*)(lds + PG8_SA(b, h) + aoff + m * 2048 + k * 1024); } while (0)
#define PG8_LDB(dst, b, h) do { _Pragma("unroll") for (int n = 0; n < 2; ++n) _Pragma("unroll") for (int k = 0; k < 2; ++k) dst[n][k] = *(const LAS bf16x8*)(lds + PG8_SB(b, h) + boff + n * 2048 + k * 1024); } while (0)
#define PG8_MMA(ai, bj, At, Bt) do { __builtin_amdgcn_s_setprio(1); _Pragma("unroll") for (int m = 0; m < 4; ++m) _Pragma("unroll") for (int n = 0; n < 2; ++n) _Pragma("unroll") for (int k = 0; k < 2; ++k) \
        acc[ai][bj][m][n] = __builtin_amdgcn_mfma_f32_16x16x32_bf16(Bt[n][k], At[m][k], acc[ai][bj][m][n], 0, 0, 0); __builtin_amdgcn_s_setprio(0); } while (0)
#define PG8_WAIT_V(n) asm volatile("s_waitcnt vmcnt(" #n ")" ::: "memory")
#define PG8_WAIT_L(n) asm volatile("s_waitcnt lgkmcnt(" #n ")" ::: "memory")
#define PG8_BAR __builtin_amdgcn_s_barrier()
#define PG8_SCHED __builtin_amdgcn_sched_barrier(0)
    Unit cur, nxt; int ui = 0;
    if (!S.next(0, cur)) return;
    f32x4 acc[2][2][4][2];
#pragma unroll
    for (int a = 0; a < 2; ++a)
#pragma unroll
        for (int b = 0; b < 2; ++b)
#pragma unroll
            for (int m = 0; m < 4; ++m)
#pragma unroll
                for (int n = 0; n < 2; ++n) acc[a][b][m][n] = (f32x4){0.f, 0.f, 0.f, 0.f};
    bf16x8 At[4][2], B0[2][2], B1[2][2];
    unsigned vAc[2][2], vAn[2][2];
#pragma unroll
    for (int h = 0; h < 2; ++h)
#pragma unroll
        for (int i = 0; i < 2; ++i) vAc[h][i] = S.a_off(cur, Rr[i] + HALF * h) + ccA[i];
    const char* gA = S.a_base();
    const char* cB = S.b_ptr(cur);
    PG8_STAGE(PG8_SB(0, 0), cB, voffB); PG8_STAGE(PG8_SB(0, 1), cB + hstepB, voffB); PG8_STAGE(PG8_SA(0, 0), gA, vAc[0]); PG8_STAGE(PG8_SA(0, 1), gA, vAc[1]);
    if (wr == 1) PG8_BAR;
    PG8_WAIT_V(2); PG8_BAR;
    PG8_STAGE(PG8_SB(1, 0), cB + kstep, voffB); PG8_STAGE(PG8_SA(1, 0), gA + kstep, vAc[0]); PG8_STAGE(PG8_SB(1, 1), cB + hstepB + kstep, voffB);
    PG8_WAIT_V(6); PG8_BAR;
    for (;;) {
        const bool has_next = S.next(ui + 1, nxt);
        const bool hf = S.half(cur);
        const char* nB = has_next ? S.b_ptr(nxt) : cB;
#pragma unroll
        for (int h = 0; h < 2; ++h)
#pragma unroll
            for (int i = 0; i < 2; ++i) vAn[h][i] = has_next ? (S.a_off(nxt, Rr[i] + HALF * h) + ccA[i]) : vAc[h][i];
        for (int t = 0; t < nt; t += 2) {
            const bool last = (t == nt - 2);
            const char* a1 = gA + (size_t)(t + 1) * kstep;
            const char* a2 = last ? gA : gA + (size_t)(t + 2) * kstep; const char* b2 = last ? nB : cB + (size_t)(t + 2) * kstep;
            const char* a3 = a2 + kstep; const char* b3 = b2 + kstep;
            unsigned w0[2], w1[2];
#pragma unroll
            for (int i = 0; i < 2; ++i) { w0[i] = last ? vAn[0][i] : vAc[0][i]; w1[i] = last ? vAn[1][i] : vAc[1][i]; }
            PG8_LDB(B0, 0, 0); PG8_LDB(B1, 0, 1); PG8_SCHED; PG8_LDA(At, 0, 0); PG8_STAGE(PG8_SA(1, 1), a1, vAc[1]);
            PG8_WAIT_V(8); PG8_WAIT_L(0); PG8_BAR; PG8_MMA(0, 0, At, B0); PG8_MMA(0, 1, At, B1); PG8_BAR; PG8_SCHED;
            if (!hf) PG8_LDA(At, 0, 1); PG8_STAGE(PG8_SB(0, 0), b2, voffB); PG8_STAGE(PG8_SB(0, 1), b2 + hstepB, voffB); PG8_STAGE(PG8_SA(0, 0), a2, w0);
            PG8_WAIT_V(8); PG8_WAIT_L(0); PG8_BAR; if (!hf) { PG8_MMA(1, 0, At, B0); PG8_MMA(1, 1, At, B1); } PG8_BAR; PG8_SCHED;
            PG8_LDB(B0, 1, 0); PG8_LDB(B1, 1, 1); PG8_SCHED; PG8_LDA(At, 1, 0); PG8_STAGE(PG8_SA(0, 1), a2, w1);
            PG8_WAIT_V(8); PG8_WAIT_L(0); PG8_BAR; PG8_MMA(0, 0, At, B0); PG8_MMA(0, 1, At, B1); PG8_BAR; PG8_SCHED;
            if (!hf) PG8_LDA(At, 1, 1); PG8_STAGE(PG8_SB(1, 0), b3, voffB); PG8_STAGE(PG8_SB(1, 1), b3 + hstepB, voffB); PG8_STAGE(PG8_SA(1, 0), a3, w0);
            PG8_WAIT_V(8); PG8_WAIT_L(0); PG8_BAR; if (!hf) { PG8_MMA(1, 0, At, B0); PG8_MMA(1, 1, At, B1); } PG8_BAR; PG8_SCHED;
        }
        if (wr == 0) PG8_BAR;
        E(acc, cur, wr, wc, fr, fq);
        if (!has_next) break;
        if (!S.keep(cur)) {
#pragma unroll
        for (int a = 0; a < 2; ++a)
#pragma unroll
            for (int b = 0; b < 2; ++b)
#pragma unroll
                for (int m = 0; m < 4; ++m)
#pragma unroll
                    for (int n = 0; n < 2; ++n) acc[a][b][m][n] = (f32x4){0.f, 0.f, 0.f, 0.f};
        }
        cur = nxt; cB = nB; ++ui;
#pragma unroll
        for (int h = 0; h < 2; ++h)
#pragma unroll
            for (int i = 0; i < 2; ++i) vAc[h][i] = vAn[h][i];
        if (wr == 1) PG8_BAR;
    }
    PG8_WAIT_V(0);
    PG8_BAR;
#undef PG8_SA
#undef PG8_SB
#undef PG8_STAGE
#undef PG8_LDA
#undef PG8_LDB
#undef PG8_MMA
#undef PG8_WAIT_V
#undef PG8_WAIT_L
#undef PG8_BAR
#undef PG8_SCHED
}
}

struct SchedDense {
    pg8::StaticOrder so; const char* A; unsigned lda2; int K; const char* Bt; int rowmap;
    __device__ bool next(int i, pg8::Unit& u) const { return so.next(i, u); }
    __device__ const char* a_base() const { return A; }
    __device__ unsigned a_off(const pg8::Unit& u, int r) const { const int row = u.pm * 256 + r; return (unsigned)(rowmap ? prow_of(row) : row) * lda2; }
    __device__ const char* b_ptr(const pg8::Unit& u) const { return Bt + (size_t)u.pn * 256 * K * 2; }
    __device__ bool keep(const pg8::Unit&) const { return false; }
    __device__ bool half(const pg8::Unit&) const { return false; }
};
struct SchedMerge {
    pg8::StaticOrder so; const char* base; unsigned offA, offB; int K; const char* Whg; const char* Wgd;
    __device__ bool next(int i, pg8::Unit& u) const { const bool ok = so.next(i >> 1, u); u.e = i & 1; return ok; }
    __device__ const char* a_base() const { return base; }
    __device__ unsigned a_off(const pg8::Unit& u, int r) const { return (u.e ? offB : offA) + (unsigned)(u.pm * 256 + r) * 1024u; }
    __device__ const char* b_ptr(const pg8::Unit& u) const { return (u.e ? Wgd : Whg) + (size_t)u.pn * 256 * K * 2; }
    __device__ bool keep(const pg8::Unit& u) const { return u.e == 0; }
    __device__ bool half(const pg8::Unit&) const { return false; }
};
struct SchedMoe {
    const int* cnt; const int* list; LAS const int* pref;
    const char* A; unsigned lda2; int K; const char* Bt; size_t bstride; int gather; int G, c;
    __device__ bool next(int i, pg8::Unit& u) const {
        const int L = i * G + c; const int nF = pref[33 + NEXP] * 4, nH = pref[66 + NEXP] * 4; if (L >= nF + nH) return false;
        int e = 0;
        if (L < nF) {
#pragma unroll 1
            for (int j = 1; j < NEXP; ++j) if (L >= pref[33 + j] * 4) e = j;
            const int q = L - pref[33 + e] * 4, nte = pref[33 + e + 1] - pref[33 + e];
            u.e = e; u.pn = q / nte; u.t = q % nte;
        } else {
            const int Lh = L - nF;
#pragma unroll 1
            for (int j = 1; j < NEXP; ++j) if (Lh >= pref[66 + j] * 4) e = j;
            u.e = e; u.pn = Lh - pref[66 + e] * 4; u.t = (pref[e + 1] - pref[e]) - 1;
        }
        u.pm = pref[u.e] + u.t; return true;
    }
    __device__ const char* a_base() const { return A; }
    __device__ unsigned a_off(const pg8::Unit& u, int r) const {
        if (gather) { const int p = u.t * 256 + r; const int n = cnt[u.e]; const int tok = p < n ? list[u.e * ECAP + p] : 0; return (unsigned)tok * lda2; }
        return (unsigned)(u.pm * 256 + r) * lda2;
    }
    __device__ const char* b_ptr(const pg8::Unit& u) const { return Bt + (size_t)u.e * bstride + (size_t)u.pn * 256 * K * 2; }
    __device__ bool keep(const pg8::Unit&) const { return false; }
    __device__ bool half(const pg8::Unit& u) const { const int rem = cnt[u.e] & 255; return rem != 0 && rem <= 128 && u.t == (pref[u.e + 1] - pref[u.e]) - 1; }
};

struct EpiProj {
    static constexpr bool PERM = true;
    bf16_t* proj; const float* lbt; const float* rsx;
    __device__ __forceinline__ void operator()(const f32x4 (&acc)[2][2][4][2], const pg8::Unit& u, int wr, int wc, int fr, int fq) const {
        const int seg = u.pn >> 1;
        float rv[2][4];
#pragma unroll
        for (int ai = 0; ai < 2; ++ai)
#pragma unroll
            for (int m = 0; m < 4; ++m) rv[ai][m] = rsx[u.pm * 256 + wr * 64 + fr + ai * 128 + m * 16];
        const int row0 = prow_of(u.pm * 256) + wr * 64 + fr, col0 = u.pn * 256 + wc * 32 + 8 * fq;
        const int mode = (seg == 0 || seg == 3 || seg == 7) ? 1 : (seg == 1 ? 2 : 0);
        float lb[2][8];
#pragma unroll
        for (int bj = 0; bj < 2; ++bj)
#pragma unroll
            for (int j = 0; j < 8; ++j) lb[bj][j] = (mode == 2) ? lbt[col0 + bj * 128 + j - C_LF] : 0.f;
#pragma unroll
        for (int ai = 0; ai < 2; ++ai)
#pragma unroll
            for (int m = 0; m < 4; ++m) { bf16_t* rowp = proj + (size_t)(row0 + ai * 128 + m * 16) * NPROJ + col0;
#pragma unroll
                for (int bj = 0; bj < 2; ++bj) { float v[8];
#pragma unroll
                    for (int j = 0; j < 4; ++j) { v[j] = acc[ai][bj][m][0][j] * rv[ai][m]; v[4 + j] = acc[ai][bj][m][1][j] * rv[ai][m]; }
                    if (mode == 1) {
#pragma unroll
                        for (int j = 0; j < 8; ++j) v[j] = siluf_(v[j]);
                    } else if (mode == 2) {
#pragma unroll
                        for (int j = 0; j < 8; ++j) v[j] = __logf(lb[bj][j] + (1.0f - lb[bj][j]) * sigmoidf_(v[j]));
                    }
                    u32x4 w; w.x = cvt_pk_bf16(v[0], v[1]); w.y = cvt_pk_bf16(v[2], v[3]); w.z = cvt_pk_bf16(v[4], v[5]); w.w = cvt_pk_bf16(v[6], v[7]);
                    *(u32x4*)(rowp + bj * 128) = w; } }
    }
};
struct EpiMerge {
    static constexpr bool PERM = true;
    bf16_t* proj; bf16_t* mg;
    __device__ __forceinline__ void operator()(f32x4 (&acc)[2][2][4][2], const pg8::Unit& u, int wr, int wc, int fr, int fq) const {
        const int prow0 = prow_of(u.pm * 256) + wr * 64 + fr, row0 = u.pm * 256 + wr * 64 + fr, col0 = u.pn * 256 + wc * 32 + 8 * fq;
#pragma unroll
        for (int ai = 0; ai < 2; ++ai) {
            u32x4 gbw[4][2], gaw[4][2];
#pragma unroll
            for (int m = 0; m < 4; ++m) { const bf16_t* rp = proj + (size_t)(prow0 + ai * 128 + m * 16) * NPROJ + col0;
#pragma unroll
                for (int bj = 0; bj < 2; ++bj) { gbw[m][bj] = *(const u32x4*)(rp + C_PB + bj * 128); gaw[m][bj] = (u.e == 0) ? *(const u32x4*)(rp + C_PA + bj * 128) : (u32x4){0u, 0u, 0u, 0u}; } }
#pragma unroll
            for (int m = 0; m < 4; ++m)
#pragma unroll
                for (int bj = 0; bj < 2; ++bj) {
                    const u32x4 gb = gbw[m][bj], ga = gaw[m][bj];
                    const float gbv[8] = {bf_lo(gb.x), bf_hi(gb.x), bf_lo(gb.y), bf_hi(gb.y), bf_lo(gb.z), bf_hi(gb.z), bf_lo(gb.w), bf_hi(gb.w)};
                    if (u.e == 0) {
                        const float gav[8] = {bf_lo(ga.x), bf_hi(ga.x), bf_lo(ga.y), bf_hi(ga.y), bf_lo(ga.z), bf_hi(ga.z), bf_lo(ga.w), bf_hi(ga.w)};
#pragma unroll
                        for (int j = 0; j < 4; ++j) { acc[ai][bj][m][0][j] *= (1.0f + __expf(-gbv[j])) * __builtin_amdgcn_rcpf(1.0f + __expf(-gav[j])); acc[ai][bj][m][1][j] *= (1.0f + __expf(-gbv[4 + j])) * __builtin_amdgcn_rcpf(1.0f + __expf(-gav[4 + j])); }
                    } else {
                        float v[8];
#pragma unroll
                        for (int j = 0; j < 4; ++j) { v[j] = acc[ai][bj][m][0][j] * sigmoidf_(gbv[j]); v[4 + j] = acc[ai][bj][m][1][j] * sigmoidf_(gbv[4 + j]); }
                        u32x4 w; w.x = cvt_pk_bf16(v[0], v[1]); w.y = cvt_pk_bf16(v[2], v[3]); w.z = cvt_pk_bf16(v[4], v[5]); w.w = cvt_pk_bf16(v[6], v[7]);
                        *(u32x4*)(mg + (size_t)(row0 + ai * 128 + m * 16) * D + col0 + bj * 128) = w; }
                }
            asm volatile("" ::: "memory"); }
    }
};
struct EpiResid {
    static constexpr bool PERM = true;
    const float* x; bf16_t* h1b;
    __device__ __forceinline__ void operator()(const f32x4 (&acc)[2][2][4][2], const pg8::Unit& u, int wr, int wc, int fr, int fq) const {
        const int row0 = u.pm * 256 + wr * 64 + fr, col0 = u.pn * 256 + wc * 32 + 8 * fq;
#pragma unroll
        for (int ai = 0; ai < 2; ++ai) {
            f32x4 xv[4][2][2];
#pragma unroll
            for (int m = 0; m < 4; ++m) { const size_t off = (size_t)(row0 + ai * 128 + m * 16) * D + col0;
#pragma unroll
                for (int bj = 0; bj < 2; ++bj)
#pragma unroll
                    for (int n = 0; n < 2; ++n) xv[m][bj][n] = *(const f32x4*)(x + off + bj * 128 + n * 4); }
#pragma unroll
            for (int m = 0; m < 4; ++m) { const size_t off = (size_t)(row0 + ai * 128 + m * 16) * D + col0;
#pragma unroll
                for (int bj = 0; bj < 2; ++bj) { const f32x4 a = xv[m][bj][0] + acc[ai][bj][m][0], b = xv[m][bj][1] + acc[ai][bj][m][1];
                    u32x4 w; w.x = cvt_pk_bf16(a[0], a[1]); w.y = cvt_pk_bf16(a[2], a[3]); w.z = cvt_pk_bf16(b[0], b[1]); w.w = cvt_pk_bf16(b[2], b[3]);
                    *(u32x4*)(h1b + off + bj * 128) = w; } }
            asm volatile("" ::: "memory"); }
    }
};
struct EpiSwiglu {
    static constexpr bool PERM = false;
    bf16_t* H; const float* rs;
    __device__ __forceinline__ void operator()(const f32x4 (&acc)[2][2][4][2], const pg8::Unit& u, int wr, int wc, int fr, int fq) const {
        const int row0 = u.pm * 256 + wr * 64 + fr, col0 = u.pn * 128 + wc * 16 + 4 * fq;
        const float* rsp = rs + (size_t)u.e * ECAP + u.t * 256 + wr * 64 + fr;
        float rv[2][4];
#pragma unroll
        for (int ai = 0; ai < 2; ++ai)
#pragma unroll
            for (int m = 0; m < 4; ++m) rv[ai][m] = rsp[ai * 128 + m * 16];
#pragma unroll
        for (int ai = 0; ai < 2; ++ai)
#pragma unroll
            for (int m = 0; m < 4; ++m) { bf16_t* rowp = H + (size_t)(row0 + ai * 128 + m * 16) * 512 + col0;
#pragma unroll
                for (int bj = 0; bj < 2; ++bj) { const f32x4 g = acc[ai][bj][m][0] * rv[ai][m], up = acc[ai][bj][m][1] * rv[ai][m];
                    u32x2 w; w.x = cvt_pk_bf16(siluf_(g[0]) * up[0], siluf_(g[1]) * up[1]); w.y = cvt_pk_bf16(siluf_(g[2]) * up[2], siluf_(g[3]) * up[3]);
                    *(u32x2*)(rowp + bj * 64) = w; } }
    }
};
struct EpiY {
    static constexpr bool PERM = true;
    bf16_t* Y;
    __device__ __forceinline__ void operator()(const f32x4 (&acc)[2][2][4][2], const pg8::Unit& u, int wr, int wc, int fr, int fq) const {
        const int row0 = u.pm * 256 + wr * 64 + fr, col0 = u.pn * 256 + wc * 32 + 8 * fq;
#pragma unroll
        for (int ai = 0; ai < 2; ++ai)
#pragma unroll
            for (int m = 0; m < 4; ++m) { bf16_t* rowp = Y + (size_t)(row0 + ai * 128 + m * 16) * D + col0;
#pragma unroll
                for (int bj = 0; bj < 2; ++bj) { const f32x4 a = acc[ai][bj][m][0], b = acc[ai][bj][m][1];
                    u32x4 w; w.x = cvt_pk_bf16(a[0], a[1]); w.y = cvt_pk_bf16(a[2], a[3]); w.z = cvt_pk_bf16(b[0], b[1]); w.w = cvt_pk_bf16(b[2], b[3]);
                    *(u32x4*)(rowp + bj * 128) = w; } }
    }
};


#define XB_TMO      128
#define XB_XCNT(j)  (256  + 64 * (j))
#define XB_XSUB(j)  (1280 + 64 * (j))
#define XB_XGEN(j)  (2304 + 64 * (j))
#define XB_TOP      3328
#define XB_TOPGEN   3392
#define XCD_BAR_WORDS 3456
#define XB_SPIN_CAP (1u << 22)
__device__ __forceinline__ unsigned xb_ld(unsigned* p)              { return __hip_atomic_load(p, __ATOMIC_RELAXED, __HIP_MEMORY_SCOPE_AGENT); }
__device__ __forceinline__ unsigned xb_add(unsigned* p, unsigned v) { return __hip_atomic_fetch_add(p, v, __ATOMIC_RELAXED, __HIP_MEMORY_SCOPE_AGENT); }
__device__ __forceinline__ unsigned xb_xcc_id() { return (unsigned)__builtin_amdgcn_s_getreg((3 << 11) | 20) & 0xFu; }
#define XB_SPIN(cond, bar) do { unsigned _sp = 0; while (cond) { __builtin_amdgcn_s_sleep(1); \
    if ((++_sp & 255u) == 0u) { if (xb_ld(&(bar)[XB_TMO])) break; if (_sp > XB_SPIN_CAP) { atomicAdd(&(bar)[XB_TMO], 1u); break; } } } } while (0)
struct XcdBarrier { unsigned* bar; unsigned x; volatile LAS unsigned* st; };
__device__ __forceinline__ XcdBarrier xcd_barrier_post(unsigned* bar, volatile LAS unsigned* st) {
    XcdBarrier b; b.bar = bar; b.x = xb_xcc_id(); b.st = st;
    if (threadIdx.x == 0) (void)xb_add(&bar[XB_XCNT(b.x)], 1u);
    return b;
}
__device__ __forceinline__ void xcd_barrier_complete(unsigned* bar, unsigned x, unsigned& nloc, unsigned& nx) {
    const unsigned G = gridDim.x * gridDim.y * gridDim.z;
    unsigned sum, cnt, mine, sp = 0u;
    for (;;) {
        sum = 0u; cnt = 0u; mine = 0u;
#pragma unroll
        for (unsigned j = 0; j < 16; ++j) { const unsigned c = xb_ld(&bar[XB_XCNT(j)]); sum += c; cnt += (c > 0u) ? 1u : 0u; mine = (j == x) ? c : mine; }
        if (sum == G) break;
        __builtin_amdgcn_s_sleep(1);
        if ((++sp & 255u) == 0u) { if (xb_ld(&bar[XB_TMO])) break; if (sp > XB_SPIN_CAP) { atomicAdd(&bar[XB_TMO], 1u); break; } }
    }
    nloc = mine > 0u ? mine : 1u; nx = cnt > 0u ? cnt : 1u;
}
__device__ __forceinline__ void xcd_barrier(const XcdBarrier& b) {
    asm volatile("s_waitcnt vmcnt(0)" ::: "memory");
    __syncthreads();
    if (threadIdx.x == 0) {
        unsigned* bar = b.bar;
        __builtin_amdgcn_s_waitcnt(0);
        unsigned nloc = b.st[0], nx = b.st[1];
        if (nloc == 0u) { xcd_barrier_complete(bar, b.x, nloc, nx); b.st[0] = nloc; b.st[1] = nx; }
        const unsigned old = xb_add(&bar[XB_XSUB(b.x)], 1u);
        const unsigned gen = old / nloc;
        if (old + 1u == (gen + 1u) * nloc) {
            __builtin_amdgcn_fence(__ATOMIC_RELEASE, "agent");
            asm volatile("s_waitcnt vmcnt(0)" ::: "memory");
            const unsigned og = xb_add(&bar[XB_TOP], 1u);
            const unsigned tg = og / nx;
            if (og + 1u == (tg + 1u) * nx) xb_add(&bar[XB_TOPGEN], 1u);
            else XB_SPIN(xb_ld(&bar[XB_TOPGEN]) == tg, bar);
            __builtin_amdgcn_fence(__ATOMIC_ACQUIRE, "agent");
            xb_add(&bar[XB_XGEN(b.x)], 1u);
            asm volatile("s_waitcnt vmcnt(0)" ::: "memory");
        } else {
            XB_SPIN(xb_ld(&bar[XB_XGEN(b.x)]) == gen, bar);
            __builtin_amdgcn_fence(__ATOMIC_ACQUIRE, "agent");
            asm volatile("s_waitcnt vmcnt(0)" ::: "memory");
        }
    }
    __syncthreads();
}

constexpr int LDS_BYTES = 150 * 1024;
constexpr int NTHR = 512;
struct Args {
    const float* in[22]; float* out; char* ws; int ph_lo, ph_hi;
};

__device__ __forceinline__ f32x4 mfma16(bf16x8 a, bf16x8 b, f32x4 c) { return __builtin_amdgcn_mfma_f32_16x16x32_bf16(a, b, c, 0, 0, 0); }
struct TrJob { const float* s0; const float* s1; bf16_t* dst; int mode, K, ld, ndst, nb; size_t sbatch, dbatch; const float* ks; };
__device__ __forceinline__ void tr_load(f32x4 (&v)[8], const TrJob& j, int t) {
    const int tk = j.K / 64, tn = j.ndst / 256, per = tk * tn; const int e = t / per, r = t % per, k0 = (r % tk) * 64, n0 = (r / tk) * 256;
    const float* a = j.s0 + (size_t)e * j.sbatch; const float* b = j.s1 ? j.s1 + (size_t)e * j.sbatch : nullptr;
    const int tid = threadIdx.x;
#pragma unroll
    for (int i = 0; i < 8; ++i) { const int idx = tid + NTHR * i, row = idx >> 6, j4 = idx & 63, n = n0 + 4 * j4;
        const float* p;
        if (j.mode == 0) p = a + (n < 4096 ? n : n + 8);
        else if (j.mode == 1) p = a + n;
        else { const int grp = n >> 5, w = n & 31; p = (w < 16 ? a : b) + grp * 16 + (w & 15); }
        v[i] = *(const f32x4*)(p + (size_t)(k0 + row) * j.ld); if (j.ks) v[i] = v[i] * j.ks[k0 + row]; }
}
__device__ __forceinline__ void tr_store(LAS float* tile  , const f32x4 (&v)[8], const TrJob& j, int t) {
    const int tk = j.K / 64, tn = j.ndst / 256, per = tk * tn; const int e = t / per, r = t % per, k0 = (r % tk) * 64, n0 = (r / tk) * 256;
    bf16_t* dst = j.dst + (size_t)e * j.dbatch; const int K = j.K;
    const int tid = threadIdx.x;
    __syncthreads();
#pragma unroll
    for (int i = 0; i < 8; ++i) { const int idx = tid + NTHR * i, row = idx >> 6, j4 = idx & 63; *(LAS f32x4*)(tile + row * 260 + 4 * j4) = v[i]; }
    __syncthreads();
#pragma unroll
    for (int i = 0; i < 4; ++i) { const int ch = tid + NTHR * i, n = ch >> 3, kq = (ch & 7) * 8;
        unsigned w[4];
#pragma unroll
        for (int jx = 0; jx < 4; ++jx) w[jx] = cvt_pk_bf16(tile[(kq + 2 * jx) * 260 + n], tile[(kq + 2 * jx + 1) * 260 + n]);
        *(u32x4*)(dst + (size_t)(n0 + n) * K + k0 + kq) = (u32x4){w[0], w[1], w[2], w[3]}; }
}
__device__ __forceinline__ void run_tr(LAS unsigned char* lds, const TrJob& j, int first, int stride) {
    const int total = (j.K / 64) * (j.ndst / 256) * j.nb;
    f32x4 va[8], vb[8];
    int t = first;
    if (t < total) tr_load(va, j, t);
    while (t < total) {
        int tn = t + stride;
        if (tn < total) tr_load(vb, j, tn);
        tr_store((LAS float*)lds, va, j, t);
        t = tn; if (t >= total) break;
        tn = t + stride;
        if (tn < total) tr_load(va, j, tn);
        tr_store((LAS float*)lds, vb, j, t);
        t = tn;
    }
    __syncthreads();
}
__device__ __forceinline__ float softplusf_(float x) { return x > 20.f ? x : log1pf(__expf(x)); }

constexpr int META_WG = (WIN_LD + 127) / 128;
constexpr int PX_ST = 2064;
__device__ __forceinline__ void p0_prep_x(LAS unsigned char* lds, const float* x, const float* g1, const float* w_in, const float* A_log, const float* dt_bias, bf16_t* xb, float* gbf, float* rsx, unsigned* q0) {
    const int tid = threadIdx.x, wv = tid >> 6, l = tid & 63, c = l & 15, q = l >> 4;
    __syncthreads();
    for (int i = tid; i < 2048; i += NTHR) { const int k = i >> 1, j4 = (i & 1) * 4; const f32x4 g = *(const f32x4*)(w_in + (size_t)k * WIN_LD + 4096 + j4); const float gg = g1[k];
#pragma unroll
        for (int n = 0; n < 4; ++n) { const float w = g[n] * gg; const bf16_t hi = f2bf(w); *(LAS bf16_t*)(lds + (j4 + n) * PX_ST + k * 2) = hi; *(LAS bf16_t*)(lds + (8 + j4 + n) * PX_ST + k * 2) = f2bf(w - bf2f(hi)); } }
    if (tid < PX_ST / 16) *(LAS u32x4*)(lds + 16 * PX_ST + tid * 16) = (u32x4){0u, 0u, 0u, 0u};
    __syncthreads();
    const int ohi = (c < 8 ? c : 16) * PX_ST + 32 * q, olo = (c < 8 ? 8 + c : 16) * PX_ST + 32 * q;
    const bool even = (gridDim.x == 256);
    const int nfix = even ? (256 - META_WG) * 8 : 0;
    int tk_ = 0; const bool fixed1 = even && (int)blockIdx.x >= META_WG;
    if (!fixed1 && l == 0) tk_ = nfix + (int)atomicAdd(q0, 1u);
    if (fixed1) tk_ = ((int)blockIdx.x - META_WG) * 8 + wv;
    for (;;) {
        const int tile = __builtin_amdgcn_readfirstlane(tk_);
        if (tile * 16 >= T) break;
        if (l == 0) tk_ = nfix + (int)atomicAdd(q0, 1u);
        const int row = tile * 16 + c;
        const float* xr = x + (size_t)row * D + 16 * q;
        bf16_t* xo = xb + (size_t)row * D + 16 * q;
        f32x4 acc = (f32x4){0.f, 0.f, 0.f, 0.f}; float ss = 0.f;
#pragma unroll 8
        for (int j = 0; j < 16; ++j) {
            f32x4 a[4];
#pragma unroll
            for (int e = 0; e < 4; ++e) a[e] = *(const f32x4*)(xr + 64 * j + 4 * e);
#pragma unroll
            for (int e = 0; e < 4; ++e) ss += a[e][0] * a[e][0] + a[e][1] * a[e][1] + a[e][2] * a[e][2] + a[e][3] * a[e][3];
            u32x4 hi[2], lo[2];
#pragma unroll
            for (int s_ = 0; s_ < 2; ++s_) { const f32x4 p = a[2 * s_], r = a[2 * s_ + 1];
                hi[s_].x = cvt_pk_bf16(p[0], p[1]); hi[s_].y = cvt_pk_bf16(p[2], p[3]); hi[s_].z = cvt_pk_bf16(r[0], r[1]); hi[s_].w = cvt_pk_bf16(r[2], r[3]);
                lo[s_].x = cvt_pk_bf16(p[0] - bf_lo(hi[s_].x), p[1] - bf_hi(hi[s_].x)); lo[s_].y = cvt_pk_bf16(p[2] - bf_lo(hi[s_].y), p[3] - bf_hi(hi[s_].y));
                lo[s_].z = cvt_pk_bf16(r[0] - bf_lo(hi[s_].z), r[1] - bf_hi(hi[s_].z)); lo[s_].w = cvt_pk_bf16(r[2] - bf_lo(hi[s_].w), r[3] - bf_hi(hi[s_].w)); }
            *(u32x4*)(xo + 64 * j) = hi[0]; *(u32x4*)(xo + 64 * j + 8) = hi[1];
#pragma unroll
            for (int s_ = 0; s_ < 2; ++s_) { const bf16x8 ah = __builtin_bit_cast(bf16x8, hi[s_]), al = __builtin_bit_cast(bf16x8, lo[s_]);
                const bf16x8 bh = *(const LAS bf16x8*)(lds + ohi + 128 * j + 16 * s_), bl = *(const LAS bf16x8*)(lds + olo + 128 * j + 16 * s_);
                acc = mfma16(ah, bh, acc); acc = mfma16(ah, bl, acc); acc = mfma16(al, bh, acc); }
        }
        ss += __shfl_xor(ss, 16); ss += __shfl_xor(ss, 32);
        const float rstd = rsqrtf(ss * (1.0f / D) + EPS);
        if (q == 0) rsx[row] = rstd;
#pragma unroll
        for (int i = 0; i < 4; ++i) { const float rr = __shfl(rstd, 4 * q + i); const float v = acc[i] * rr;
            if (c < 8) { const int cj = c & 3; const float o = c < 4 ? sigmoidf_(v) : -__expf(A_log[cj]) * softplusf_(v + dt_bias[cj]);
                gbf[(size_t)prow_of(tile * 16 + 4 * q + i) * 8 + c] = o; } }
    }
    __syncthreads();
}
__device__ __forceinline__ void p0_meta(LAS unsigned char* lds, const float* meta, const float* g1, const float* w_in, const float* lbl, const float* A_log, const float* dt_bias, bf16_t* proj, float* gbf) {
    LAS float* hn = (LAS float*)lds;
    LAS float* red = (LAS float*)lds;
    const int wv = threadIdx.x >> 6, l = threadIdx.x & 63;
    if (blockIdx.x < META_WG) {
        __syncthreads();
        for (int r = wv; r < 16; r += 8) {
            const f32x4* xr = (const f32x4*)(meta + (size_t)r * D);
            f32x4 v[4]; float ss = 0.f;
#pragma unroll
            for (int i = 0; i < 4; ++i) { v[i] = xr[l + 64 * i]; ss += v[i][0] * v[i][0] + v[i][1] * v[i][1] + v[i][2] * v[i][2] + v[i][3] * v[i][3]; }
            ss = wave_sum(ss);
            const float rstd = rsqrtf(ss * (1.0f / D) + EPS);
#pragma unroll
            for (int i = 0; i < 4; ++i) { const f32x4 gv = ((const f32x4*)g1)[l + 64 * i];
#pragma unroll
                for (int c = 0; c < 4; ++c) hn[(4 * (l + 64 * i) + c) * 16 + r] = v[i][c] * rstd * gv[c]; }
        }
        __syncthreads();
        const int cl = threadIdx.x & 31, kg = threadIdx.x >> 5;
        const int n0 = blockIdx.x * 128 + 4 * cl, ncl = n0 < WIN_LD ? n0 : 0;
        f32x4 acc[16];
#pragma unroll
        for (int i = 0; i < 16; ++i) acc[i] = (f32x4){0.f, 0.f, 0.f, 0.f};
#pragma unroll 1
        for (int kb = 0; kb < 4; ++kb) {
            f32x4 wq[16];
#pragma unroll
            for (int kk = 0; kk < 16; ++kk) wq[kk] = *(const f32x4*)(w_in + (size_t)(kg * 64 + kb * 16 + kk) * WIN_LD + ncl);
#pragma unroll
            for (int kk = 0; kk < 16; ++kk) { const int k = kg * 64 + kb * 16 + kk;
#pragma unroll
                for (int i4 = 0; i4 < 4; ++i4) { const f32x4 h = *(const LAS f32x4*)&hn[k * 16 + 4 * i4]; acc[4 * i4] += wq[kk] * h[0]; acc[4 * i4 + 1] += wq[kk] * h[1]; acc[4 * i4 + 2] += wq[kk] * h[2]; acc[4 * i4 + 3] += wq[kk] * h[3]; } } }
        __syncthreads();
#pragma unroll
        for (int i = 0; i < 16; ++i)
#pragma unroll
            for (int cc = 0; cc < 4; ++cc) red[(kg * 128 + 4 * cl + cc) * 17 + i] = acc[i][cc];
        __syncthreads();
#pragma unroll 1
        for (int e = 0; e < 4; ++e) { const int o = threadIdx.x + NTHR * e, i = o >> 7, col = o & 127;
          float v = 0.f;
#pragma unroll
          for (int g = 0; g < 16; ++g) v += red[(g * 128 + col) * 17 + i];
          const int n = blockIdx.x * 128 + col;
          if (n < WIN_LD) {
              if (n < 4096 || n >= 4104) {
                  const int pc = n < 4096 ? n : n - 8, seg = pc >> 9;
                  if (seg == 0 || seg == 3 || seg == 7) v = siluf_(v);
                  else if (seg == 1) { const float a = lbl[pc - C_LF], bq = lbl[512 + pc - C_LF]; const float m = fmaxf(a, bq); const float ea = __expf(a - m), eb = __expf(bq - m); const float lb = ea / (ea + eb); v = __logf(lb + (1.0f - lb) * sigmoidf_(v)); }
                  const bf16_t ob = f2bf(v);
                  for (int b = 0; b < NB; ++b) proj[(size_t)(b * LP + 48 + i) * NPROJ + pc] = ob;
              } else {
                  const int j = n - 4096;
                  const float ov = j < 4 ? sigmoidf_(v) : -__expf(A_log[j - 4]) * softplusf_(v + dt_bias[j - 4]);
                  for (int b = 0; b < NB; ++b) gbf[(size_t)(b * LP + 48 + i) * 8 + j] = ov;
              } } }
        __syncthreads();
    }
}
__device__ __forceinline__ void p0_zero(bf16_t* proj, float* gbf) {
    for (size_t i = (size_t)blockIdx.x * NTHR + threadIdx.x; i < (size_t)NB * 48 * (NPROJ / 8); i += (size_t)gridDim.x * NTHR) {
        const int b = (int)(i / (48 * (NPROJ / 8))), rem = (int)(i % (48 * (NPROJ / 8))), r = rem / (NPROJ / 8), c8 = rem % (NPROJ / 8);
        *(u32x4*)(proj + (size_t)(b * LP + r) * NPROJ + c8 * 8) = (u32x4){0u, 0u, 0u, 0u};
    }
    for (int i = blockIdx.x * NTHR + threadIdx.x; i < NB * 48 * 8; i += gridDim.x * NTHR) { const int b = i / (48 * 8), rem = i % (48 * 8); gbf[(size_t)(b * LP) * 8 + rem] = 0.f; }
}

constexpr int HG_QDP = 0, HG_QS = 17408, HG_KS = 34816, HG_KHT = 52224, HG_VT = 70656, HG_AT = 89088, HG_SEG = 98304, HG_DEND = 102400, HG_PART = 102912;
constexpr int RS_K = 272, RS_T = 144;
__device__ __forceinline__ int kperm(int k) { const int w = k & 31; return (k & ~31) + 8 * ((w >> 2) & 3) + 4 * (w >> 4) + (w & 3); }
__device__ __forceinline__ bf16x8 pack8(const f32x4& lo, const f32x4& hi) {
    u32x4 p; p.x = cvt_pk_bf16(lo[0], lo[1]); p.y = cvt_pk_bf16(lo[2], lo[3]); p.z = cvt_pk_bf16(hi[0], hi[1]); p.w = cvt_pk_bf16(hi[2], hi[3]);
    return __builtin_bit_cast(bf16x8, p);
}
__device__ __forceinline__ float expc(float x) { return __expf(fminf(x, 80.0f)); }

template <bool OUT>
__device__ __forceinline__ void hgrn_run(LAS unsigned char* lds, bf16_t* proj, float* arun, float* drun, const float* gn, int item, bf16_t* oa) {
    const int tid = threadIdx.x, w = tid >> 6, lane = tid & 63, c = lane & 15, q = lane >> 4;
    const int bh = item >> 4, run = item & 15, b = bh >> 2, h = bh & 3;
    const int ch0 = run == 0 ? 0 : 9 + 8 * (run - 1), nc = run == 0 ? 9 : 8;
    LAS float* seg = (LAS float*)(lds + HG_SEG); LAS float* dend = (LAS float*)(lds + HG_DEND); LAS float* part = (LAS float*)(lds + HG_PART);
    f32x4 Sacc[8];
#pragma unroll
    for (int kt = 0; kt < 8; ++kt) Sacc[kt] = (f32x4){0.f, 0.f, 0.f, 0.f};
    if (OUT) {
        for (int m = 0; m < run; ++m) { const int im = bh * 16 + m;
#pragma unroll
            for (int kt = 0; kt < 8; ++kt) { const f32x4 d4 = *(const f32x4*)(drun + (size_t)im * 128 + 16 * kt + 4 * q); const f32x4 a4 = *(const f32x4*)(arun + (((size_t)im * 8 + w) * 8 + kt) * 256 + lane * 4); Sacc[kt] = Sacc[kt] * d4 + a4; } }
    }
    float dp = 1.0f;
    const int col = 2 * lane, sg = w;
    unsigned lfw[8], qw[8], vw[8];
#define HG_LOAD(ci_) do { const bf16_t* base_ = proj + (size_t)(b * LP + (ch0 + (ci_)) * 64 + 8 * sg) * NPROJ + h * 128 + col; \
        _Pragma("unroll") for (int j = 0; j < 8; ++j) { lfw[j] = *(const unsigned*)(base_ + (size_t)j * NPROJ + C_LF); vw[j] = *(const unsigned*)(base_ + (size_t)j * NPROJ + C_VA); qw[j] = OUT ? *(const unsigned*)(base_ + (size_t)j * NPROJ + C_QA) : 0u; } } while (0)
    HG_LOAD(0);
    for (int ci = 0; ci < nc; ++ci) {
        const int r0 = b * LP + (ch0 + ci) * 64;
        __syncthreads();
        u32x2 gwp[4];
        if (OUT) {
#pragma unroll
            for (int tt = 0; tt < 4; ++tt) gwp[tt] = *(const u32x2*)(proj + (size_t)(r0 + 16 * tt + c) * NPROJ + h * 128 + 16 * w + 4 * q + C_HG);
        }
        float cs0[8], cs1[8]; { float s0 = 0.f, s1 = 0.f;
#pragma unroll
            for (int j = 0; j < 8; ++j) { s0 += bf_lo(lfw[j]); cs0[j] = s0; s1 += bf_hi(lfw[j]); cs1[j] = s1; }
            seg[sg * 128 + col] = s0; seg[sg * 128 + col + 1] = s1; }
        __syncthreads();
        float base0 = 0.f, base1 = 0.f, bend0 = 0.f, bend1 = 0.f, bref0 = 0.f, bref1 = 0.f;
#pragma unroll
        for (int g = 0; g < 8; ++g) { const float a0 = seg[g * 128 + col], a1 = seg[g * 128 + col + 1]; if (g < sg) { base0 += a0; base1 += a1; } if (g < 4) { bref0 += a0; bref1 += a1; } bend0 += a0; bend1 += a1; }
        unsigned khw0[4], khw1[4];
        float kh0p = 0.f, kh1p = 0.f;
#pragma unroll
        for (int j = 0; j < 8; ++j) {
            const int t = 8 * sg + j;
            const float b0 = base0 + cs0[j], b1 = base1 + cs1[j];
            const float kk0 = 1.0f - __expf(bf_lo(lfw[j])), kk1 = 1.0f - __expf(bf_hi(lfw[j]));
            const float kh0 = kk0 * __expf(bend0 - b0), kh1 = kk1 * __expf(bend1 - b1);
            if (j & 1) { khw0[j >> 1] = cvt_pk_bf16(kh0p, kh0); khw1[j >> 1] = cvt_pk_bf16(kh1p, kh1); } else { kh0p = kh0; kh1p = kh1; }
            if (OUT) {
                const float q0 = bf_lo(qw[j]), q1 = bf_hi(qw[j]);
                *(LAS unsigned*)(lds + HG_QDP + t * RS_K + kperm(col) * 2) = cvt_pk_bf16(q0 * __expf(b0), q1 * __expf(b1));
                *(LAS unsigned*)(lds + HG_QS + t * RS_K + col * 2) = cvt_pk_bf16(q0 * expc(b0 - bref0), q1 * expc(b1 - bref1));
                *(LAS unsigned*)(lds + HG_KS + t * RS_K + col * 2) = cvt_pk_bf16(kk0 * expc(bref0 - b0), kk1 * expc(bref1 - b1));
            }
        }
        *(LAS u32x4*)(lds + HG_KHT + col * RS_T + 16 * sg) = (u32x4){khw0[0], khw0[1], khw0[2], khw0[3]};
        *(LAS u32x4*)(lds + HG_KHT + (col + 1) * RS_T + 16 * sg) = (u32x4){khw1[0], khw1[1], khw1[2], khw1[3]};
        { u32x4 v0, v1;
          v0.x = (vw[0] & 0xffffu) | (vw[1] << 16); v0.y = (vw[2] & 0xffffu) | (vw[3] << 16); v0.z = (vw[4] & 0xffffu) | (vw[5] << 16); v0.w = (vw[6] & 0xffffu) | (vw[7] << 16);
          v1.x = (vw[0] >> 16) | (vw[1] & 0xffff0000u); v1.y = (vw[2] >> 16) | (vw[3] & 0xffff0000u); v1.z = (vw[4] >> 16) | (vw[5] & 0xffff0000u); v1.w = (vw[6] >> 16) | (vw[7] & 0xffff0000u);
          *(LAS u32x4*)(lds + HG_VT + col * RS_T + 16 * sg) = v0; *(LAS u32x4*)(lds + HG_VT + (col + 1) * RS_T + 16 * sg) = v1; }
        if (sg == 7) { dend[col] = __expf(bend0); dend[col + 1] = __expf(bend1); }
        if (ci + 1 < nc) HG_LOAD(ci + 1);
        __syncthreads();
        if (!OUT) { if (tid < 128) dp *= dend[tid]; }
        if (OUT) {
#pragma unroll
            for (int rep = 0; rep < 2; ++rep) { const int id = w + 8 * rep, st = id >> 2, tt = id & 3;
                f32x4 acc = (f32x4){0.f, 0.f, 0.f, 0.f};
                if (st <= tt) {
#pragma unroll
                    for (int ks = 0; ks < 4; ++ks) { const bf16x8 a = *(const LAS bf16x8*)(lds + HG_KS + (16 * st + c) * RS_K + (32 * ks + 8 * q) * 2); const bf16x8 bq = *(const LAS bf16x8*)(lds + HG_QS + (16 * tt + c) * RS_K + (32 * ks + 8 * q) * 2); acc = mfma16(a, bq, acc); }
                }
                const int tq = 16 * tt + c, s0 = 16 * st + 4 * q;
                u32x2 o; o.x = cvt_pk_bf16(s0 <= tq ? acc[0] : 0.f, s0 + 1 <= tq ? acc[1] : 0.f); o.y = cvt_pk_bf16(s0 + 2 <= tq ? acc[2] : 0.f, s0 + 3 <= tq ? acc[3] : 0.f);
                *(LAS u32x2*)(lds + HG_AT + tq * RS_T + s0 * 2) = o; }
            __syncthreads();
            f32x4 oacc[4];
#pragma unroll
            for (int tt = 0; tt < 4; ++tt) oacc[tt] = (f32x4){0.f, 0.f, 0.f, 0.f};
#pragma unroll
            for (int ks = 0; ks < 4; ++ks) { const bf16x8 a = pack8(Sacc[2 * ks], Sacc[2 * ks + 1]);
#pragma unroll
                for (int tt = 0; tt < 4; ++tt) { const bf16x8 bq = *(const LAS bf16x8*)(lds + HG_QDP + (16 * tt + c) * RS_K + (32 * ks + 8 * q) * 2); oacc[tt] = mfma16(a, bq, oacc[tt]); } }
#pragma unroll
            for (int ss = 0; ss < 2; ++ss) { const bf16x8 a = *(const LAS bf16x8*)(lds + HG_VT + (16 * w + c) * RS_T + (32 * ss + 8 * q) * 2);
#pragma unroll
                for (int tt = 0; tt < 4; ++tt) { const bf16x8 bq = *(const LAS bf16x8*)(lds + HG_AT + (16 * tt + c) * RS_T + (32 * ss + 8 * q) * 2); oacc[tt] = mfma16(a, bq, oacc[tt]); } }
#pragma unroll
            for (int tt = 0; tt < 4; ++tt) { float p = oacc[tt][0] * oacc[tt][0] + oacc[tt][1] * oacc[tt][1] + oacc[tt][2] * oacc[tt][2] + oacc[tt][3] * oacc[tt][3];
                p += __shfl_xor(p, 16); p += __shfl_xor(p, 32); if (q == 0) part[w * 64 + 16 * tt + c] = p; }
            __syncthreads();
            const f32x4 gnv = *(const f32x4*)(gn + 16 * w + 4 * q);
#pragma unroll
            for (int tt = 0; tt < 4; ++tt) { float tot = 0.f;
#pragma unroll
                for (int ww = 0; ww < 8; ++ww) tot += part[ww * 64 + 16 * tt + c];
                const float rstd = rsqrtf(tot * (1.0f / 128.0f) + EPS);
                bf16_t* rp = proj + (size_t)(r0 + 16 * tt + c) * NPROJ + h * 128 + 16 * w + 4 * q;
                const u32x2 gw = gwp[tt];
                u32x2 o; o.x = cvt_pk_bf16(oacc[tt][0] * rstd * gnv[0] * bf_lo(gw.x), oacc[tt][1] * rstd * gnv[1] * bf_hi(gw.x));
                o.y = cvt_pk_bf16(oacc[tt][2] * rstd * gnv[2] * bf_lo(gw.y), oacc[tt][3] * rstd * gnv[3] * bf_hi(gw.y));
                if (ch0 + ci >= 1) *(u32x2*)(oa + (size_t)(b * SEQ + (ch0 + ci - 1) * 64 + 16 * tt + c) * 512 + h * 128 + 16 * w + 4 * q) = o; }
        }
#pragma unroll
        for (int kt = 0; kt < 8; ++kt) { const f32x4 d4 = *(const LAS f32x4*)(dend + 16 * kt + 4 * q); Sacc[kt] = Sacc[kt] * d4;
#pragma unroll
            for (int ts = 0; ts < 2; ++ts) { const bf16x8 a = *(const LAS bf16x8*)(lds + HG_KHT + (16 * kt + c) * RS_T + (32 * ts + 8 * q) * 2); const bf16x8 bq = *(const LAS bf16x8*)(lds + HG_VT + (16 * w + c) * RS_T + (32 * ts + 8 * q) * 2); Sacc[kt] = mfma16(a, bq, Sacc[kt]); } }
    }
    if (!OUT) {
#pragma unroll
        for (int kt = 0; kt < 8; ++kt) *(f32x4*)(arun + (((size_t)item * 8 + w) * 8 + kt) * 256 + lane * 4) = Sacc[kt];
        if (tid < 128) drun[(size_t)item * 128 + tid] = dp;
    }
    __syncthreads();
#undef HG_LOAD
}


constexpr int GB_KN = 0, GB_QN = 17408, GB_RTK = 34816, GB_RTV = 53248, GB_TM = 71680, GB_LM = 80896, GB_TF = 98304, GB_XS = 115712, LST = 68;
constexpr int GD_NITEM = NB * 129 * 4;
struct GdnBufs { bf16_t* QT; bf16_t* AT; bf16_t* WP; bf16_t* U0T; bf16_t* KHT; float* GEND; };

__device__ __forceinline__ void head_norm_store(f32x4 (&oacc)[4], LAS float* part, bf16_t* proj, int r0, int h, int cgate, int cout, const float* gn, int w, int c, int q) {
#pragma unroll
    for (int tt = 0; tt < 4; ++tt) { float p = oacc[tt][0] * oacc[tt][0] + oacc[tt][1] * oacc[tt][1] + oacc[tt][2] * oacc[tt][2] + oacc[tt][3] * oacc[tt][3];
        p += __shfl_xor(p, 16); p += __shfl_xor(p, 32); if (q == 0) part[w * 64 + 16 * tt + c] = p; }
    __syncthreads();
    const f32x4 gnv = *(const f32x4*)(gn + 16 * w + 4 * q);
#pragma unroll
    for (int tt = 0; tt < 4; ++tt) { float tot = 0.f;
#pragma unroll
        for (int ww = 0; ww < 8; ++ww) tot += part[ww * 64 + 16 * tt + c];
        const float rstd = rsqrtf(tot * (1.0f / 128.0f) + EPS);
        bf16_t* rp = proj + (size_t)(r0 + 16 * tt + c) * NPROJ + h * 128 + 16 * w + 4 * q;
        const u32x2 gw = *(const u32x2*)(rp + cgate);
        u32x2 o; o.x = cvt_pk_bf16(oacc[tt][0] * rstd * gnv[0] * bf_lo(gw.x), oacc[tt][1] * rstd * gnv[1] * bf_hi(gw.x));
        o.y = cvt_pk_bf16(oacc[tt][2] * rstd * gnv[2] * bf_lo(gw.y), oacc[tt][3] * rstd * gnv[3] * bf_hi(gw.y));
        *(u32x2*)(rp + cout) = o; }
}

constexpr int GB_CW = 118784;
struct GdnBRegs { unsigned xq[11], xk[11], xv[11]; float Gl, betal; };
__device__ __forceinline__ void gdn_phaseB_load(GdnBRegs& R, const bf16_t* proj, const float* gbf, int item, int tid) {
    const int sg = __builtin_amdgcn_readfirstlane(tid >> 6), lane = tid & 63, col = 2 * lane;
    const int h = item & 3, bc = item >> 2, b = bc / 129, ch = bc % 129, r0 = b * LP + ch * 64;
    R.Gl = gbf[(size_t)(r0 + lane) * 8 + 4 + h]; R.betal = gbf[(size_t)(r0 + lane) * 8 + h];
#pragma unroll
    for (int i = 0; i < 11; ++i) { const int pp = ch * 64 + 8 * sg - 3 + i;
        if (pp >= 48) { const bf16_t* rp = proj + (size_t)(b * LP + pp) * NPROJ + h * 128 + col; R.xq[i] = *(const unsigned*)(rp + C_GQ); R.xk[i] = *(const unsigned*)(rp + C_GK); R.xv[i] = *(const unsigned*)(rp + C_GV); }
        else { R.xq[i] = 0u; R.xk[i] = 0u; R.xv[i] = 0u; } }
}

__device__ __forceinline__ int gdn_phaseB(LAS unsigned char* lds, const bf16_t* proj, const float* gbf, const GdnBufs& G, int item, GdnBRegs& R, unsigned* q2, unsigned& tk) {
    int tid_ = threadIdx.x; asm volatile("" : "+v"(tid_));
    const int tid = tid_, w = __builtin_amdgcn_readfirstlane(tid >> 6), lane = tid & 63, c = lane & 15, q = lane >> 4;
    const int h = item & 3, bc = item >> 2, b = bc / 129, ch = bc % 129;
    const int r0 = b * LP + ch * 64;
    const int col = 2 * lane, sg = w;
    LAS float* Lm = (LAS float*)(lds + GB_LM);
    LAS int* qit = (LAS int*)(lds + LDS_BYTES - 64);
    __syncthreads();
    LAS unsigned long long* tsq = (LAS unsigned long long*)(lds + LDS_BYTES - 256);
    unsigned long long tq0 = 0; if (PROBE_PH >= 0 && blockIdx.x == 0 && tid == 0) tq0 = __builtin_amdgcn_s_memrealtime();
    float Gl = R.Gl; const float betal = R.betal;
#pragma unroll
    for (int off = 1; off < 64; off <<= 1) { const float v = __shfl_up(Gl, off); if (lane >= off) Gl += v; }
    const float Gend = __builtin_bit_cast(float, __builtin_amdgcn_readlane(__builtin_bit_cast(int, Gl), 63));
    float cq[4][2], ck[4][2], cv[4][2];
#pragma unroll
    for (int j = 0; j < 4; ++j) { const LAS float* p = (const LAS float*)(lds + GB_CW) + j * 1536 + h * 128 + col; const f32x2_t a = *(const LAS f32x2_t*)p, bq = *(const LAS f32x2_t*)(p + 512), cc = *(const LAS f32x2_t*)(p + 1024);
        cq[j][0] = a[0]; cq[j][1] = a[1]; ck[j][0] = bq[0]; ck[j][1] = bq[1]; cv[j][0] = cc[0]; cv[j][1] = cc[1]; }
    unsigned xq[11], xk[11], xv[11];
#pragma unroll
    for (int i = 0; i < 11; ++i) { xq[i] = R.xq[i]; xk[i] = R.xk[i]; xv[i] = R.xv[i]; }
    unsigned rtk0[4], rtk1[4], rtv0[4], rtv1[4], kh0[4], kh1[4];
    float pk0 = 0.f, pk1 = 0.f, pv0 = 0.f, pv1 = 0.f, ph0 = 0.f, ph1 = 0.f;
    bf16_t* qt = G.QT + (size_t)item * 8192;
#pragma unroll
    for (int j = 0; j < 8; ++j) {
        const int t = 8 * sg + j;
        float q0 = 0.f, q1 = 0.f, k0 = 0.f, k1 = 0.f, v0 = 0.f, v1 = 0.f;
#pragma unroll
        for (int jj = 0; jj < 4; ++jj) { q0 += cq[jj][0] * bf_lo(xq[j + jj]); q1 += cq[jj][1] * bf_hi(xq[j + jj]); k0 += ck[jj][0] * bf_lo(xk[j + jj]); k1 += ck[jj][1] * bf_hi(xk[j + jj]); v0 += cv[jj][0] * bf_lo(xv[j + jj]); v1 += cv[jj][1] * bf_hi(xv[j + jj]); }
        q0 = siluf_(q0); q1 = siluf_(q1); k0 = siluf_(k0); k1 = siluf_(k1); v0 = siluf_(v0); v1 = siluf_(v1);
        const float sq = rsqrtf(wave_sum(q0 * q0 + q1 * q1) + EPS) * 0.08838834764831845f, sk = rsqrtf(wave_sum(k0 * k0 + k1 * k1) + EPS);
        q0 *= sq; q1 *= sq; k0 *= sk; k1 *= sk;
        const float Gt = __builtin_bit_cast(float, __builtin_amdgcn_readlane(__builtin_bit_cast(int, Gl), t)), bt = __builtin_bit_cast(float, __builtin_amdgcn_readlane(__builtin_bit_cast(int, betal), t));
        const float eg = __expf(Gt), eh = __expf(Gend - Gt);
        *(LAS unsigned*)(lds + GB_KN + t * RS_K + col * 2) = cvt_pk_bf16(k0, k1);
        *(LAS unsigned*)(lds + GB_QN + t * RS_K + col * 2) = cvt_pk_bf16(q0, q1);
        *(unsigned*)(qt + t * 128 + kperm(col)) = cvt_pk_bf16(q0 * eg, q1 * eg);
        const float rk0 = bt * eg * k0, rk1 = bt * eg * k1, rv0 = bt * v0, rv1 = bt * v1, h0 = k0 * eh, h1 = k1 * eh;
        if (j & 1) { rtk0[j >> 1] = cvt_pk_bf16(pk0, rk0); rtk1[j >> 1] = cvt_pk_bf16(pk1, rk1); rtv0[j >> 1] = cvt_pk_bf16(pv0, rv0); rtv1[j >> 1] = cvt_pk_bf16(pv1, rv1); kh0[j >> 1] = cvt_pk_bf16(ph0, h0); kh1[j >> 1] = cvt_pk_bf16(ph1, h1); }
        else { pk0 = rk0; pk1 = rk1; pv0 = rv0; pv1 = rv1; ph0 = h0; ph1 = h1; }
    }
    *(LAS u32x4*)(lds + GB_RTK + col * RS_T + 16 * sg) = (u32x4){rtk0[0], rtk0[1], rtk0[2], rtk0[3]};
    *(LAS u32x4*)(lds + GB_RTK + (col + 1) * RS_T + 16 * sg) = (u32x4){rtk1[0], rtk1[1], rtk1[2], rtk1[3]};
    *(LAS u32x4*)(lds + GB_RTV + col * RS_T + 16 * sg) = (u32x4){rtv0[0], rtv0[1], rtv0[2], rtv0[3]};
    *(LAS u32x4*)(lds + GB_RTV + (col + 1) * RS_T + 16 * sg) = (u32x4){rtv1[0], rtv1[1], rtv1[2], rtv1[3]};
    {
      const int pbase = 32 * (sg >> 2) + 16 * (sg & 1) + 4 * ((sg & 3) >> 1);
      bf16_t* kp = G.KHT + (size_t)item * 8192;
      *(u32x2*)(kp + col * 64 + pbase) = (u32x2){kh0[0], kh0[1]}; *(u32x2*)(kp + col * 64 + pbase + 8) = (u32x2){kh0[2], kh0[3]};
      *(u32x2*)(kp + (col + 1) * 64 + pbase) = (u32x2){kh1[0], kh1[1]}; *(u32x2*)(kp + (col + 1) * 64 + pbase + 8) = (u32x2){kh1[2], kh1[3]}; }
    if (tid == 0) { G.GEND[item] = Gend; qit[1] = (int)tk; }
    __syncthreads();
    const int nxt = qit[1];
    if (tid == 0) tk = atomicAdd(q2, 1u);
    if (nxt < GD_NITEM) gdn_phaseB_load(R, proj, gbf, nxt, tid);
    if (PROBE_PH >= 0 && blockIdx.x == 0 && tid == 0) { const unsigned long long t_ = __builtin_amdgcn_s_memrealtime(); tsq[14] += t_ - tq0; tq0 = t_; }
#pragma unroll
    for (int rep = 0; rep < 2; ++rep) { const int id = w + 8 * rep;
        if (id < 10) { int st, tt; if (id < 4) { st = 0; tt = id; } else if (id < 7) { st = 1; tt = id - 3; } else if (id < 9) { st = 2; tt = id - 5; } else { st = 3; tt = 3; }
            f32x4 acc = (f32x4){0.f, 0.f, 0.f, 0.f};
#pragma unroll
            for (int ks = 0; ks < 4; ++ks) { const bf16x8 a = *(const LAS bf16x8*)(lds + GB_KN + (16 * st + c) * RS_K + (32 * ks + 8 * q) * 2); const bf16x8 bq = *(const LAS bf16x8*)(lds + GB_KN + (16 * tt + c) * RS_K + (32 * ks + 8 * q) * 2); acc = mfma16(a, bq, acc); }
            const int tq = 16 * tt + c, s0 = 16 * st + 4 * q;
            const float Gt = __shfl(Gl, tq), bt = __shfl(betal, tq);
            f32x4 o;
#pragma unroll
            for (int i = 0; i < 4; ++i) { const float Gs = __shfl(Gl, s0 + i); o[i] = bt * __expf(fminf(Gt - Gs, 0.f)) * acc[i]; }
            *(LAS f32x4*)(Lm + tq * LST + s0) = o; } }
    __syncthreads();
    if (PROBE_PH >= 0 && blockIdx.x == 0 && tid == 0) tq0 = __builtin_amdgcn_s_memrealtime();
    LAS float* Tf = (LAS float*)(lds + GB_TF); LAS float* Xs = (LAS float*)(lds + GB_XS);
    if (w == 0) {
        const int bb = lane >> 4, cl = lane & 15;
        f32x4 lr[16][4];
#pragma unroll
        for (int i = 1; i < 16; ++i)
#pragma unroll
            for (int j = 0; j < i; j += 4) lr[i][j >> 2] = *(const LAS f32x4*)(Lm + (16 * bb + i) * LST + 16 * bb + j);
        float Dc[16];
#pragma unroll
        for (int i = 0; i < 16; ++i) { float acc = (i == cl) ? 1.0f : 0.0f;
#pragma unroll
            for (int j = 0; j < i; ++j) acc -= lr[i][j >> 2][j & 3] * Dc[j];
            Dc[i] = acc; }
#pragma unroll
        for (int i = 0; i < 16; ++i) Tf[(16 * bb + i) * LST + 16 * bb + cl] = Dc[i];
    } else {
        bf16_t* at = G.AT + (size_t)item * 4096;
        for (int id = w - 1; id < 16; id += 7) { const int st = id >> 2, tt = id & 3;
            f32x4 acc = (f32x4){0.f, 0.f, 0.f, 0.f};
            if (st <= tt) {
#pragma unroll
                for (int ks = 0; ks < 4; ++ks) { const bf16x8 a = *(const LAS bf16x8*)(lds + GB_KN + (16 * st + c) * RS_K + (32 * ks + 8 * q) * 2); const bf16x8 bq = *(const LAS bf16x8*)(lds + GB_QN + (16 * tt + c) * RS_K + (32 * ks + 8 * q) * 2); acc = mfma16(a, bq, acc); } }
            const int tq = 16 * tt + c, s0 = 16 * st + 4 * q;
            const float Gt = __shfl(Gl, tq);
            float o[4];
#pragma unroll
            for (int i = 0; i < 4; ++i) { const float Gs = __shfl(Gl, s0 + i); o[i] = (s0 + i <= tq) ? __expf(fminf(Gt - Gs, 0.f)) * acc[i] : 0.f; }
            *(u32x2*)(at + tq * 64 + 32 * (st >> 1) + 8 * q + 4 * (st & 1)) = (u32x2){cvt_pk_bf16(o[0], o[1]), cvt_pk_bf16(o[2], o[3])}; }
    }
    __syncthreads();
#pragma unroll
    for (int d = 1; d < 4; ++d) {
        if (w < 4 - d) { const int I = w + d, J = w;
            f32x4 X = (f32x4){0.f, 0.f, 0.f, 0.f};
            for (int M = J; M < I; ++M) {
#pragma unroll
                for (int m = 0; m < 4; ++m) X = __builtin_amdgcn_mfma_f32_16x16x4f32(Lm[(16 * I + c) * LST + 16 * M + 4 * m + q], Tf[(16 * M + 4 * m + q) * LST + 16 * J + c], X, 0, 0, 0); }
#pragma unroll
            for (int i = 0; i < 4; ++i) Xs[w * 256 + (4 * q + i) * 16 + c] = X[i];
            f32x4 Tb = (f32x4){0.f, 0.f, 0.f, 0.f};
#pragma unroll
            for (int m = 0; m < 4; ++m) Tb = __builtin_amdgcn_mfma_f32_16x16x4f32(Tf[(16 * I + c) * LST + 16 * I + 4 * m + q], Xs[w * 256 + (4 * m + q) * 16 + c], Tb, 0, 0, 0);
#pragma unroll
            for (int i = 0; i < 4; ++i) Tf[(16 * I + 4 * q + i) * LST + 16 * J + c] = -Tb[i]; }
        __syncthreads();
    }
    {
      const int row = tid >> 3, c8 = (tid & 7) * 8;
      f32x4 t0 = *(const LAS f32x4*)(Tf + row * LST + c8), t1 = *(const LAS f32x4*)(Tf + row * LST + c8 + 4);
      if ((c8 >> 4) > (row >> 4)) { t0 = (f32x4){0.f, 0.f, 0.f, 0.f}; t1 = t0; }
      *(LAS u32x4*)(lds + GB_TM + row * RS_T + c8 * 2) = (u32x4){cvt_pk_bf16(t0[0], t0[1]), cvt_pk_bf16(t0[2], t0[3]), cvt_pk_bf16(t1[0], t1[1]), cvt_pk_bf16(t1[2], t1[3])}; }
    __syncthreads();
    if (PROBE_PH >= 0 && blockIdx.x == 0 && tid == 0) tsq[15] += __builtin_amdgcn_s_memrealtime() - tq0;
    { bf16_t* wp = G.WP + (size_t)item * 8192; bf16_t* u0 = G.U0T + (size_t)item * 8192;
#pragma unroll
      for (int tt = 0; tt < 4; ++tt) {
          f32x4 aw = (f32x4){0.f, 0.f, 0.f, 0.f}, au = (f32x4){0.f, 0.f, 0.f, 0.f};
#pragma unroll
          for (int ss = 0; ss < 2; ++ss) { if (ss == 1 && tt < 2) continue;
              const bf16x8 tb = *(const LAS bf16x8*)(lds + GB_TM + (16 * tt + c) * RS_T + (32 * ss + 8 * q) * 2);
              const bf16x8 ak = *(const LAS bf16x8*)(lds + GB_RTK + (16 * w + c) * RS_T + (32 * ss + 8 * q) * 2);
              const bf16x8 bv = *(const LAS bf16x8*)(lds + GB_RTV + (16 * w + c) * RS_T + (32 * ss + 8 * q) * 2);
              aw = mfma16(ak, tb, aw);
              au = mfma16(tb, bv, au); }
          *(u32x2*)(wp + (16 * tt + c) * 128 + 32 * (w >> 1) + 8 * q + 4 * (w & 1)) = (u32x2){cvt_pk_bf16(aw[0], aw[1]), cvt_pk_bf16(aw[2], aw[3])};
          *(u32x2*)(u0 + (16 * w + c) * 64 + 32 * (tt >> 1) + 8 * q + 4 * (tt & 1)) = (u32x2){cvt_pk_bf16(au[0], au[1]), cvt_pk_bf16(au[2], au[3])}; } }
    return nxt;
}

__device__ __forceinline__ bf16_t* snt_ptr(bf16_t* proj, int r0, int h, int v) { return proj + (size_t)(r0 + (v & 63)) * NPROJ + (v < 64 ? C_GQ : C_GK) + h * 128; }

__device__ __forceinline__ void gdn_scan(LAS unsigned char* lds, bf16_t* proj, const GdnBufs& G, int unit) {
    const int tid = threadIdx.x, w = __builtin_amdgcn_readfirstlane(tid >> 6), lane = tid & 63, c = lane & 15, q = lane >> 4;
    const int bh = unit >> 3, slice = unit & 7, b = bh >> 2, h = bh & 3;
    constexpr int SLOT = 32768, OW = 0, OK_ = 16384, OU = 3 * SLOT, OATAB = OU + 6 * 2048, OFLAG = OATAB + 1024;
    const int item0 = (b * 129) * 4 + h;
    LAS float* atab = (LAS float*)(lds + OATAB);
    volatile LAS unsigned* rdy = (volatile LAS unsigned*)(lds + OFLAG);
    volatile LAS unsigned* prog = (volatile LAS unsigned*)(lds + OFLAG + 64);
    __syncthreads();
    if (tid < 129) atab[tid] = __expf(G.GEND[item0 + 4 * tid]);
    if (tid < 16) rdy[tid] = 0u; if (tid >= 16 && tid < 20) prog[tid - 16] = 0u;
    asm volatile("s_waitcnt vmcnt(0) lgkmcnt(0)" ::: "memory");
    __syncthreads();
    if (w >= 4) {
        const int j = w - 4;
        u32x4 R[32];
#define GS_LD(m_) do { const int it_ = item0 + 4 * (m_); const char* wp_ = (const char*)(G.WP + (size_t)it_ * 8192); const char* kp_ = (const char*)(G.KHT + (size_t)it_ * 8192); const char* up_ = (const char*)(G.U0T + (size_t)it_ * 8192) + slice * 2048; \
        _Pragma("unroll") for (int i = 0; i < 16; ++i) { const int rw = 4 * i + (lane >> 4); R[i] = *(const u32x4*)(wp_ + rw * 256 + (((lane & 15) ^ (rw & 15)) << 4)); \
            const int rk = 8 * i + (lane >> 3); R[16 + i] = *(const u32x4*)(kp_ + rk * 128 + (((lane & 7) ^ (rk & 7)) << 4)); } \
        LAS unsigned char* ud_ = lds + OU + ((m_) % 6) * 2048; \
        _Pragma("unroll") for (int i = 0; i < 2; ++i) __builtin_amdgcn_global_load_lds((const unsigned*)(up_ + (lane + 64 * i) * 16), (LAS unsigned*)(ud_ + i * 1024), 16, 0, 0); } while (0)
#define GS_ST(slot_) do { LAS unsigned char* d_ = lds + (slot_) * SLOT + lane * 16; \
        _Pragma("unroll") for (int i = 0; i < 16; ++i) { *(LAS u32x4*)(d_ + OW + i * 1024) = R[i]; *(LAS u32x4*)(d_ + OK_ + i * 1024) = R[16 + i]; } } while (0)
#define GS_WAIT_PROG(need_) do { const unsigned nd_ = (unsigned)(need_); while (prog[0] < nd_) __builtin_amdgcn_s_sleep(1); asm volatile("" ::: "memory"); } while (0)
        GS_LD(j);
        for (int m = j; m <= 128; m += 4) {
            if (m >= 3) GS_WAIT_PROG(m - 2);
            asm volatile("s_waitcnt vmcnt(0)" ::: "memory");
            GS_ST(m % 3);
            asm volatile("s_waitcnt lgkmcnt(0)" ::: "memory");
            if (lane == 0) rdy[m & 7] = (unsigned)(m + 1);
            if (m + 4 <= 128) { if (m >= 2) GS_WAIT_PROG(m - 1);
                GS_LD(m + 4); }
        }
        asm volatile("s_waitcnt vmcnt(0) lgkmcnt(0)" ::: "memory");
#undef GS_LD
#undef GS_ST
#undef GS_WAIT_PROG
    } else if (w == 0) {
        const int vl = c, v = 16 * slice + vl;
        f32x4 Sacc[8];
#pragma unroll
        for (int kt = 0; kt < 8; ++kt) Sacc[kt] = (f32x4){0.f, 0.f, 0.f, 0.f};
        int slot = 0;
        for (int n = 0; n < 129; ++n) {
            const int item = item0 + 4 * n, r0 = b * LP + n * 64;
            while (rdy[n & 7] != (unsigned)(n + 1)) __builtin_amdgcn_s_sleep(1);
            asm volatile("" ::: "memory");
            LAS unsigned char* cur = lds + slot * SLOT;
            const float a = atab[n];
            bf16_t* sp = snt_ptr(proj, r0, h, v) + 8 * q;
            f32x4 u[4];
#pragma unroll
            for (int tt = 0; tt < 4; ++tt) u[tt] = (f32x4){0.f, 0.f, 0.f, 0.f};
#pragma unroll
            for (int ks = 0; ks < 4; ++ks) { const bf16x8 sb = pack8(Sacc[2 * ks], Sacc[2 * ks + 1]);
                *(bf16x8*)(sp + 32 * ks) = sb;
#pragma unroll
                for (int tt = 0; tt < 4; ++tt) { const bf16x8 aw = *(const LAS bf16x8*)(cur + OW + (16 * tt + c) * 256 + (((4 * ks + q) ^ c) << 4)); u[tt] = mfma16(aw, sb, u[tt]); } }
            bf16_t* up = G.U0T + (size_t)item * 8192 + v * 64 + 8 * q;
#pragma unroll
            for (int kt = 0; kt < 8; ++kt) Sacc[kt] = Sacc[kt] * a;
#pragma unroll
            for (int ts = 0; ts < 2; ++ts) { const u32x4 u0w = *(const LAS u32x4*)(lds + OU + (n % 6) * 2048 + vl * 128 + (32 * ts + 8 * q) * 2);
                f32x4 ua, ub_;
                ua[0] = bf_lo(u0w.x) - u[2 * ts][0]; ua[1] = bf_hi(u0w.x) - u[2 * ts][1]; ua[2] = bf_lo(u0w.y) - u[2 * ts][2]; ua[3] = bf_hi(u0w.y) - u[2 * ts][3];
                ub_[0] = bf_lo(u0w.z) - u[2 * ts + 1][0]; ub_[1] = bf_hi(u0w.z) - u[2 * ts + 1][1]; ub_[2] = bf_lo(u0w.w) - u[2 * ts + 1][2]; ub_[3] = bf_hi(u0w.w) - u[2 * ts + 1][3];
                const bf16x8 ub = pack8(ua, ub_);
                *(bf16x8*)(up + 32 * ts) = ub;
#pragma unroll
                for (int kt = 0; kt < 8; ++kt) { const bf16x8 ak = *(const LAS bf16x8*)(cur + OK_ + (16 * kt + c) * 128 + (((4 * ts + q) ^ (c & 7)) << 4)); Sacc[kt] = mfma16(ak, ub, Sacc[kt]); } }
            asm volatile("s_waitcnt lgkmcnt(0)" ::: "memory");
            if (lane == 0) prog[0] = (unsigned)(n + 1);
            slot = slot + 1; if (slot >= 3) slot -= 3;
            if (PROBE_PH >= 0 && blockIdx.x == 0 && tid == 0) { LAS unsigned long long* tsw_ = (LAS unsigned long long*)(lds + LDS_BYTES - 256); if (n == 63) tsw_[12] = __builtin_amdgcn_s_memrealtime(); if (n == 128) tsw_[13] = __builtin_amdgcn_s_memrealtime(); }
        }
    }
    __syncthreads();
}

struct GdnDRegs { u32x4 q0, q1, a0; bf16x8 as_[4], au_[2]; u32x2 gz[4]; };
__device__ __forceinline__ void gdn_phaseD_load(GdnDRegs& R, bf16_t* proj, const GdnBufs& G, int item, int tid) {
    const int w = tid >> 6, lane = tid & 63, c = lane & 15, q = lane >> 4;
    const int h = item & 3, bc = item >> 2, b = bc / 129, ch = bc % 129, r0 = b * LP + ch * 64, v = 16 * w + c;
    const u32x4* qp = (const u32x4*)(G.QT + (size_t)item * 8192); const u32x4* ap = (const u32x4*)(G.AT + (size_t)item * 4096);
    R.q0 = qp[tid]; R.q1 = qp[tid + 512]; R.a0 = ap[tid];
    const bf16_t* sp = snt_ptr(proj, r0, h, v) + 8 * q; const bf16_t* up = G.U0T + (size_t)item * 8192 + v * 64 + 8 * q;
#pragma unroll
    for (int ks = 0; ks < 4; ++ks) R.as_[ks] = *(const bf16x8*)(sp + 32 * ks);
#pragma unroll
    for (int ss = 0; ss < 2; ++ss) R.au_[ss] = *(const bf16x8*)(up + 32 * ss);
#pragma unroll
    for (int tt = 0; tt < 4; ++tt) R.gz[tt] = *(const u32x2*)(proj + (size_t)(r0 + 16 * tt + c) * NPROJ + h * 128 + 16 * w + 4 * q + C_GZ);
}
__device__ __forceinline__ int gdn_d_next(int it, int stride) { it += stride; while (it < GD_NITEM && (it >> 2) % 129 == 0) it += stride; return it; }
__device__ __forceinline__ void gdn_phaseD_all(LAS unsigned char* lds, bf16_t* proj, const GdnBufs& G, const float* gn, int first, int stride, bf16_t* ob) {
    int tid_ = threadIdx.x; asm volatile("" : "+v"(tid_));
    const int tid = tid_, w = tid >> 6, lane = tid & 63, c = lane & 15, q = lane >> 4;
    constexpr int OQ = 0, OA = 17408, OP = 26624;
    LAS float* part = (LAS float*)(lds + OP);
    int it = first - stride; it = gdn_d_next(it, stride);
    GdnDRegs R;
    if (it < GD_NITEM) gdn_phaseD_load(R, proj, G, it, tid);
    while (it < GD_NITEM) {
        const int item = it, h = item & 3, bc = item >> 2, b = bc / 129, ch = bc % 129, r0 = b * LP + ch * 64;
        __syncthreads();
        *(LAS u32x4*)(lds + OQ + (tid >> 4) * RS_K + (tid & 15) * 16) = R.q0; *(LAS u32x4*)(lds + OQ + ((tid + 512) >> 4) * RS_K + (tid & 15) * 16) = R.q1;
        *(LAS u32x4*)(lds + OA + (tid >> 3) * RS_T + (tid & 7) * 16) = R.a0;
        bf16x8 as_[4], au_[2]; u32x2 gz[4];
#pragma unroll
        for (int ks = 0; ks < 4; ++ks) as_[ks] = R.as_[ks];
#pragma unroll
        for (int ss = 0; ss < 2; ++ss) au_[ss] = R.au_[ss];
#pragma unroll
        for (int tt = 0; tt < 4; ++tt) gz[tt] = R.gz[tt];
        it = gdn_d_next(it, stride);
        if (it < GD_NITEM) gdn_phaseD_load(R, proj, G, it, tid);
        __syncthreads();
        f32x4 oacc[4];
#pragma unroll
        for (int tt = 0; tt < 4; ++tt) oacc[tt] = (f32x4){0.f, 0.f, 0.f, 0.f};
#pragma unroll
        for (int ks = 0; ks < 4; ++ks)
#pragma unroll
            for (int tt = 0; tt < 4; ++tt) { const bf16x8 bq = *(const LAS bf16x8*)(lds + OQ + (16 * tt + c) * RS_K + (32 * ks + 8 * q) * 2); oacc[tt] = mfma16(as_[ks], bq, oacc[tt]); }
#pragma unroll
        for (int ss = 0; ss < 2; ++ss)
#pragma unroll
            for (int tt = 0; tt < 4; ++tt) { const bf16x8 bq = *(const LAS bf16x8*)(lds + OA + (16 * tt + c) * RS_T + (32 * ss + 8 * q) * 2); oacc[tt] = mfma16(au_[ss], bq, oacc[tt]); }
#pragma unroll
        for (int tt = 0; tt < 4; ++tt) { float p = oacc[tt][0] * oacc[tt][0] + oacc[tt][1] * oacc[tt][1] + oacc[tt][2] * oacc[tt][2] + oacc[tt][3] * oacc[tt][3];
            p += __shfl_xor(p, 16); p += __shfl_xor(p, 32); if (q == 0) part[w * 64 + 16 * tt + c] = p; }
        __syncthreads();
        const f32x4 gnv = *(const f32x4*)(gn + 16 * w + 4 * q);
#pragma unroll
        for (int tt = 0; tt < 4; ++tt) { float tot = 0.f;
#pragma unroll
            for (int ww = 0; ww < 8; ++ww) tot += part[ww * 64 + 16 * tt + c];
            const float rstd = rsqrtf(tot * (1.0f / 128.0f) + EPS);
            const u32x2 gw = gz[tt];
            u32x2 o; o.x = cvt_pk_bf16(oacc[tt][0] * rstd * gnv[0] * bf_lo(gw.x), oacc[tt][1] * rstd * gnv[1] * bf_hi(gw.x));
            o.y = cvt_pk_bf16(oacc[tt][2] * rstd * gnv[2] * bf_lo(gw.y), oacc[tt][3] * rstd * gnv[3] * bf_hi(gw.y));
            *(u32x2*)(ob + (size_t)(b * SEQ + (ch - 1) * 64 + 16 * tt + c) * 512 + h * 128 + 16 * w + 4 * q) = o; }
    }
    __syncthreads();
}

constexpr int RW_ST = 1040, RW_OLG = 73 * RW_ST, RW_OCN = RW_OLG + 8 * 16 * 52 * 4;
__device__ __forceinline__ void p_router(LAS unsigned char* lds, const bf16_t* h1b, const float* g2, const float* rgw, const float* rgb, const float* rew, const float* reb, int* cnt, int* list, float* rs, int* asg) {
    LAS int* lcnt = (LAS int*)(lds + RW_OCN);
    LAS int* dec = lcnt + 64;
    const int tid = threadIdx.x, wv = tid >> 6, l = tid & 63, c = l & 15, q = l >> 4;
    const int rows_cap = (T + (int)gridDim.x - 1) / (int)gridDim.x;
    const int rbase = blockIdx.x * rows_cap; const int rend = (rbase + rows_cap <= T) ? rbase + rows_cap : T;
    LAS float* lg = (LAS float*)(lds + RW_OLG) + wv * 16 * 52;
    for (int p0 = rbase; p0 < rend; p0 += 128) {
        const int rows_per = (rend - p0) < 128 ? (rend - p0) : 128;
        __syncthreads();
        if (tid < 64) lcnt[tid] = 0;
        const bool valid = (wv * 16 + c) < rows_per;
        const int row = valid ? p0 + wv * 16 + c : p0;
        u32x4 xa[16][2];
#pragma unroll
        for (int j = 0; j < 16; ++j)
#pragma unroll
            for (int s_ = 0; s_ < 2; ++s_) xa[j][s_] = *(const u32x4*)(h1b + (size_t)row * D + 64 * j + 16 * q + 8 * s_);
        f32x4 acc[3], accS = (f32x4){0.f, 0.f, 0.f, 0.f};
#pragma unroll
        for (int ct = 0; ct < 3; ++ct) acc[ct] = (f32x4){0.f, 0.f, 0.f, 0.f};
        int rhi[3], rlo[3];
#pragma unroll
        for (int ct = 0; ct < 3; ++ct) { const int n = 16 * ct + c; rhi[ct] = (n < 36 ? n : 72) * RW_ST + 32 * q; rlo[ct] = (n < 36 ? 36 + n : 72) * RW_ST + 32 * q; }
#pragma unroll
        for (int half = 0; half < 2; ++half) {
            if (half) __syncthreads();
            const int k0 = 512 * half;
            for (int i = tid; i < 512; i += NTHR) { const int k = k0 + i; const f32x4 g = *(const f32x4*)(rgw + 4 * k); const float gg = g2[k];
#pragma unroll
                for (int n = 0; n < 4; ++n) { const float w = g[n] * gg; const bf16_t hi = f2bf(w); *(LAS bf16_t*)(lds + n * RW_ST + i * 2) = hi; *(LAS bf16_t*)(lds + (36 + n) * RW_ST + i * 2) = f2bf(w - bf2f(hi)); } }
            for (int i = tid; i < 512 * 8; i += NTHR) { const int kk = i >> 3, j = (i & 7) * 4; const f32x4 g = *(const f32x4*)(rew + (size_t)(k0 + kk) * 32 + j); const float gg = g2[k0 + kk];
#pragma unroll
                for (int n = 0; n < 4; ++n) { const float w = g[n] * gg; const bf16_t hi = f2bf(w); *(LAS bf16_t*)(lds + (4 + j + n) * RW_ST + kk * 2) = hi; *(LAS bf16_t*)(lds + (40 + j + n) * RW_ST + kk * 2) = f2bf(w - bf2f(hi)); } }
            if (tid < RW_ST / 16) *(LAS u32x4*)(lds + 72 * RW_ST + tid * 16) = (u32x4){0u, 0u, 0u, 0u};
            __syncthreads();
#pragma unroll
            for (int jj = 0; jj < 8; ++jj)
#pragma unroll
                for (int s_ = 0; s_ < 2; ++s_) { const bf16x8 a = __builtin_bit_cast(bf16x8, xa[8 * half + jj][s_]);
                    accS = mfma16(a, a, accS);
#pragma unroll
                    for (int ct = 0; ct < 3; ++ct) { const bf16x8 bh = *(const LAS bf16x8*)(lds + rhi[ct] + 128 * jj + 16 * s_); const bf16x8 bl = *(const LAS bf16x8*)(lds + rlo[ct] + 128 * jj + 16 * s_);
                        acc[ct] = mfma16(a, bh, acc[ct]); acc[ct] = mfma16(a, bl, acc[ct]); } }
        }
        const float sd = (c & 3) == 0 ? accS[0] : (c & 3) == 1 ? accS[1] : (c & 3) == 2 ? accS[2] : accS[3];
        const float ssq = __shfl(sd, c + 16 * (c >> 2));
        const float rstd = rsqrtf(ssq * (1.0f / D) + EPS);
#pragma unroll
        for (int ct = 0; ct < 3; ++ct)
#pragma unroll
            for (int i = 0; i < 4; ++i) lg[(4 * q + i) * 52 + 16 * ct + c] = acc[ct][i];
        asm volatile("s_waitcnt lgkmcnt(0)" ::: "memory");
        if (q == 0 && valid) {
            const LAS float* lr_ = lg + c * 52;
            float gl[4];
#pragma unroll
            for (int i = 0; i < 4; ++i) gl[i] = lr_[i] * rstd + rgb[i];
            int grp = 0; float gm = gl[0];
#pragma unroll
            for (int i = 1; i < 4; ++i) if (gl[i] > gm) { gm = gl[i]; grp = i; }
            float gs = 0.f;
#pragma unroll
            for (int i = 0; i < 4; ++i) gs += __expf(gl[i] - gm);
            const float pg = 1.0f / gs;
            float el[8];
#pragma unroll
            for (int j = 0; j < 8; ++j) el[j] = lr_[4 + grp * 8 + j] * rstd + reb[grp * 8 + j];
            int i1 = 0; float m1 = el[0];
#pragma unroll
            for (int j = 1; j < 8; ++j) if (el[j] > m1) { m1 = el[j]; i1 = j; }
            int i2 = (i1 == 0) ? 1 : 0; float m2 = -3.0e38f;
#pragma unroll
            for (int j = 0; j < 8; ++j) if (j != i1 && el[j] > m2) { m2 = el[j]; i2 = j; }
            const float p2 = __expf(m2 - m1);
            const float w1 = pg / (1.0f + p2), w2 = pg * p2 / (1.0f + p2);
            const int e1 = grp * 8 + i1, e2 = grp * 8 + i2;
            LAS int* dd = dec + (wv * 16 + c) * 8;
            dd[0] = e1; dd[1] = e2; dd[2] = atomicAdd((int*)(lcnt + e1), 1); dd[3] = atomicAdd((int*)(lcnt + e2), 1); dd[4] = __float_as_int(w1); dd[5] = __float_as_int(w2); dd[6] = __float_as_int(rstd);
        }
        __syncthreads();
        if (tid < NEXP) lcnt[32 + tid] = atomicAdd(&cnt[tid], lcnt[tid]);
        __syncthreads();
        for (int lr = tid; lr < rows_per; lr += NTHR) {
            const int row_ = p0 + lr; LAS int* dd = dec + lr * 8;
            const int e1 = dd[0], e2 = dd[1], pos1 = lcnt[32 + e1] + dd[2], pos2 = lcnt[32 + e2] + dd[3];
            list[e1 * ECAP + pos1] = row_; list[e2 * ECAP + pos2] = row_;
            rs[e1 * ECAP + pos1] = __int_as_float(dd[6]); rs[e2 * ECAP + pos2] = __int_as_float(dd[6]);
            int* a = asg + (size_t)row_ * 6;
            a[0] = e1; a[1] = pos1; a[2] = dd[4]; a[3] = e2; a[4] = pos2; a[5] = dd[5];
        }
    }
    __syncthreads();
}
__device__ __forceinline__ void p_final(LAS unsigned char* lds, const bf16_t* h1b, float* out, const bf16_t* Y, const int* cnt, const int* asg, const float* gf) {
    LAS int* offr = (LAS int*)lds;
    __syncthreads();
    if (threadIdx.x == 0) { int s = 0; for (int e = 0; e < NEXP; ++e) { offr[e] = s * 256; s += (cnt[e] + 255) >> 8; } }
    __syncthreads();
    const int wv = threadIdx.x >> 6, l = threadIdx.x & 63;
    constexpr int NR = 4;
    const int rstep = (int)gridDim.x * 8;
    f32x4 gv[4];
#pragma unroll
    for (int i = 0; i < 4; ++i) gv[i] = ((const f32x4*)gf)[l + 64 * i];
    for (int row0 = blockIdx.x * 8 + wv; row0 < T; row0 += rstep * NR) {
        u32x2 ag[NR][3];
#pragma unroll
        for (int r = 0; r < NR; ++r) { const int row = (row0 + r * rstep < T) ? row0 + r * rstep : row0; const u32x2* a2 = (const u32x2*)(asg + (size_t)row * 6); ag[r][0] = a2[0]; ag[r][1] = a2[1]; ag[r][2] = a2[2]; }
        u32x2 hw[NR][4], y1[NR][4], y2[NR][4];
#pragma unroll
        for (int r = 0; r < NR; ++r) { const int row = (row0 + r * rstep < T) ? row0 + r * rstep : row0;
#pragma unroll
            for (int i = 0; i < 4; ++i) hw[r][i] = *(const u32x2*)(h1b + (size_t)row * D + 4 * (l + 64 * i)); }
#pragma unroll
        for (int r = 0; r < NR; ++r) { const int s1 = offr[ag[r][0].x] + (int)ag[r][0].y, s2 = offr[ag[r][1].y] + (int)ag[r][2].x;
#pragma unroll
            for (int i = 0; i < 4; ++i) { y1[r][i] = *(const u32x2*)(Y + (size_t)s1 * D + 4 * (l + 64 * i)); y2[r][i] = *(const u32x2*)(Y + (size_t)s2 * D + 4 * (l + 64 * i)); } }
#pragma unroll
        for (int r = 0; r < NR; ++r) { const int row = row0 + r * rstep; if (row >= T) break;
            const float w1 = __uint_as_float(ag[r][1].x), w2 = __uint_as_float(ag[r][2].y);
            f32x4 v[4]; float ss = 0.f;
#pragma unroll
            for (int i = 0; i < 4; ++i) {
                v[i][0] = bf_lo(hw[r][i].x) + w1 * bf_lo(y1[r][i].x) + w2 * bf_lo(y2[r][i].x); v[i][1] = bf_hi(hw[r][i].x) + w1 * bf_hi(y1[r][i].x) + w2 * bf_hi(y2[r][i].x);
                v[i][2] = bf_lo(hw[r][i].y) + w1 * bf_lo(y1[r][i].y) + w2 * bf_lo(y2[r][i].y); v[i][3] = bf_hi(hw[r][i].y) + w1 * bf_hi(y1[r][i].y) + w2 * bf_hi(y2[r][i].y);
                ss += v[i][0] * v[i][0] + v[i][1] * v[i][1] + v[i][2] * v[i][2] + v[i][3] * v[i][3]; }
            ss = wave_sum(ss);
            const float rstd = rsqrtf(ss * (1.0f / D) + EPS);
            f32x4* xr = (f32x4*)(out + (size_t)row * D);
#pragma unroll
            for (int i = 0; i < 4; ++i) xr[l + 64 * i] = v[i] * rstd * gv[i]; }
    }
}

__device__ __forceinline__ void run_dense(LAS unsigned char* lds, const char* A, unsigned lda2, int K, const char* Bt, int M, int N, int rowmap, int mode, void* o0, const void* i0, const float* aux) {
    SchedDense S; S.so.init(M, N, (int)gridDim.x, (int)blockIdx.x); S.A = A; S.lda2 = lda2; S.K = K; S.Bt = Bt; S.rowmap = rowmap;
    if (mode == 0) { EpiProj E{(bf16_t*)o0, (const float*)i0, aux}; pg8::gemm_phase<EpiProj, SchedDense>(lds, S, E); }
    else { EpiResid E{(const float*)i0, (bf16_t*)o0}; pg8::gemm_phase<EpiResid, SchedDense>(lds, S, E); }
}
__device__ __forceinline__ void run_moe(LAS unsigned char* lds, const char* A, unsigned lda2, int K, const char* Bt, size_t bstride, const int* cnt, const int* list, int mode, void* out, const float* rs) {
    LAS int* pref = (LAS int*)(lds + pg8::STAGE_BYTES);
    __syncthreads();
    if (threadIdx.x == 0) { int s = 0, sf = 0, sh = 0; for (int e = 0; e < NEXP; ++e) { const int n = cnt[e], nt_ = (n + 255) >> 8, rem = n & 255, hh = (rem != 0 && rem <= 128) ? 1 : 0;
            pref[e] = s; pref[33 + e] = sf; pref[66 + e] = sh; s += nt_; sf += nt_ - hh; sh += hh; } pref[NEXP] = s; pref[33 + NEXP] = sf; pref[66 + NEXP] = sh; }
    __syncthreads();
    SchedMoe S; S.cnt = cnt; S.list = list; S.pref = pref; S.A = A; S.lda2 = lda2; S.K = K; S.Bt = Bt; S.bstride = bstride; S.gather = (mode == 0); S.G = (int)gridDim.x; S.c = ((gridDim.x & 7) == 0) ? (int)((blockIdx.x & 7) * (gridDim.x >> 3) + (blockIdx.x >> 3)) : (int)blockIdx.x;
    if (mode == 0) { EpiSwiglu E{(bf16_t*)out, rs}; pg8::gemm_phase<EpiSwiglu, SchedMoe>(lds, S, E); }
    else { EpiY E{(bf16_t*)out}; pg8::gemm_phase<EpiY, SchedMoe>(lds, S, E); }
}

__global__ void __launch_bounds__(NTHR, 2) mega(Args a) {
    extern __shared__ __attribute__((aligned(16))) unsigned char shm[];
    LAS unsigned char* lds = (LAS unsigned char*)shm;
    cg::grid_group grid = cg::this_grid();
    const float* x = a.in[0]; const float* meta = a.in[1]; const float* lbl = a.in[2]; const float* g1 = a.in[3];
    const float* w_in = a.in[4]; const float* convw = a.in[5]; const float* A_log = a.in[6]; const float* dt_bias = a.in[7];
    const float* hg_ng = a.in[8]; const float* gd_ng = a.in[9]; const float* hg_up = a.in[10]; const float* gd_up = a.in[11];
    const float* w_out = a.in[12]; const float* g2 = a.in[13]; const float* rgw = a.in[14]; const float* rgb = a.in[15];
    const float* rew = a.in[16]; const float* reb = a.in[17]; const float* w_gate = a.in[18]; const float* w_up = a.in[19];
    const float* w_down = a.in[20]; const float* gf = a.in[21];
    char* ws = a.ws; float* out = a.out;
    bf16_t* proj = (bf16_t*)(ws + OFF_PROJ); bf16_t* Win = (bf16_t*)(ws + OFF_WIN); bf16_t* Whg = (bf16_t*)(ws + OFF_WHG); bf16_t* Wgd = (bf16_t*)(ws + OFF_WGD); bf16_t* Wout = (bf16_t*)(ws + OFF_WOUT);
    float* gbf = (float*)(ws + OFF_GBF); float* lbt = (float*)(ws + OFF_MISC + MISC_LBT); int* cnt = (int*)(ws + OFF_MISC + MISC_CNT);
    bf16_t* tmp = (bf16_t*)(ws + OFF_TMP);
    bf16_t* xb = (bf16_t*)(ws + OFF_QKVN); float* rsx = (float*)(ws + OFF_RSX);
    bf16_t* h1b = (bf16_t*)(ws + OFF_XN); float* rsl = (float*)(ws + OFF_RS); bf16_t* We1 = (bf16_t*)(ws + OFF_WE1); bf16_t* We2 = (bf16_t*)(ws + OFF_WE2); bf16_t* Hb = (bf16_t*)(ws + OFF_H); bf16_t* Yb = (bf16_t*)(ws + OFF_Y);
    int* list = (int*)(ws + OFF_LIST); int* asg = (int*)(ws + OFF_ASG);
    bf16_t* oab = (bf16_t*)((char*)a.out + DO_OA); bf16_t* obb = (bf16_t*)((char*)a.out + DO_OB); bf16_t* mgb = (bf16_t*)(ws + OFF_MG);
    float* arun = (float*)((char*)a.out + DO_ARUN); float* drun = arun + (size_t)256 * 16384;
    GdnBufs GB; GB.QT = (bf16_t*)(ws + OFF_QT); GB.AT = (bf16_t*)(ws + OFF_AT); GB.KHT = (bf16_t*)(ws + OFF_KHT); GB.GEND = (float*)(ws + OFF_GEND); GB.WP = (bf16_t*)((char*)a.out + DO_WP); GB.U0T = (bf16_t*)((char*)a.out + DO_U0T);
    const int lo = a.ph_lo, hi = a.ph_hi;
#define IN(k) (lo <= (k) && (k) < hi)
    LAS unsigned long long* tsw = (LAS unsigned long long*)(lds + LDS_BYTES - 256);
#define STAMP(k) do { if (PROBE_PH >= 0 && blockIdx.x == PROBE_BLK && threadIdx.x == 0) tsw[k] = __builtin_amdgcn_s_memrealtime(); } while (0)
    volatile LAS unsigned* xbst = (volatile LAS unsigned*)(lds + LDS_BYTES - 128);
    if (threadIdx.x == 0) { xbst[0] = 0u; xbst[1] = 0u; }
    __syncthreads();
    const XcdBarrier xbar = xcd_barrier_post((unsigned*)(ws + OFF_BAR), xbst);
#define SEAM(k) do { if (IN(k) && IN((k) + 1)) { if ((k) == 0) grid.sync(); else xcd_barrier(xbar); } STAMP((k) + 1); } while (0)
    if (PROBE_PH >= 0 && threadIdx.x == 0) { tsw[14] = 0; tsw[15] = 0; }
    STAMP(0);
    if (IN(0)) {
        if (blockIdx.x == 0) {
            const int i = threadIdx.x;
            { const float aa = lbl[i], bb = lbl[512 + i]; const float m = fmaxf(aa, bb); const float ea = __expf(aa - m), eb = __expf(bb - m); lbt[i] = ea / (ea + eb); }
            if (i < NEXP) cnt[i] = 0;
        }
        {
          const TrJob jw{w_in, nullptr, Win, 0, 1024, WIN_LD, NPROJ, 1, 0, 0, g1}, jh{hg_up, nullptr, Whg, 1, 512, 1024, 1024, 1, 0, 0, nullptr}, jg{gd_up, nullptr, Wgd, 1, 512, 1024, 1024, 1, 0, 0, nullptr}, jo{w_out, nullptr, Wout, 1, 1024, 1024, 1024, 1, 0, 0, nullptr};
          const int b_ = (int)blockIdx.x; const bool even = (gridDim.x == 256);
          int id0, id1, id2;
          if (even) { if (b_ >= META_WG) { const int bb = b_ - META_WG, nw = 256 - META_WG; id0 = bb; id1 = bb + nw; id2 = bb + 2 * nw < 512 ? bb + 2 * nw : -1; } else { id0 = -1; id1 = -1; id2 = -1; } }
          else { id0 = -1; id1 = -1; id2 = -1; }
#define TR_LOAD_ID(v_, id_) do { if ((id_) >= 0) { if ((id_) < 384) tr_load(v_, jw, (id_)); else if ((id_) < 416) tr_load(v_, jh, (id_) - 384); else if ((id_) < 448) tr_load(v_, jg, (id_) - 416); else tr_load(v_, jo, (id_) - 448); } } while (0)
#define TR_STORE_ID(v_, id_) do { if ((id_) >= 0) { if ((id_) < 384) tr_store((LAS float*)lds, v_, jw, (id_)); else if ((id_) < 416) tr_store((LAS float*)lds, v_, jh, (id_) - 384); else if ((id_) < 448) tr_store((LAS float*)lds, v_, jg, (id_) - 416); else tr_store((LAS float*)lds, v_, jo, (id_) - 448); } } while (0)
          if (even && b_ < META_WG) p0_meta(lds, meta, g1, w_in, lbl, A_log, dt_bias, proj, gbf);
          else if (even) {
              f32x4 t0[8], t1[8], t2[8];
              TR_LOAD_ID(t0, id0); TR_LOAD_ID(t1, id1); TR_LOAD_ID(t2, id2);
              TR_STORE_ID(t0, id0); TR_STORE_ID(t1, id1); TR_STORE_ID(t2, id2);
              __syncthreads(); }
          else p0_meta(lds, meta, g1, w_in, lbl, A_log, dt_bias, proj, gbf);
          p0_zero(proj, gbf);
          if (!even) { run_tr(lds, jw, b_, (int)gridDim.x); run_tr(lds, jh, b_, (int)gridDim.x); run_tr(lds, jg, b_, (int)gridDim.x); run_tr(lds, jo, b_, (int)gridDim.x); }
#undef TR_LOAD_ID
#undef TR_STORE_ID
        }
        p0_prep_x(lds, x, g1, w_in, A_log, dt_bias, xb, gbf, rsx, (unsigned*)(ws + OFF_BAR) + 33);
    }
    SEAM(0);
    if (IN(1)) run_dense(lds, (const char*)xb, D * 2, 1024, (const char*)Win, T, NPROJ, 0, 0, proj, lbt, rsx);
    SEAM(1);
    if (IN(2)) {
        unsigned* q2 = (unsigned*)(ws + OFF_BAR) + 32;
        LAS int* qit = (LAS int*)(lds + LDS_BYTES - 64);
        unsigned tk = 0; if (threadIdx.x == 0) tk = atomicAdd(q2, 1u);
        for (int it = blockIdx.x; it < 256; it += gridDim.x) hgrn_run<false>(lds, proj, arun, drun, hg_ng, it, oab);
        for (int i = threadIdx.x; i < 6144 / 4; i += NTHR) *(LAS f32x4*)(lds + GB_CW + i * 16) = *(const f32x4*)(convw + 4 * i);
        if (threadIdx.x == 0) qit[0] = (int)tk;
        __syncthreads();
        int cur = qit[0];
        if (threadIdx.x == 0) tk = atomicAdd(q2, 1u);
        GdnBRegs R;
        if (cur < GD_NITEM) gdn_phaseB_load(R, proj, gbf, cur, threadIdx.x);
        while (cur < GD_NITEM) cur = gdn_phaseB(lds, proj, gbf, GB, cur, R, q2, tk);
    }
    SEAM(2);
    if (IN(3)) {
        unsigned* hq = (unsigned*)(ws + OFF_BAR);
        unsigned* scan_done = hq + 64;
        if (blockIdx.x < 128) { const int lab = blockIdx.x & 7, kk = blockIdx.x >> 3; gdn_scan(lds, proj, GB, (2 * lab + (kk >> 3)) * 8 + (kk & 7));
            asm volatile("s_waitcnt vmcnt(0)" ::: "memory");
            __syncthreads();
            if (threadIdx.x == 0) { __builtin_amdgcn_fence(__ATOMIC_RELEASE, "agent"); asm volatile("s_waitcnt vmcnt(0)" ::: "memory"); __hip_atomic_fetch_add(scan_done, 1u, __ATOMIC_RELAXED, __HIP_MEMORY_SCOPE_AGENT); } }
        {
          LAS int* qit = (LAS int*)(lds + LDS_BYTES - 64);
          bool acquired = false;
          for (;;) { __syncthreads(); if (threadIdx.x == 0) *qit = (int)atomicAdd(hq, 1u); __syncthreads(); const int it = *qit; if (it >= 512) break;
              if (it < 256) hgrn_run<true>(lds, proj, arun, drun, hg_ng, ((it & 15) * 16) + (it >> 4), oab);
              else {
                  if (!acquired) { if (threadIdx.x == 0) { while (__hip_atomic_load(scan_done, __ATOMIC_RELAXED, __HIP_MEMORY_SCOPE_AGENT) < 128u) __builtin_amdgcn_s_sleep(8);
                                       __builtin_amdgcn_fence(__ATOMIC_ACQUIRE, "agent"); asm volatile("s_waitcnt vmcnt(0)" ::: "memory"); }
                                   __syncthreads(); acquired = true; }
                  gdn_phaseD_all(lds, proj, GB, gd_ng, it - 256, 256, obb); } }
          if (PROBE_BLK != 0) STAMP(12); }
    }
    if (IN(3) && IN(4)) STAMP(4);
    SEAM(4);
    if (IN(5)) { SchedMerge S; S.so.init(T, 1024, (int)gridDim.x, (int)blockIdx.x); S.base = (const char*)a.out; S.offA = (unsigned)DO_OA; S.offB = (unsigned)DO_OB; S.K = 512; S.Whg = (const char*)Whg; S.Wgd = (const char*)Wgd;
        EpiMerge E{proj, mgb}; pg8::gemm_phase<EpiMerge, SchedMerge>(lds, S, E); }
    SEAM(5);
    if (IN(6)) run_dense(lds, (const char*)mgb, D * 2, 1024, (const char*)Wout, T, 1024, 0, 3, h1b, x, nullptr);
    SEAM(6);
    if (IN(7)) {
        { TrJob j{w_gate, w_up, We1, 2, 1024, 512, 1024, NEXP, (size_t)1024 * 512, (size_t)1024 * 1024, g2}; run_tr(lds, j, (int)blockIdx.x, (int)gridDim.x); }
        { TrJob j{w_down, nullptr, We2, 1, 512, 1024, 1024, NEXP, (size_t)512 * 1024, (size_t)1024 * 512}; run_tr(lds, j, (int)blockIdx.x, (int)gridDim.x); }
        p_router(lds, h1b, g2, rgw, rgb, rew, reb, cnt, list, rsl, asg);
    }
    SEAM(7);
    if (IN(8)) run_moe(lds, (const char*)h1b, D * 2, 1024, (const char*)We1, (size_t)1024 * 1024 * 2, cnt, list, 0, Hb, rsl);
    SEAM(8);
    if (IN(9)) run_moe(lds, (const char*)Hb, 512 * 2, 512, (const char*)We2, (size_t)1024 * 512 * 2, cnt, list, 1, Yb, nullptr);
    SEAM(9);
    if (IN(10)) p_final(lds, h1b, out, Yb, cnt, asg, gf);
    if (PROBE_PH >= 0) {
        __syncthreads();
        if (blockIdx.x == PROBE_BLK && threadIdx.x == 0) { const unsigned long long t1 = __builtin_amdgcn_s_memrealtime(); if (PROBE_PH == 10) tsw[11] = t1;
            const unsigned long long dt = (PROBE_PH == 14 ? tsw[14] : PROBE_PH == 15 ? tsw[15] : PROBE_PH == 13 ? (tsw[13] - tsw[12]) : PROBE_PH == 12 ? (tsw[12] - tsw[3]) : (tsw[PROBE_PH + 1] - tsw[PROBE_PH])) * PROBE_K; while (__builtin_amdgcn_s_memrealtime() - t1 < dt) __builtin_amdgcn_s_sleep(32); }
    }
#undef IN
#undef SEAM
}

#ifndef N_LAUNCH_SPLIT
#define N_LAUNCH_SPLIT 0
#endif
constexpr int NPHASE = 11;
extern "C" void kernel_launch(void* const* d_in, const int* in_sizes, int n_in, void* d_out, int out_size, void* d_ws, size_t ws_size, hipStream_t stream) {
    static int grid = 0;
    if (grid == 0) {
        if (n_in != 22 || in_sizes[0] != T * D || out_size != T * D || ws_size < WS_END) { fprintf(stderr, "kernel_launch: unexpected shapes (n_in %d in0 %d out %d ws %zu need %zu)\n", n_in, n_in > 0 ? in_sizes[0] : -1, out_size, ws_size, (size_t)WS_END); grid = -1; }
        else {
            int dev = 0, cus = 0, per_cu = 0;
            if (hipGetDevice(&dev) != hipSuccess || hipDeviceGetAttribute(&cus, hipDeviceAttributeMultiprocessorCount, dev) != hipSuccess) grid = -1;
            else if (hipFuncSetAttribute((const void*)mega, hipFuncAttributeMaxDynamicSharedMemorySize, LDS_BYTES) != hipSuccess) { fprintf(stderr, "kernel_launch: hipFuncSetAttribute failed\n"); grid = -1; }
            else if (hipOccupancyMaxActiveBlocksPerMultiprocessor(&per_cu, (const void*)mega, NTHR, LDS_BYTES) != hipSuccess || per_cu < 1) { fprintf(stderr, "kernel_launch: occupancy query says %d\n", per_cu); grid = -1; }
            else grid = cus;
            (void)hipGetLastError();
        }
    }
    if (grid < 0) return;
    if (hipMemsetAsync((char*)d_ws + OFF_BAR, 0, XCD_BAR_WORDS * 4, stream) != hipSuccess) { fprintf(stderr, "kernel_launch: memset of the barrier words failed\n"); return; }
    Args a{};
    for (int i = 0; i < 22; ++i) a.in[i] = (const float*)d_in[i];
    a.out = (float*)d_out; a.ws = (char*)d_ws;
#if N_LAUNCH_SPLIT
    for (int p = 0; p < NPHASE; ++p) { a.ph_lo = p; a.ph_hi = p + 1; hipLaunchKernelGGL(mega, dim3(grid), dim3(NTHR), LDS_BYTES, stream, a); }
#else
    a.ph_lo = 0; a.ph_hi = NPHASE;
    void* args[] = {&a};
    hipError_t e = hipLaunchCooperativeKernel((const void*)mega, dim3(grid), dim3(NTHR), args, LDS_BYTES, stream);
    if (e != hipSuccess) fprintf(stderr, "cooperative launch failed: %s (grid %d)\n", hipGetErrorString(e), grid);
#endif
}
```

```cpp
#include <hip/hip_runtime.h>
#include <hip/hip_cooperative_groups.h>
namespace cg = cooperative_groups;
#include <cstdio>
#include <cstdint>

#define LAS __attribute__((address_space(3)))
#ifndef PROBE_PH
#define PROBE_PH -1
#endif
#define PROBE_K 4
#ifndef PROBE_BLK
#define PROBE_BLK 0
#endif
typedef unsigned short bf16_t;
typedef short bf16x8 __attribute__((ext_vector_type(8)));
typedef float f32x4 __attribute__((ext_vector_type(4)));
typedef unsigned u32x4 __attribute__((ext_vector_type(4)));
typedef unsigned u32x2 __attribute__((ext_vector_type(2)));

constexpr int D = 1024, NB = 4, SEQ = 8192, NMETA = 16, T = NB * SEQ;
constexpr int LP = 8256;
constexpr int TP = NB * LP;
constexpr int NPROJ = 6144;
constexpr int WIN_LD = 6152;
constexpr float EPS = 1e-6f;
constexpr int NEXP = 32, ECAP = 32768, HROWS = 73728;
constexpr int C_QA = 0, C_LF = 512, C_VA = 1024, C_HG = 1536, C_GQ = 2048, C_GK = 2560, C_GV = 3072, C_GZ = 3584, C_PA = 4096, C_PB = 5120;

constexpr size_t OFF_PROJ = 0;
constexpr size_t SZ_PROJ = (size_t)TP * NPROJ * 2;
constexpr size_t OFF_WIN = OFF_PROJ + SZ_PROJ;
constexpr size_t OFF_WHG = OFF_WIN + (size_t)NPROJ * D * 2;
constexpr size_t OFF_WGD = OFF_WHG + (size_t)1024 * 512 * 2;
constexpr size_t OFF_WOUT = OFF_WGD + (size_t)1024 * 512 * 2;
constexpr size_t OFF_GBF = OFF_WOUT + (size_t)1024 * 1024 * 2;
constexpr size_t OFF_MISC = OFF_GBF + (size_t)TP * 8 * 4;
constexpr size_t OFF_QKVN = OFF_MISC + 8192;
constexpr size_t GD_SZ16 = (size_t)NB * 129 * 4 * 16384;
constexpr size_t OFF_KHT = OFF_QKVN, OFF_QT = OFF_KHT + GD_SZ16, OFF_AT = OFF_QT + GD_SZ16, OFF_GEND = OFF_AT + GD_SZ16 / 2;
constexpr size_t OFF_BAR = OFF_GEND + 16384;
constexpr size_t OFF_RSX = OFF_BAR + 16384;
constexpr size_t OFF_MP = OFF_RSX + (size_t)T * 4;
constexpr size_t WS_END = OFF_MP + (size_t)2 * 16 * WIN_LD * 4;
static_assert(WS_END <= ((size_t)512 << 20), "workspace");
constexpr size_t OFF_TMP = OFF_QKVN;
constexpr size_t DO_WP = 0, DO_U0T = GD_SZ16, DO_ARUN = (size_t)68 << 20, DO_OA = (size_t)90 << 20, DO_OB = 0;
constexpr size_t OFF_MG = OFF_QKVN;
constexpr size_t OFF_XN = 0;
constexpr size_t OFF_WE1 = OFF_XN + (size_t)T * D * 2;
constexpr size_t OFF_WE2 = OFF_WE1 + (size_t)NEXP * 1024 * 1024 * 2;
constexpr size_t OFF_H = OFF_WE2 + (size_t)NEXP * 1024 * 512 * 2;
constexpr size_t OFF_Y = OFF_H + (size_t)HROWS * 512 * 2;
constexpr size_t OFF_LIST = OFF_Y + (size_t)HROWS * 1024 * 2;
constexpr size_t OFF_ASG = OFF_LIST + (size_t)NEXP * ECAP * 4;
constexpr size_t OFF_RS = OFF_ASG + (size_t)T * 2 * 12;
constexpr size_t MOE_END = OFF_RS + (size_t)NEXP * ECAP * 4;
static_assert(MOE_END <= SZ_PROJ, "moe scratch must fit in the dead proj region");
constexpr size_t MISC_LBT = 0, MISC_CNT = 4096;

typedef __bf16 bf16x2_t __attribute__((ext_vector_type(2)));
typedef float f32x2_t __attribute__((ext_vector_type(2)));
__device__ __forceinline__ unsigned cvt_pk_bf16(float lo, float hi) { const f32x2_t f = {lo, hi}; const bf16x2_t b = __builtin_convertvector(f, bf16x2_t); return __builtin_bit_cast(unsigned, b); }
__device__ __forceinline__ float bf_lo(unsigned w) { return __uint_as_float(w << 16); }
__device__ __forceinline__ float bf_hi(unsigned w) { return __uint_as_float(w & 0xffff0000u); }
__device__ __forceinline__ float bf2f(bf16_t b) { return __uint_as_float(((unsigned)b) << 16); }
__device__ __forceinline__ bf16_t f2bf(float f) { return (bf16_t)(cvt_pk_bf16(f, 0.f) & 0xffffu); }
__device__ __forceinline__ float sigmoidf_(float x) { return __builtin_amdgcn_rcpf(1.0f + __expf(-x)); }
__device__ __forceinline__ float siluf_(float x) { return x * __builtin_amdgcn_rcpf(1.0f + __expf(-x)); }
__device__ __forceinline__ float wave_sum(float v) {
    v += __builtin_bit_cast(float, __builtin_amdgcn_update_dpp(0, __builtin_bit_cast(int, v), 0xB1, 0xF, 0xF, true));
    v += __builtin_bit_cast(float, __builtin_amdgcn_update_dpp(0, __builtin_bit_cast(int, v), 0x4E, 0xF, 0xF, true));
    v += __builtin_bit_cast(float, __builtin_amdgcn_update_dpp(0, __builtin_bit_cast(int, v), 0x141, 0xF, 0xF, true));
    v += __builtin_bit_cast(float, __builtin_amdgcn_update_dpp(0, __builtin_bit_cast(int, v), 0x140, 0xF, 0xF, true));
    const int vi = __builtin_bit_cast(int, v);
    const float r0 = __builtin_bit_cast(float, __builtin_amdgcn_readlane(vi, 0)), r1 = __builtin_bit_cast(float, __builtin_amdgcn_readlane(vi, 16));
    const float r2 = __builtin_bit_cast(float, __builtin_amdgcn_readlane(vi, 32)), r3 = __builtin_bit_cast(float, __builtin_amdgcn_readlane(vi, 48));
    return (r0 + r1) + (r2 + r3);
}
__device__ __forceinline__ int prow_of(int r) { return (r >> 13) * LP + 64 + (r & 8191); }

namespace pg8 {
constexpr int BM = 256, BK = 64, HALF = 128, HTB = HALF * BK * 2, STAGE_BYTES = 8 * HTB, NXCD = 8, WGM = 4;
__host__ __device__ __forceinline__ int lds_byte(int r, int c) { const int st = (r >> 4) * 2 + (c >> 5), rr = r & 15, cc = c & 31, ob = rr * 64 + cc * 2; return st * 1024 + (ob ^ (((ob >> 9) & 1) << 5)); }
__host__ __device__ __forceinline__ void stage_rc(int b, int& R, int& C) { const int st = b / 1024, sb = b % 1024, swz = sb ^ (((sb >> 9) & 1) << 5); R = (st >> 1) * 16 + swz / 64; C = (st & 1) * 32 + (swz % 64) / 2; }
__host__ __device__ __forceinline__ int perm32(int rho) { const int n = rho >> 4, i = rho & 15; return 8 * (i >> 2) + 4 * n + (i & 3); }

struct Unit { int pm, pn, e, t; };

struct StaticOrder {
    int nM, nN, nwg, G, c;
    __device__ void init(int M, int N, int G_, int c_) { nM = M / BM; nN = N / BM; nwg = nM * nN; G = G_; c = c_; }
    __device__ bool next(int i, Unit& u) const {
        const long L = (long)i * G + c; if (L >= nwg) return false;
        int wgid = (int)L; { const int q = nwg / NXCD, r = nwg % NXCD, xcd = wgid % NXCD, off = wgid / NXCD; wgid = (xcd < r ? xcd * (q + 1) : r * (q + 1) + (xcd - r) * q) + off; }
        const int nig = WGM * nN, gid = wgid / nig, fm = gid * WGM, gsz = (nM - fm) < WGM ? (nM - fm) : WGM;
        u.pm = fm + ((wgid % nig) % gsz); u.pn = (wgid % nig) / gsz; u.e = 0; u.t = 0; return true;
    }
};

template <class Epi, class Sched>
__device__ __forceinline__ void gemm_phase(LAS unsigned char* lds, const Sched& S, const Epi& E) {
    const int tid = threadIdx.x, wid = __builtin_amdgcn_readfirstlane(tid >> 6), lane = tid & 63, wr = wid >> 2, wc = wid & 3, fr = lane & 15, fq = lane >> 4;
    const int K = S.K, nt = K / BK;
    int Rr[2]; unsigned ccA[2], voffB[2];
#pragma unroll
    for (int i = 0; i < 2; ++i) { int R, C; stage_rc(tid * 16 + i * 8192, R, C); const int Rb = Epi::PERM ? ((R & ~31) + perm32(R & 31)) : R;
        Rr[i] = R; ccA[i] = (unsigned)C * 2u; voffB[i] = (unsigned)(Rb * K + C) * 2u; }
    const size_t kstep = (size_t)(BK * 2);
    const size_t hstepB = (size_t)HALF * K * 2;
    const unsigned ldsw = (unsigned)wid * 1024u;
    const int aoff = lds_byte(wr * 64 + fr, fq * 8), boff = lds_byte(wc * 32 + fr, fq * 8);
#define PG8_SA(b, h) (((b) * 2 + (h)) * HTB)
#define PG8_SB(b, h) ((4 + (b) * 2 + (h)) * HTB)
#define PG8_STAGE(bufoff, gbase, voff) do { _Pragma("unroll") for (int _i = 0; _i < 2; ++_i) \
        __builtin_amdgcn_global_load_lds((const unsigned*)((const char*)(gbase) + (voff)[_i]), (LAS unsigned*)(lds + (bufoff) + ldsw + _i * 8192), 16, 0, 0); } while (0)
#define PG8_LDA(dst, b, h) do { _Pragma("unroll") for (int m = 0; m < 4; ++m) _Pragma("unroll") for (int k = 0; k < 2; ++k) dst[m][k] = *(const LAS bf16x8*)(lds + PG8_SA(b, h) + aoff + m * 2048 + k * 1024); } while (0)
#define PG8_LDB(dst, b, h) do { _Pragma("unroll") for (int n = 0; n < 2; ++n) _Pragma("unroll") for (int k = 0; k < 2; ++k) dst[n][k] = *(const LAS bf16x8*)(lds + PG8_SB(b, h) + boff + n * 2048 + k * 1024); } while (0)
#define PG8_MMA(ai, bj, At, Bt) do { __builtin_amdgcn_s_setprio(1); _Pragma("unroll") for (int m = 0; m < 4; ++m) _Pragma("unroll") for (int n = 0; n < 2; ++n) _Pragma("unroll") for (int k = 0; k < 2; ++k) \
        acc[ai][bj][m][n] = __builtin_amdgcn_mfma_f32_16x16x32_bf16(Bt[n][k], At[m][k], acc[ai][bj][m][n], 0, 0, 0); __builtin_amdgcn_s_setprio(0); } while (0)
#define PG8_WAIT_V(n) asm volatile("s_waitcnt vmcnt(" #n ")" ::: "memory")
#define PG8_WAIT_L(n) asm volatile("s_waitcnt lgkmcnt(" #n ")" ::: "memory")
#define PG8_BAR __builtin_amdgcn_s_barrier()
#define PG8_SCHED __builtin_amdgcn_sched_barrier(0)
    Unit cur, nxt; int ui = 0;
    if (!S.next(0, cur)) return;
    f32x4 acc[2][2][4][2];
#pragma unroll
    for (int a = 0; a < 2; ++a)
#pragma unroll
        for (int b = 0; b < 2; ++b)
#pragma unroll
            for (int m = 0; m < 4; ++m)
#pragma unroll
                for (int n = 0; n < 2; ++n) acc[a][b][m][n] = (f32x4){0.f, 0.f, 0.f, 0.f};
    bf16x8 At[4][2], B0[2][2], B1[2][2];
    unsigned vAc[2][2], vAn[2][2];
#pragma unroll
    for (int h = 0; h < 2; ++h)
#pragma unroll
        for (int i = 0; i < 2; ++i) vAc[h][i] = S.a_off(cur, Rr[i] + HALF * h) + ccA[i];
    const char* gA = S.a_base();
    const char* cB = S.b_ptr(cur);
    PG8_STAGE(PG8_SB(0, 0), cB, voffB); PG8_STAGE(PG8_SB(0, 1), cB + hstepB, voffB); PG8_STAGE(PG8_SA(0, 0), gA, vAc[0]); PG8_STAGE(PG8_SA(0, 1), gA, vAc[1]);
    if (wr == 1) PG8_BAR;
    PG8_WAIT_V(2); PG8_BAR;
    PG8_STAGE(PG8_SB(1, 0), cB + kstep, voffB); PG8_STAGE(PG8_SA(1, 0), gA + kstep, vAc[0]); PG8_STAGE(PG8_SB(1, 1), cB + hstepB + kstep, voffB);
    PG8_WAIT_V(6); PG8_BAR;
    for (;;) {
        const bool has_next = S.next(ui + 1, nxt);
        const bool hf = S.half(cur);
        const char* nB = has_next ? S.b_ptr(nxt) : cB;
#pragma unroll
        for (int h = 0; h < 2; ++h)
#pragma unroll
            for (int i = 0; i < 2; ++i) vAn[h][i] = has_next ? (S.a_off(nxt, Rr[i] + HALF * h) + ccA[i]) : vAc[h][i];
        for (int t = 0; t < nt; t += 2) {
            const bool last = (t == nt - 2);
            const char* a1 = gA + (size_t)(t + 1) * kstep;
            const char* a2 = last ? gA : gA + (size_t)(t + 2) * kstep; const char* b2 = last ? nB : cB + (size_t)(t + 2) * kstep;
            const char* a3 = a2 + kstep; const char* b3 = b2 + kstep;
            unsigned w0[2], w1[2];
#pragma unroll
            for (int i = 0; i < 2; ++i) { w0[i] = last ? vAn[0][i] : vAc[0][i]; w1[i] = last ? vAn[1][i] : vAc[1][i]; }
            PG8_LDB(B0, 0, 0); PG8_LDB(B1, 0, 1); PG8_SCHED; PG8_LDA(At, 0, 0); PG8_STAGE(PG8_SA(1, 1), a1, vAc[1]);
            PG8_WAIT_V(8); PG8_WAIT_L(0); PG8_BAR; PG8_MMA(0, 0, At, B0); PG8_MMA(0, 1, At, B1); PG8_BAR; PG8_SCHED;
            if (!hf) PG8_LDA(At, 0, 1); PG8_STAGE(PG8_SB(0, 0), b2, voffB); PG8_STAGE(PG8_SB(0, 1), b2 + hstepB, voffB); PG8_STAGE(PG8_SA(0, 0), a2, w0);
            PG8_WAIT_V(8); PG8_WAIT_L(0); PG8_BAR; if (!hf) { PG8_MMA(1, 0, At, B0); PG8_MMA(1, 1, At, B1); } PG8_BAR; PG8_SCHED;
            PG8_LDB(B0, 1, 0); PG8_LDB(B1, 1, 1); PG8_SCHED; PG8_LDA(At, 1, 0); PG8_STAGE(PG8_SA(0, 1), a2, w1);
            PG8_WAIT_V(8); PG8_WAIT_L(0); PG8_BAR; PG8_MMA(0, 0, At, B0); PG8_MMA(0, 1, At, B1); PG8_BAR; PG8_SCHED;
            if (!hf) PG8_LDA(At, 1, 1); PG8_STAGE(PG8_SB(1, 0), b3, voffB); PG8_STAGE(PG8_SB(1, 1), b3 + hstepB, voffB); PG8_STAGE(PG8_SA(1, 0), a3, w0);
            PG8_WAIT_V(8); PG8_WAIT_L(0); PG8_BAR; if (!hf) { PG8_MMA(1, 0, At, B0); PG8_MMA(1, 1, At, B1); } PG8_BAR; PG8_SCHED;
        }
        if (wr == 0) PG8_BAR;
        E(acc, cur, wr, wc, fr, fq);
        if (!has_next) break;
        if (!S.keep(cur)) {
#pragma unroll
        for (int a = 0; a < 2; ++a)
#pragma unroll
            for (int b = 0; b < 2; ++b)
#pragma unroll
                for (int m = 0; m < 4; ++m)
#pragma unroll
                    for (int n = 0; n < 2; ++n) acc[a][b][m][n] = (f32x4){0.f, 0.f, 0.f, 0.f};
        }
        cur = nxt; cB = nB; ++ui;
#pragma unroll
        for (int h = 0; h < 2; ++h)
#pragma unroll
            for (int i = 0; i < 2; ++i) vAc[h][i] = vAn[h][i];
        if (wr == 1) PG8_BAR;
    }
    PG8_WAIT_V(0);
    PG8_BAR;
#undef PG8_SA
#undef PG8_SB
#undef PG8_STAGE
#undef PG8_LDA
#undef PG8_LDB
#undef PG8_MMA
#undef PG8_WAIT_V
#undef PG8_WAIT_L
#undef PG8_BAR
#undef PG8_SCHED
}
}

struct SchedDense {
    pg8::StaticOrder so; const char* A; unsigned lda2; int K; const char* Bt; int rowmap;
    __device__ bool next(int i, pg8::Unit& u) const { return so.next(i, u); }
    __device__ const char* a_base() const { return A; }
    __device__ unsigned a_off(const pg8::Unit& u, int r) const { const int row = u.pm * 256 + r; return (unsigned)(rowmap ? prow_of(row) : row) * lda2; }
    __device__ const char* b_ptr(const pg8::Unit& u) const { return Bt + (size_t)u.pn * 256 * K * 2; }
    __device__ bool keep(const pg8::Unit&) const { return false; }
    __device__ bool half(const pg8::Unit&) const { return false; }
};
struct SchedMerge {
    pg8::StaticOrder so; const char* base; unsigned offA, offB; int K; const char* Whg; const char* Wgd;
    __device__ bool next(int i, pg8::Unit& u) const { const bool ok = so.next(i >> 1, u); u.e = i & 1; return ok; }
    __device__ const char* a_base() const { return base; }
    __device__ unsigned a_off(const pg8::Unit& u, int r) const { return (u.e ? offB : offA) + (unsigned)(u.pm * 256 + r) * 1024u; }
    __device__ const char* b_ptr(const pg8::Unit& u) const { return (u.e ? Wgd : Whg) + (size_t)u.pn * 256 * K * 2; }
    __device__ bool keep(const pg8::Unit& u) const { return u.e == 0; }
    __device__ bool half(const pg8::Unit&) const { return false; }
};
struct SchedMoe {
    const int* cnt; const int* list; LAS const int* pref;
    const char* A; unsigned lda2; int K; const char* Bt; size_t bstride; int gather; int G, c;
    __device__ bool next(int i, pg8::Unit& u) const {
        const int L = i * G + c; const int nF = pref[33 + NEXP] * 4, nH = pref[66 + NEXP] * 4; if (L >= nF + nH) return false;
        int e = 0;
        if (L < nF) {
#pragma unroll 1
            for (int j = 1; j < NEXP; ++j) if (L >= pref[33 + j] * 4) e = j;
            const int q = L - pref[33 + e] * 4, nte = pref[33 + e + 1] - pref[33 + e];
            u.e = e; u.pn = q / nte; u.t = q % nte;
        } else {
            const int Lh = L - nF;
#pragma unroll 1
            for (int j = 1; j < NEXP; ++j) if (Lh >= pref[66 + j] * 4) e = j;
            u.e = e; u.pn = Lh - pref[66 + e] * 4; u.t = (pref[e + 1] - pref[e]) - 1;
        }
        u.pm = pref[u.e] + u.t; return true;
    }
    __device__ const char* a_base() const { return A; }
    __device__ unsigned a_off(const pg8::Unit& u, int r) const {
        if (gather) { const int p = u.t * 256 + r; const int n = cnt[u.e]; const int tok = p < n ? list[u.e * ECAP + p] : 0; return (unsigned)tok * lda2; }
        return (unsigned)(u.pm * 256 + r) * lda2;
    }
    __device__ const char* b_ptr(const pg8::Unit& u) const { return Bt + (size_t)u.e * bstride + (size_t)u.pn * 256 * K * 2; }
    __device__ bool keep(const pg8::Unit&) const { return false; }
    __device__ bool half(const pg8::Unit& u) const { const int rem = cnt[u.e] & 255; return rem != 0 && rem <= 128 && u.t == (pref[u.e + 1] - pref[u.e]) - 1; }
};

struct EpiProj {
    static constexpr bool PERM = true;
    bf16_t* proj; const float* lbt; const float* rsx;
    __device__ __forceinline__ void operator()(const f32x4 (&acc)[2][2][4][2], const pg8::Unit& u, int wr, int wc, int fr, int fq) const {
        const int seg = u.pn >> 1;
        float rv[2][4];
#pragma unroll
        for (int ai = 0; ai < 2; ++ai)
#pragma unroll
            for (int m = 0; m < 4; ++m) rv[ai][m] = rsx[u.pm * 256 + wr * 64 + fr + ai * 128 + m * 16];
        const int row0 = prow_of(u.pm * 256) + wr * 64 + fr, col0 = u.pn * 256 + wc * 32 + 8 * fq;
        const int mode = (seg == 0 || seg == 3 || seg == 7) ? 1 : (seg == 1 ? 2 : 0);
        float lb[2][8];
#pragma unroll
        for (int bj = 0; bj < 2; ++bj)
#pragma unroll
            for (int j = 0; j < 8; ++j) lb[bj][j] = (mode == 2) ? lbt[col0 + bj * 128 + j - C_LF] : 0.f;
#pragma unroll
        for (int ai = 0; ai < 2; ++ai)
#pragma unroll
            for (int m = 0; m < 4; ++m) { bf16_t* rowp = proj + (size_t)(row0 + ai * 128 + m * 16) * NPROJ + col0;
#pragma unroll
                for (int bj = 0; bj < 2; ++bj) { float v[8];
#pragma unroll
                    for (int j = 0; j < 4; ++j) { v[j] = acc[ai][bj][m][0][j] * rv[ai][m]; v[4 + j] = acc[ai][bj][m][1][j] * rv[ai][m]; }
                    if (mode == 1) {
#pragma unroll
                        for (int j = 0; j < 8; ++j) v[j] = siluf_(v[j]);
                    } else if (mode == 2) {
#pragma unroll
                        for (int j = 0; j < 8; ++j) v[j] = __logf(lb[bj][j] + (1.0f - lb[bj][j]) * sigmoidf_(v[j]));
                    }
                    u32x4 w; w.x = cvt_pk_bf16(v[0], v[1]); w.y = cvt_pk_bf16(v[2], v[3]); w.z = cvt_pk_bf16(v[4], v[5]); w.w = cvt_pk_bf16(v[6], v[7]);
                    *(u32x4*)(rowp + bj * 128) = w; } }
    }
};
struct EpiMerge {
    static constexpr bool PERM = true;
    bf16_t* proj; bf16_t* mg;
    __device__ __forceinline__ void operator()(f32x4 (&acc)[2][2][4][2], const pg8::Unit& u, int wr, int wc, int fr, int fq) const {
        const int prow0 = prow_of(u.pm * 256) + wr * 64 + fr, row0 = u.pm * 256 + wr * 64 + fr, col0 = u.pn * 256 + wc * 32 + 8 * fq;
#pragma unroll
        for (int ai = 0; ai < 2; ++ai) {
            u32x4 gbw[4][2], gaw[4][2];
#pragma unroll
            for (int m = 0; m < 4; ++m) { const bf16_t* rp = proj + (size_t)(prow0 + ai * 128 + m * 16) * NPROJ + col0;
#pragma unroll
                for (int bj = 0; bj < 2; ++bj) { gbw[m][bj] = *(const u32x4*)(rp + C_PB + bj * 128); gaw[m][bj] = (u.e == 0) ? *(const u32x4*)(rp + C_PA + bj * 128) : (u32x4){0u, 0u, 0u, 0u}; } }
#pragma unroll
            for (int m = 0; m < 4; ++m)
#pragma unroll
                for (int bj = 0; bj < 2; ++bj) {
                    const u32x4 gb = gbw[m][bj], ga = gaw[m][bj];
                    const float gbv[8] = {bf_lo(gb.x), bf_hi(gb.x), bf_lo(gb.y), bf_hi(gb.y), bf_lo(gb.z), bf_hi(gb.z), bf_lo(gb.w), bf_hi(gb.w)};
                    if (u.e == 0) {
                        const float gav[8] = {bf_lo(ga.x), bf_hi(ga.x), bf_lo(ga.y), bf_hi(ga.y), bf_lo(ga.z), bf_hi(ga.z), bf_lo(ga.w), bf_hi(ga.w)};
#pragma unroll
                        for (int j = 0; j < 4; ++j) { acc[ai][bj][m][0][j] *= (1.0f + __expf(-gbv[j])) * __builtin_amdgcn_rcpf(1.0f + __expf(-gav[j])); acc[ai][bj][m][1][j] *= (1.0f + __expf(-gbv[4 + j])) * __builtin_amdgcn_rcpf(1.0f + __expf(-gav[4 + j])); }
                    } else {
                        float v[8];
#pragma unroll
                        for (int j = 0; j < 4; ++j) { v[j] = acc[ai][bj][m][0][j] * sigmoidf_(gbv[j]); v[4 + j] = acc[ai][bj][m][1][j] * sigmoidf_(gbv[4 + j]); }
                        u32x4 w; w.x = cvt_pk_bf16(v[0], v[1]); w.y = cvt_pk_bf16(v[2], v[3]); w.z = cvt_pk_bf16(v[4], v[5]); w.w = cvt_pk_bf16(v[6], v[7]);
                        *(u32x4*)(mg + (size_t)(row0 + ai * 128 + m * 16) * D + col0 + bj * 128) = w; }
                }
            asm volatile("" ::: "memory"); }
    }
};
struct EpiResid {
    static constexpr bool PERM = true;
    const float* x; bf16_t* h1b;
    __device__ __forceinline__ void operator()(const f32x4 (&acc)[2][2][4][2], const pg8::Unit& u, int wr, int wc, int fr, int fq) const {
        const int row0 = u.pm * 256 + wr * 64 + fr, col0 = u.pn * 256 + wc * 32 + 8 * fq;
#pragma unroll
        for (int ai = 0; ai < 2; ++ai) {
            f32x4 xv[4][2][2];
#pragma unroll
            for (int m = 0; m < 4; ++m) { const size_t off = (size_t)(row0 + ai * 128 + m * 16) * D + col0;
#pragma unroll
                for (int bj = 0; bj < 2; ++bj)
#pragma unroll
                    for (int n = 0; n < 2; ++n) xv[m][bj][n] = *(const f32x4*)(x + off + bj * 128 + n * 4); }
#pragma unroll
            for (int m = 0; m < 4; ++m) { const size_t off = (size_t)(row0 + ai * 128 + m * 16) * D + col0;
#pragma unroll
                for (int bj = 0; bj < 2; ++bj) { const f32x4 a = xv[m][bj][0] + acc[ai][bj][m][0], b = xv[m][bj][1] + acc[ai][bj][m][1];
                    u32x4 w; w.x = cvt_pk_bf16(a[0], a[1]); w.y = cvt_pk_bf16(a[2], a[3]); w.z = cvt_pk_bf16(b[0], b[1]); w.w = cvt_pk_bf16(b[2], b[3]);
                    *(u32x4*)(h1b + off + bj * 128) = w; } }
            asm volatile("" ::: "memory"); }
    }
};
struct EpiSwiglu {
    static constexpr bool PERM = false;
    bf16_t* H; const float* rs;
    __device__ __forceinline__ void operator()(const f32x4 (&acc)[2][2][4][2], const pg8::Unit& u, int wr, int wc, int fr, int fq) const {
        const int row0 = u.pm * 256 + wr * 64 + fr, col0 = u.pn * 128 + wc * 16 + 4 * fq;
        const float* rsp = rs + (size_t)u.e * ECAP + u.t * 256 + wr * 64 + fr;
        float rv[2][4];
#pragma unroll
        for (int ai = 0; ai < 2; ++ai)
#pragma unroll
            for (int m = 0; m < 4; ++m) rv[ai][m] = rsp[ai * 128 + m * 16];
#pragma unroll
        for (int ai = 0; ai < 2; ++ai)
#pragma unroll
            for (int m = 0; m < 4; ++m) { bf16_t* rowp = H + (size_t)(row0 + ai * 128 + m * 16) * 512 + col0;
#pragma unroll
                for (int bj = 0; bj < 2; ++bj) { const f32x4 g = acc[ai][bj][m][0] * rv[ai][m], up = acc[ai][bj][m][1] * rv[ai][m];
                    u32x2 w; w.x = cvt_pk_bf16(siluf_(g[0]) * up[0], siluf_(g[1]) * up[1]); w.y = cvt_pk_bf16(siluf_(g[2]) * up[2], siluf_(g[3]) * up[3]);
                    *(u32x2*)(rowp + bj * 64) = w; } }
    }
};
struct EpiY {
    static constexpr bool PERM = true;
    bf16_t* Y;
    __device__ __forceinline__ void operator()(const f32x4 (&acc)[2][2][4][2], const pg8::Unit& u, int wr, int wc, int fr, int fq) const {
        const int row0 = u.pm * 256 + wr * 64 + fr, col0 = u.pn * 256 + wc * 32 + 8 * fq;
#pragma unroll
        for (int ai = 0; ai < 2; ++ai)
#pragma unroll
            for (int m = 0; m < 4; ++m) { bf16_t* rowp = Y + (size_t)(row0 + ai * 128 + m * 16) * D + col0;
#pragma unroll
                for (int bj = 0; bj < 2; ++bj) { const f32x4 a = acc[ai][bj][m][0], b = acc[ai][bj][m][1];
                    u32x4 w; w.x = cvt_pk_bf16(a[0], a[1]); w.y = cvt_pk_bf16(a[2], a[3]); w.z = cvt_pk_bf16(b[0], b[1]); w.w = cvt_pk_bf16(b[2], b[3]);
                    *(u32x4*)(rowp + bj * 128) = w; } }
    }
};


#define XB_TMO      128
#define XB_XCNT(j)  (256  + 64 * (j))
#define XB_XSUB(j)  (1280 + 64 * (j))
#define XB_XGEN(j)  (2304 + 64 * (j))
#define XB_TOP      3328
#define XB_TOPGEN   3392
#define XCD_BAR_WORDS 3456
#define XB_SPIN_CAP (1u << 22)
__device__ __forceinline__ unsigned xb_ld(unsigned* p)              { return __hip_atomic_load(p, __ATOMIC_RELAXED, __HIP_MEMORY_SCOPE_AGENT); }
__device__ __forceinline__ unsigned xb_add(unsigned* p, unsigned v) { return __hip_atomic_fetch_add(p, v, __ATOMIC_RELAXED, __HIP_MEMORY_SCOPE_AGENT); }
__device__ __forceinline__ unsigned xb_xcc_id() { return (unsigned)__builtin_amdgcn_s_getreg((3 << 11) | 20) & 0xFu; }
#define XB_SPIN(cond, bar) do { unsigned _sp = 0; while (cond) { __builtin_amdgcn_s_sleep(1); \
    if ((++_sp & 255u) == 0u) { if (xb_ld(&(bar)[XB_TMO])) break; if (_sp > XB_SPIN_CAP) { atomicAdd(&(bar)[XB_TMO], 1u); break; } } } } while (0)
struct XcdBarrier { unsigned* bar; unsigned x; volatile LAS unsigned* st; };
__device__ __forceinline__ XcdBarrier xcd_barrier_post(unsigned* bar, volatile LAS unsigned* st) {
    XcdBarrier b; b.bar = bar; b.x = xb_xcc_id(); b.st = st;
    if (threadIdx.x == 0) (void)xb_add(&bar[XB_XCNT(b.x)], 1u);
    return b;
}
__device__ __forceinline__ void xcd_barrier_complete(unsigned* bar, unsigned x, unsigned& nloc, unsigned& nx) {
    const unsigned G = gridDim.x * gridDim.y * gridDim.z;
    unsigned sum, cnt, mine, sp = 0u;
    for (;;) {
        sum = 0u; cnt = 0u; mine = 0u;
#pragma unroll
        for (unsigned j = 0; j < 16; ++j) { const unsigned c = xb_ld(&bar[XB_XCNT(j)]); sum += c; cnt += (c > 0u) ? 1u : 0u; mine = (j == x) ? c : mine; }
        if (sum == G) break;
        __builtin_amdgcn_s_sleep(1);
        if ((++sp & 255u) == 0u) { if (xb_ld(&bar[XB_TMO])) break; if (sp > XB_SPIN_CAP) { atomicAdd(&bar[XB_TMO], 1u); break; } }
    }
    nloc = mine > 0u ? mine : 1u; nx = cnt > 0u ? cnt : 1u;
}
__device__ __forceinline__ void xcd_barrier(const XcdBarrier& b) {
    asm volatile("s_waitcnt vmcnt(0)" ::: "memory");
    __syncthreads();
    if (threadIdx.x == 0) {
        unsigned* bar = b.bar;
        __builtin_amdgcn_s_waitcnt(0);
        unsigned nloc = b.st[0], nx = b.st[1];
        if (nloc == 0u) { xcd_barrier_complete(bar, b.x, nloc, nx); b.st[0] = nloc; b.st[1] = nx; }
        const unsigned old = xb_add(&bar[XB_XSUB(b.x)], 1u);
        const unsigned gen = old / nloc;
        if (old + 1u == (gen + 1u) * nloc) {
            __builtin_amdgcn_fence(__ATOMIC_RELEASE, "agent");
            asm volatile("s_waitcnt vmcnt(0)" ::: "memory");
            const unsigned og = xb_add(&bar[XB_TOP], 1u);
            const unsigned tg = og / nx;
            if (og + 1u == (tg + 1u) * nx) xb_add(&bar[XB_TOPGEN], 1u);
            else XB_SPIN(xb_ld(&bar[XB_TOPGEN]) == tg, bar);
            __builtin_amdgcn_fence(__ATOMIC_ACQUIRE, "agent");
            xb_add(&bar[XB_XGEN(b.x)], 1u);
            asm volatile("s_waitcnt vmcnt(0)" ::: "memory");
        } else {
            XB_SPIN(xb_ld(&bar[XB_XGEN(b.x)]) == gen, bar);
            __builtin_amdgcn_fence(__ATOMIC_ACQUIRE, "agent");
            asm volatile("s_waitcnt vmcnt(0)" ::: "memory");
        }
    }
    __syncthreads();
}

constexpr int LDS_BYTES = 150 * 1024;
constexpr int NTHR = 512;
struct Args {
    const float* in[22]; float* out; char* ws; int ph_lo, ph_hi;
};

__device__ __forceinline__ f32x4 mfma16(bf16x8 a, bf16x8 b, f32x4 c) { return __builtin_amdgcn_mfma_f32_16x16x32_bf16(a, b, c, 0, 0, 0); }
struct TrJob { const float* s0; const float* s1; bf16_t* dst; int mode, K, ld, ndst, nb; size_t sbatch, dbatch; const float* ks; };
__device__ __forceinline__ void tr_load(f32x4 (&v)[8], const TrJob& j, int t) {
    const int tk = j.K / 64, tn = j.ndst / 256, per = tk * tn; const int e = t / per, r = t % per, k0 = (r % tk) * 64, n0 = (r / tk) * 256;
    const float* a = j.s0 + (size_t)e * j.sbatch; const float* b = j.s1 ? j.s1 + (size_t)e * j.sbatch : nullptr;
    const int tid = threadIdx.x;
#pragma unroll
    for (int i = 0; i < 8; ++i) { const int idx = tid + NTHR * i, row = idx >> 6, j4 = idx & 63, n = n0 + 4 * j4;
        const float* p;
        if (j.mode == 0) p = a + (n < 4096 ? n : n + 8);
        else if (j.mode == 1) p = a + n;
        else { const int grp = n >> 5, w = n & 31; p = (w < 16 ? a : b) + grp * 16 + (w & 15); }
        v[i] = *(const f32x4*)(p + (size_t)(k0 + row) * j.ld); if (j.ks) v[i] = v[i] * j.ks[k0 + row]; }
}
__device__ __forceinline__ void tr_store(LAS float* tile  , const f32x4 (&v)[8], const TrJob& j, int t) {
    const int tk = j.K / 64, tn = j.ndst / 256, per = tk * tn; const int e = t / per, r = t % per, k0 = (r % tk) * 64, n0 = (r / tk) * 256;
    bf16_t* dst = j.dst + (size_t)e * j.dbatch; const int K = j.K;
    const int tid = threadIdx.x;
    __syncthreads();
#pragma unroll
    for (int i = 0; i < 8; ++i) { const int idx = tid + NTHR * i, row = idx >> 6, j4 = idx & 63; *(LAS f32x4*)(tile + row * 260 + 4 * j4) = v[i]; }
    __syncthreads();
#pragma unroll
    for (int i = 0; i < 4; ++i) { const int ch = tid + NTHR * i, n = ch >> 3, kq = (ch & 7) * 8;
        unsigned w[4];
#pragma unroll
        for (int jx = 0; jx < 4; ++jx) w[jx] = cvt_pk_bf16(tile[(kq + 2 * jx) * 260 + n], tile[(kq + 2 * jx + 1) * 260 + n]);
        *(u32x4*)(dst + (size_t)(n0 + n) * K + k0 + kq) = (u32x4){w[0], w[1], w[2], w[3]}; }
}
__device__ __forceinline__ void run_tr(LAS unsigned char* lds, const TrJob& j, int first, int stride) {
    const int total = (j.K / 64) * (j.ndst / 256) * j.nb;
    f32x4 va[8], vb[8];
    int t = first;
    if (t < total) tr_load(va, j, t);
    while (t < total) {
        int tn = t + stride;
        if (tn < total) tr_load(vb, j, tn);
        tr_store((LAS float*)lds, va, j, t);
        t = tn; if (t >= total) break;
        tn = t + stride;
        if (tn < total) tr_load(va, j, tn);
        tr_store((LAS float*)lds, vb, j, t);
        t = tn;
    }
    __syncthreads();
}
__device__ __forceinline__ float softplusf_(float x) { return x > 20.f ? x : log1pf(__expf(x)); }

constexpr int PX_ST = 2064;
__device__ __forceinline__ void p0_prep_x(LAS unsigned char* lds, const float* x, const float* g1, const float* w_in, const float* A_log, const float* dt_bias, bf16_t* xb, float* gbf, float* rsx) {
    const int tid = threadIdx.x, wv = tid >> 6, l = tid & 63, c = l & 15, q = l >> 4;
    __syncthreads();
    for (int i = tid; i < 2048; i += NTHR) { const int k = i >> 1, j4 = (i & 1) * 4; const f32x4 g = *(const f32x4*)(w_in + (size_t)k * WIN_LD + 4096 + j4); const float gg = g1[k];
#pragma unroll
        for (int n = 0; n < 4; ++n) { const float w = g[n] * gg; const bf16_t hi = f2bf(w); *(LAS bf16_t*)(lds + (j4 + n) * PX_ST + k * 2) = hi; *(LAS bf16_t*)(lds + (8 + j4 + n) * PX_ST + k * 2) = f2bf(w - bf2f(hi)); } }
    if (tid < PX_ST / 16) *(LAS u32x4*)(lds + 16 * PX_ST + tid * 16) = (u32x4){0u, 0u, 0u, 0u};
    __syncthreads();
    const int ohi = (c < 8 ? c : 16) * PX_ST + 32 * q, olo = (c < 8 ? 8 + c : 16) * PX_ST + 32 * q;
    for (int tile = blockIdx.x * 8 + wv; tile * 16 < T; tile += gridDim.x * 8) {
        const int row = tile * 16 + c;
        const float* xr = x + (size_t)row * D + 16 * q;
        bf16_t* xo = xb + (size_t)row * D + 16 * q;
        f32x4 acc = (f32x4){0.f, 0.f, 0.f, 0.f}; float ss = 0.f;
#pragma unroll 8
        for (int j = 0; j < 16; ++j) {
            f32x4 a[4];
#pragma unroll
            for (int e = 0; e < 4; ++e) a[e] = *(const f32x4*)(xr + 64 * j + 4 * e);
#pragma unroll
            for (int e = 0; e < 4; ++e) ss += a[e][0] * a[e][0] + a[e][1] * a[e][1] + a[e][2] * a[e][2] + a[e][3] * a[e][3];
            u32x4 hi[2], lo[2];
#pragma unroll
            for (int s_ = 0; s_ < 2; ++s_) { const f32x4 p = a[2 * s_], r = a[2 * s_ + 1];
                hi[s_].x = cvt_pk_bf16(p[0], p[1]); hi[s_].y = cvt_pk_bf16(p[2], p[3]); hi[s_].z = cvt_pk_bf16(r[0], r[1]); hi[s_].w = cvt_pk_bf16(r[2], r[3]);
                lo[s_].x = cvt_pk_bf16(p[0] - bf_lo(hi[s_].x), p[1] - bf_hi(hi[s_].x)); lo[s_].y = cvt_pk_bf16(p[2] - bf_lo(hi[s_].y), p[3] - bf_hi(hi[s_].y));
                lo[s_].z = cvt_pk_bf16(r[0] - bf_lo(hi[s_].z), r[1] - bf_hi(hi[s_].z)); lo[s_].w = cvt_pk_bf16(r[2] - bf_lo(hi[s_].w), r[3] - bf_hi(hi[s_].w)); }
            *(u32x4*)(xo + 64 * j) = hi[0]; *(u32x4*)(xo + 64 * j + 8) = hi[1];
#pragma unroll
            for (int s_ = 0; s_ < 2; ++s_) { const bf16x8 ah = __builtin_bit_cast(bf16x8, hi[s_]), al = __builtin_bit_cast(bf16x8, lo[s_]);
                const bf16x8 bh = *(const LAS bf16x8*)(lds + ohi + 128 * j + 16 * s_), bl = *(const LAS bf16x8*)(lds + olo + 128 * j + 16 * s_);
                acc = mfma16(ah, bh, acc); acc = mfma16(ah, bl, acc); acc = mfma16(al, bh, acc); }
        }
        ss += __shfl_xor(ss, 16); ss += __shfl_xor(ss, 32);
        const float rstd = rsqrtf(ss * (1.0f / D) + EPS);
        if (q == 0) rsx[row] = rstd;
#pragma unroll
        for (int i = 0; i < 4; ++i) { const float rr = __shfl(rstd, 4 * q + i); const float v = acc[i] * rr;
            if (c < 8) { const int cj = c & 3; const float o = c < 4 ? sigmoidf_(v) : -__expf(A_log[cj]) * softplusf_(v + dt_bias[cj]);
                gbf[(size_t)prow_of(tile * 16 + 4 * q + i) * 8 + c] = o; } }
    }
    __syncthreads();
}
constexpr int META_CG = (WIN_LD + 127) / 128, META_WG = 2 * META_CG;
__device__ __forceinline__ void p0_meta(LAS unsigned char* lds, const float* meta, const float* g1, const float* w_in, float* mp) {
    LAS float* hn = (LAS float*)lds;
    LAS float* red = (LAS float*)lds;
    const int wv = threadIdx.x >> 6, l = threadIdx.x & 63;
    if (blockIdx.x < META_WG) {
        const int cg = blockIdx.x >> 1, kh = blockIdx.x & 1;
        __syncthreads();
        for (int r = wv; r < 16; r += 8) {
            const f32x4* xr = (const f32x4*)(meta + (size_t)r * D);
            f32x4 v[4]; float ss = 0.f;
#pragma unroll
            for (int i = 0; i < 4; ++i) { v[i] = xr[l + 64 * i]; ss += v[i][0] * v[i][0] + v[i][1] * v[i][1] + v[i][2] * v[i][2] + v[i][3] * v[i][3]; }
            ss = wave_sum(ss);
            const float rstd = rsqrtf(ss * (1.0f / D) + EPS);
#pragma unroll
            for (int i = 0; i < 4; ++i) { const f32x4 gv = ((const f32x4*)g1)[l + 64 * i];
#pragma unroll
                for (int c = 0; c < 4; ++c) hn[(4 * (l + 64 * i) + c) * 16 + r] = v[i][c] * rstd * gv[c]; }
        }
        __syncthreads();
        const int cl = threadIdx.x & 31, kg = threadIdx.x >> 5;
        const int n0 = cg * 128 + 4 * cl, ncl = n0 < WIN_LD ? n0 : 0, kbase = 512 * kh + 32 * kg;
        f32x4 acc[16];
#pragma unroll
        for (int i = 0; i < 16; ++i) acc[i] = (f32x4){0.f, 0.f, 0.f, 0.f};
#pragma unroll 1
        for (int kb = 0; kb < 2; ++kb) {
            f32x4 wq[16];
            const float* wrow = w_in + (size_t)(kbase + kb * 16) * WIN_LD + ncl;
#pragma unroll
            for (int kk = 0; kk < 16; ++kk) wq[kk] = *(const f32x4*)(wrow + (size_t)kk * WIN_LD);
            const LAS float* hrow = hn + (kbase + kb * 16) * 16;
#pragma unroll
            for (int kk = 0; kk < 16; ++kk) {
#pragma unroll
                for (int i4 = 0; i4 < 4; ++i4) { const f32x4 h = *(const LAS f32x4*)&hrow[kk * 16 + 4 * i4]; acc[4 * i4] += wq[kk] * h[0]; acc[4 * i4 + 1] += wq[kk] * h[1]; acc[4 * i4 + 2] += wq[kk] * h[2]; acc[4 * i4 + 3] += wq[kk] * h[3]; } } }
        __syncthreads();
#pragma unroll
        for (int i = 0; i < 16; ++i)
#pragma unroll
            for (int cc = 0; cc < 4; ++cc) red[(kg * 128 + 4 * cl + cc) * 17 + i] = acc[i][cc];
        __syncthreads();
#pragma unroll 1
        for (int e = 0; e < 4; ++e) { const int o = threadIdx.x + NTHR * e, i = o >> 7, col = o & 127;
          float v = 0.f;
#pragma unroll
          for (int g = 0; g < 16; ++g) v += red[(g * 128 + col) * 17 + i];
          const int n = cg * 128 + col;
          if (n < WIN_LD) mp[((size_t)kh * 16 + i) * WIN_LD + n] = v; }
        __syncthreads();
    }
}
__device__ __forceinline__ void meta_finalize(const float* mp, const float* lbl, const float* A_log, const float* dt_bias, bf16_t* proj, float* gbf) {
    for (int o = blockIdx.x * NTHR + threadIdx.x; o < 16 * WIN_LD; o += gridDim.x * NTHR) { const int i = o / WIN_LD, n = o % WIN_LD;
        float v = mp[(size_t)i * WIN_LD + n] + mp[(size_t)(16 + i) * WIN_LD + n];
        if (n < 4096 || n >= 4104) {
            const int pc = n < 4096 ? n : n - 8, seg = pc >> 9;
            if (seg == 0 || seg == 3 || seg == 7) v = siluf_(v);
            else if (seg == 1) { const float a = lbl[pc - C_LF], bq = lbl[512 + pc - C_LF]; const float m = fmaxf(a, bq); const float ea = __expf(a - m), eb = __expf(bq - m); const float lb = ea / (ea + eb); v = __logf(lb + (1.0f - lb) * sigmoidf_(v)); }
            const bf16_t ob = f2bf(v);
            for (int b = 0; b < NB; ++b) proj[(size_t)(b * LP + 48 + i) * NPROJ + pc] = ob;
        } else {
            const int j = n - 4096;
            const float ov = j < 4 ? sigmoidf_(v) : -__expf(A_log[j - 4]) * softplusf_(v + dt_bias[j - 4]);
            for (int b = 0; b < NB; ++b) gbf[(size_t)(b * LP + 48 + i) * 8 + j] = ov;
        } }
}
__device__ __forceinline__ void p0_zero(bf16_t* proj, float* gbf) {
    for (size_t i = (size_t)blockIdx.x * NTHR + threadIdx.x; i < (size_t)NB * 48 * (NPROJ / 8); i += (size_t)gridDim.x * NTHR) {
        const int b = (int)(i / (48 * (NPROJ / 8))), rem = (int)(i % (48 * (NPROJ / 8))), r = rem / (NPROJ / 8), c8 = rem % (NPROJ / 8);
        *(u32x4*)(proj + (size_t)(b * LP + r) * NPROJ + c8 * 8) = (u32x4){0u, 0u, 0u, 0u};
    }
    for (int i = blockIdx.x * NTHR + threadIdx.x; i < NB * 48 * 8; i += gridDim.x * NTHR) { const int b = i / (48 * 8), rem = i % (48 * 8); gbf[(size_t)(b * LP) * 8 + rem] = 0.f; }
}

constexpr int HG_QDP = 0, HG_QS = 17408, HG_KS = 34816, HG_KHT = 52224, HG_VT = 70656, HG_AT = 89088, HG_SEG = 98304, HG_DEND = 102400, HG_PART = 102912;
constexpr int RS_K = 272, RS_T = 144;
__device__ __forceinline__ int kperm(int k) { const int w = k & 31; return (k & ~31) + 8 * ((w >> 2) & 3) + 4 * (w >> 4) + (w & 3); }
__device__ __forceinline__ bf16x8 pack8(const f32x4& lo, const f32x4& hi) {
    u32x4 p; p.x = cvt_pk_bf16(lo[0], lo[1]); p.y = cvt_pk_bf16(lo[2], lo[3]); p.z = cvt_pk_bf16(hi[0], hi[1]); p.w = cvt_pk_bf16(hi[2], hi[3]);
    return __builtin_bit_cast(bf16x8, p);
}
__device__ __forceinline__ float expc(float x) { return __expf(fminf(x, 80.0f)); }

template <bool OUT>
__device__ __forceinline__ void hgrn_run(LAS unsigned char* lds, bf16_t* proj, float* arun, float* drun, const float* gn, int item, bf16_t* oa) {
    const int tid = threadIdx.x, w = tid >> 6, lane = tid & 63, c = lane & 15, q = lane >> 4;
    const int bh = item >> 4, run = item & 15, b = bh >> 2, h = bh & 3;
    const int ch0 = run == 0 ? 0 : 9 + 8 * (run - 1), nc = run == 0 ? 9 : 8;
    LAS float* seg = (LAS float*)(lds + HG_SEG); LAS float* dend = (LAS float*)(lds + HG_DEND); LAS float* part = (LAS float*)(lds + HG_PART);
    f32x4 Sacc[8];
#pragma unroll
    for (int kt = 0; kt < 8; ++kt) Sacc[kt] = (f32x4){0.f, 0.f, 0.f, 0.f};
    if (OUT) {
        for (int m = 0; m < run; ++m) { const int im = bh * 16 + m;
#pragma unroll
            for (int kt = 0; kt < 8; ++kt) { const f32x4 d4 = *(const f32x4*)(drun + (size_t)im * 128 + 16 * kt + 4 * q); const f32x4 a4 = *(const f32x4*)(arun + (((size_t)im * 8 + w) * 8 + kt) * 256 + lane * 4); Sacc[kt] = Sacc[kt] * d4 + a4; } }
    }
    float dp = 1.0f;
    const int col = 2 * lane, sg = w;
    unsigned lfw[8], qw[8], vw[8];
#define HG_LOAD(ci_) do { const bf16_t* base_ = proj + (size_t)(b * LP + (ch0 + (ci_)) * 64 + 8 * sg) * NPROJ + h * 128 + col; \
        _Pragma("unroll") for (int j = 0; j < 8; ++j) { lfw[j] = *(const unsigned*)(base_ + (size_t)j * NPROJ + C_LF); vw[j] = *(const unsigned*)(base_ + (size_t)j * NPROJ + C_VA); qw[j] = OUT ? *(const unsigned*)(base_ + (size_t)j * NPROJ + C_QA) : 0u; } } while (0)
    HG_LOAD(0);
    for (int ci = 0; ci < nc; ++ci) {
        const int r0 = b * LP + (ch0 + ci) * 64;
        __syncthreads();
        u32x2 gwp[4];
        if (OUT) {
#pragma unroll
            for (int tt = 0; tt < 4; ++tt) gwp[tt] = *(const u32x2*)(proj + (size_t)(r0 + 16 * tt + c) * NPROJ + h * 128 + 16 * w + 4 * q + C_HG);
        }
        float cs0[8], cs1[8]; { float s0 = 0.f, s1 = 0.f;
#pragma unroll
            for (int j = 0; j < 8; ++j) { s0 += bf_lo(lfw[j]); cs0[j] = s0; s1 += bf_hi(lfw[j]); cs1[j] = s1; }
            seg[sg * 128 + col] = s0; seg[sg * 128 + col + 1] = s1; }
        __syncthreads();
        float base0 = 0.f, base1 = 0.f, bend0 = 0.f, bend1 = 0.f, bref0 = 0.f, bref1 = 0.f;
#pragma unroll
        for (int g = 0; g < 8; ++g) { const float a0 = seg[g * 128 + col], a1 = seg[g * 128 + col + 1]; if (g < sg) { base0 += a0; base1 += a1; } if (g < 4) { bref0 += a0; bref1 += a1; } bend0 += a0; bend1 += a1; }
        unsigned khw0[4], khw1[4];
        float kh0p = 0.f, kh1p = 0.f;
#pragma unroll
        for (int j = 0; j < 8; ++j) {
            const int t = 8 * sg + j;
            const float b0 = base0 + cs0[j], b1 = base1 + cs1[j];
            const float kk0 = 1.0f - __expf(bf_lo(lfw[j])), kk1 = 1.0f - __expf(bf_hi(lfw[j]));
            const float kh0 = kk0 * __expf(bend0 - b0), kh1 = kk1 * __expf(bend1 - b1);
            if (j & 1) { khw0[j >> 1] = cvt_pk_bf16(kh0p, kh0); khw1[j >> 1] = cvt_pk_bf16(kh1p, kh1); } else { kh0p = kh0; kh1p = kh1; }
            if (OUT) {
                const float q0 = bf_lo(qw[j]), q1 = bf_hi(qw[j]);
                *(LAS unsigned*)(lds + HG_QDP + t * RS_K + kperm(col) * 2) = cvt_pk_bf16(q0 * __expf(b0), q1 * __expf(b1));
                *(LAS unsigned*)(lds + HG_QS + t * RS_K + col * 2) = cvt_pk_bf16(q0 * expc(b0 - bref0), q1 * expc(b1 - bref1));
                *(LAS unsigned*)(lds + HG_KS + t * RS_K + col * 2) = cvt_pk_bf16(kk0 * expc(bref0 - b0), kk1 * expc(bref1 - b1));
            }
        }
        *(LAS u32x4*)(lds + HG_KHT + col * RS_T + 16 * sg) = (u32x4){khw0[0], khw0[1], khw0[2], khw0[3]};
        *(LAS u32x4*)(lds + HG_KHT + (col + 1) * RS_T + 16 * sg) = (u32x4){khw1[0], khw1[1], khw1[2], khw1[3]};
        { u32x4 v0, v1;
          v0.x = (vw[0] & 0xffffu) | (vw[1] << 16); v0.y = (vw[2] & 0xffffu) | (vw[3] << 16); v0.z = (vw[4] & 0xffffu) | (vw[5] << 16); v0.w = (vw[6] & 0xffffu) | (vw[7] << 16);
          v1.x = (vw[0] >> 16) | (vw[1] & 0xffff0000u); v1.y = (vw[2] >> 16) | (vw[3] & 0xffff0000u); v1.z = (vw[4] >> 16) | (vw[5] & 0xffff0000u); v1.w = (vw[6] >> 16) | (vw[7] & 0xffff0000u);
          *(LAS u32x4*)(lds + HG_VT + col * RS_T + 16 * sg) = v0; *(LAS u32x4*)(lds + HG_VT + (col + 1) * RS_T + 16 * sg) = v1; }
        if (sg == 7) { dend[col] = __expf(bend0); dend[col + 1] = __expf(bend1); }
        if (ci + 1 < nc) HG_LOAD(ci + 1);
        __syncthreads();
        if (!OUT) { if (tid < 128) dp *= dend[tid]; }
        if (OUT) {
#pragma unroll
            for (int rep = 0; rep < 2; ++rep) { const int id = w + 8 * rep, st = id >> 2, tt = id & 3;
                f32x4 acc = (f32x4){0.f, 0.f, 0.f, 0.f};
                if (st <= tt) {
#pragma unroll
                    for (int ks = 0; ks < 4; ++ks) { const bf16x8 a = *(const LAS bf16x8*)(lds + HG_KS + (16 * st + c) * RS_K + (32 * ks + 8 * q) * 2); const bf16x8 bq = *(const LAS bf16x8*)(lds + HG_QS + (16 * tt + c) * RS_K + (32 * ks + 8 * q) * 2); acc = mfma16(a, bq, acc); }
                }
                const int tq = 16 * tt + c, s0 = 16 * st + 4 * q;
                u32x2 o; o.x = cvt_pk_bf16(s0 <= tq ? acc[0] : 0.f, s0 + 1 <= tq ? acc[1] : 0.f); o.y = cvt_pk_bf16(s0 + 2 <= tq ? acc[2] : 0.f, s0 + 3 <= tq ? acc[3] : 0.f);
                *(LAS u32x2*)(lds + HG_AT + tq * RS_T + s0 * 2) = o; }
            __syncthreads();
            f32x4 oacc[4];
#pragma unroll
            for (int tt = 0; tt < 4; ++tt) oacc[tt] = (f32x4){0.f, 0.f, 0.f, 0.f};
#pragma unroll
            for (int ks = 0; ks < 4; ++ks) { const bf16x8 a = pack8(Sacc[2 * ks], Sacc[2 * ks + 1]);
#pragma unroll
                for (int tt = 0; tt < 4; ++tt) { const bf16x8 bq = *(const LAS bf16x8*)(lds + HG_QDP + (16 * tt + c) * RS_K + (32 * ks + 8 * q) * 2); oacc[tt] = mfma16(a, bq, oacc[tt]); } }
#pragma unroll
            for (int ss = 0; ss < 2; ++ss) { const bf16x8 a = *(const LAS bf16x8*)(lds + HG_VT + (16 * w + c) * RS_T + (32 * ss + 8 * q) * 2);
#pragma unroll
                for (int tt = 0; tt < 4; ++tt) { const bf16x8 bq = *(const LAS bf16x8*)(lds + HG_AT + (16 * tt + c) * RS_T + (32 * ss + 8 * q) * 2); oacc[tt] = mfma16(a, bq, oacc[tt]); } }
#pragma unroll
            for (int tt = 0; tt < 4; ++tt) { float p = oacc[tt][0] * oacc[tt][0] + oacc[tt][1] * oacc[tt][1] + oacc[tt][2] * oacc[tt][2] + oacc[tt][3] * oacc[tt][3];
                p += __shfl_xor(p, 16); p += __shfl_xor(p, 32); if (q == 0) part[w * 64 + 16 * tt + c] = p; }
            __syncthreads();
            const f32x4 gnv = *(const f32x4*)(gn + 16 * w + 4 * q);
#pragma unroll
            for (int tt = 0; tt < 4; ++tt) { float tot = 0.f;
#pragma unroll
                for (int ww = 0; ww < 8; ++ww) tot += part[ww * 64 + 16 * tt + c];
                const float rstd = rsqrtf(tot * (1.0f / 128.0f) + EPS);
                bf16_t* rp = proj + (size_t)(r0 + 16 * tt + c) * NPROJ + h * 128 + 16 * w + 4 * q;
                const u32x2 gw = gwp[tt];
                u32x2 o; o.x = cvt_pk_bf16(oacc[tt][0] * rstd * gnv[0] * bf_lo(gw.x), oacc[tt][1] * rstd * gnv[1] * bf_hi(gw.x));
                o.y = cvt_pk_bf16(oacc[tt][2] * rstd * gnv[2] * bf_lo(gw.y), oacc[tt][3] * rstd * gnv[3] * bf_hi(gw.y));
                if (ch0 + ci >= 1) *(u32x2*)(oa + (size_t)(b * SEQ + (ch0 + ci - 1) * 64 + 16 * tt + c) * 512 + h * 128 + 16 * w + 4 * q) = o; }
        }
#pragma unroll
        for (int kt = 0; kt < 8; ++kt) { const f32x4 d4 = *(const LAS f32x4*)(dend + 16 * kt + 4 * q); Sacc[kt] = Sacc[kt] * d4;
#pragma unroll
            for (int ts = 0; ts < 2; ++ts) { const bf16x8 a = *(const LAS bf16x8*)(lds + HG_KHT + (16 * kt + c) * RS_T + (32 * ts + 8 * q) * 2); const bf16x8 bq = *(const LAS bf16x8*)(lds + HG_VT + (16 * w + c) * RS_T + (32 * ts + 8 * q) * 2); Sacc[kt] = mfma16(a, bq, Sacc[kt]); } }
    }
    if (!OUT) {
#pragma unroll
        for (int kt = 0; kt < 8; ++kt) *(f32x4*)(arun + (((size_t)item * 8 + w) * 8 + kt) * 256 + lane * 4) = Sacc[kt];
        if (tid < 128) drun[(size_t)item * 128 + tid] = dp;
    }
    __syncthreads();
#undef HG_LOAD
}


constexpr int GB_KN = 0, GB_QN = 17408, GB_RTK = 34816, GB_RTV = 53248, GB_TM = 71680, GB_LM = 80896, GB_TF = 98304, GB_XS = 115712, LST = 68;
constexpr int GD_NITEM = NB * 129 * 4;
struct GdnBufs { bf16_t* QT; bf16_t* AT; bf16_t* WP; bf16_t* U0T; bf16_t* KHT; float* GEND; };

__device__ __forceinline__ void head_norm_store(f32x4 (&oacc)[4], LAS float* part, bf16_t* proj, int r0, int h, int cgate, int cout, const float* gn, int w, int c, int q) {
#pragma unroll
    for (int tt = 0; tt < 4; ++tt) { float p = oacc[tt][0] * oacc[tt][0] + oacc[tt][1] * oacc[tt][1] + oacc[tt][2] * oacc[tt][2] + oacc[tt][3] * oacc[tt][3];
        p += __shfl_xor(p, 16); p += __shfl_xor(p, 32); if (q == 0) part[w * 64 + 16 * tt + c] = p; }
    __syncthreads();
    const f32x4 gnv = *(const f32x4*)(gn + 16 * w + 4 * q);
#pragma unroll
    for (int tt = 0; tt < 4; ++tt) { float tot = 0.f;
#pragma unroll
        for (int ww = 0; ww < 8; ++ww) tot += part[ww * 64 + 16 * tt + c];
        const float rstd = rsqrtf(tot * (1.0f / 128.0f) + EPS);
        bf16_t* rp = proj + (size_t)(r0 + 16 * tt + c) * NPROJ + h * 128 + 16 * w + 4 * q;
        const u32x2 gw = *(const u32x2*)(rp + cgate);
        u32x2 o; o.x = cvt_pk_bf16(oacc[tt][0] * rstd * gnv[0] * bf_lo(gw.x), oacc[tt][1] * rstd * gnv[1] * bf_hi(gw.x));
        o.y = cvt_pk_bf16(oacc[tt][2] * rstd * gnv[2] * bf_lo(gw.y), oacc[tt][3] * rstd * gnv[3] * bf_hi(gw.y));
        *(u32x2*)(rp + cout) = o; }
}

constexpr int GB_CW = 118784;
struct GdnBRegs { unsigned xq[11], xk[11], xv[11]; float Gl, betal; };
__device__ __forceinline__ void gdn_phaseB_load(GdnBRegs& R, const bf16_t* proj, const float* gbf, int item, int tid) {
    const int sg = __builtin_amdgcn_readfirstlane(tid >> 6), lane = tid & 63, col = 2 * lane;
    const int h = item & 3, bc = item >> 2, b = bc / 129, ch = bc % 129, r0 = b * LP + ch * 64;
    R.Gl = gbf[(size_t)(r0 + lane) * 8 + 4 + h]; R.betal = gbf[(size_t)(r0 + lane) * 8 + h];
#pragma unroll
    for (int i = 0; i < 11; ++i) { const int pp = ch * 64 + 8 * sg - 3 + i;
        if (pp >= 48) { const bf16_t* rp = proj + (size_t)(b * LP + pp) * NPROJ + h * 128 + col; R.xq[i] = *(const unsigned*)(rp + C_GQ); R.xk[i] = *(const unsigned*)(rp + C_GK); R.xv[i] = *(const unsigned*)(rp + C_GV); }
        else { R.xq[i] = 0u; R.xk[i] = 0u; R.xv[i] = 0u; } }
}

__device__ __forceinline__ int gdn_phaseB(LAS unsigned char* lds, const bf16_t* proj, const float* gbf, const GdnBufs& G, int item, GdnBRegs& R, unsigned* q2, unsigned& tk) {
    int tid_ = threadIdx.x; asm volatile("" : "+v"(tid_));
    const int tid = tid_, w = __builtin_amdgcn_readfirstlane(tid >> 6), lane = tid & 63, c = lane & 15, q = lane >> 4;
    const int h = item & 3, bc = item >> 2, b = bc / 129, ch = bc % 129;
    const int r0 = b * LP + ch * 64;
    const int col = 2 * lane, sg = w;
    LAS float* Lm = (LAS float*)(lds + GB_LM);
    LAS int* qit = (LAS int*)(lds + LDS_BYTES - 64);
    __syncthreads();
    LAS unsigned long long* tsq = (LAS unsigned long long*)(lds + LDS_BYTES - 256);
    unsigned long long tq0 = 0; if (PROBE_PH >= 0 && blockIdx.x == 0 && tid == 0) tq0 = __builtin_amdgcn_s_memrealtime();
    float Gl = R.Gl; const float betal = R.betal;
#pragma unroll
    for (int off = 1; off < 64; off <<= 1) { const float v = __shfl_up(Gl, off); if (lane >= off) Gl += v; }
    const float Gend = __builtin_bit_cast(float, __builtin_amdgcn_readlane(__builtin_bit_cast(int, Gl), 63));
    float cq[4][2], ck[4][2], cv[4][2];
#pragma unroll
    for (int j = 0; j < 4; ++j) { const LAS float* p = (const LAS float*)(lds + GB_CW) + j * 1536 + h * 128 + col; const f32x2_t a = *(const LAS f32x2_t*)p, bq = *(const LAS f32x2_t*)(p + 512), cc = *(const LAS f32x2_t*)(p + 1024);
        cq[j][0] = a[0]; cq[j][1] = a[1]; ck[j][0] = bq[0]; ck[j][1] = bq[1]; cv[j][0] = cc[0]; cv[j][1] = cc[1]; }
    unsigned xq[11], xk[11], xv[11];
#pragma unroll
    for (int i = 0; i < 11; ++i) { xq[i] = R.xq[i]; xk[i] = R.xk[i]; xv[i] = R.xv[i]; }
    unsigned rtk0[4], rtk1[4], rtv0[4], rtv1[4], kh0[4], kh1[4];
    float pk0 = 0.f, pk1 = 0.f, pv0 = 0.f, pv1 = 0.f, ph0 = 0.f, ph1 = 0.f;
    bf16_t* qt = G.QT + (size_t)item * 8192;
#pragma unroll
    for (int j = 0; j < 8; ++j) {
        const int t = 8 * sg + j;
        float q0 = 0.f, q1 = 0.f, k0 = 0.f, k1 = 0.f, v0 = 0.f, v1 = 0.f;
#pragma unroll
        for (int jj = 0; jj < 4; ++jj) { q0 += cq[jj][0] * bf_lo(xq[j + jj]); q1 += cq[jj][1] * bf_hi(xq[j + jj]); k0 += ck[jj][0] * bf_lo(xk[j + jj]); k1 += ck[jj][1] * bf_hi(xk[j + jj]); v0 += cv[jj][0] * bf_lo(xv[j + jj]); v1 += cv[jj][1] * bf_hi(xv[j + jj]); }
        q0 = siluf_(q0); q1 = siluf_(q1); k0 = siluf_(k0); k1 = siluf_(k1); v0 = siluf_(v0); v1 = siluf_(v1);
        const float sq = rsqrtf(wave_sum(q0 * q0 + q1 * q1) + EPS) * 0.08838834764831845f, sk = rsqrtf(wave_sum(k0 * k0 + k1 * k1) + EPS);
        q0 *= sq; q1 *= sq; k0 *= sk; k1 *= sk;
        const float Gt = __builtin_bit_cast(float, __builtin_amdgcn_readlane(__builtin_bit_cast(int, Gl), t)), bt = __builtin_bit_cast(float, __builtin_amdgcn_readlane(__builtin_bit_cast(int, betal), t));
        const float eg = __expf(Gt), eh = __expf(Gend - Gt);
        *(LAS unsigned*)(lds + GB_KN + t * RS_K + col * 2) = cvt_pk_bf16(k0, k1);
        *(LAS unsigned*)(lds + GB_QN + t * RS_K + col * 2) = cvt_pk_bf16(q0, q1);
        *(unsigned*)(qt + t * 128 + kperm(col)) = cvt_pk_bf16(q0 * eg, q1 * eg);
        const float rk0 = bt * eg * k0, rk1 = bt * eg * k1, rv0 = bt * v0, rv1 = bt * v1, h0 = k0 * eh, h1 = k1 * eh;
        if (j & 1) { rtk0[j >> 1] = cvt_pk_bf16(pk0, rk0); rtk1[j >> 1] = cvt_pk_bf16(pk1, rk1); rtv0[j >> 1] = cvt_pk_bf16(pv0, rv0); rtv1[j >> 1] = cvt_pk_bf16(pv1, rv1); kh0[j >> 1] = cvt_pk_bf16(ph0, h0); kh1[j >> 1] = cvt_pk_bf16(ph1, h1); }
        else { pk0 = rk0; pk1 = rk1; pv0 = rv0; pv1 = rv1; ph0 = h0; ph1 = h1; }
    }
    *(LAS u32x4*)(lds + GB_RTK + col * RS_T + 16 * sg) = (u32x4){rtk0[0], rtk0[1], rtk0[2], rtk0[3]};
    *(LAS u32x4*)(lds + GB_RTK + (col + 1) * RS_T + 16 * sg) = (u32x4){rtk1[0], rtk1[1], rtk1[2], rtk1[3]};
    *(LAS u32x4*)(lds + GB_RTV + col * RS_T + 16 * sg) = (u32x4){rtv0[0], rtv0[1], rtv0[2], rtv0[3]};
    *(LAS u32x4*)(lds + GB_RTV + (col + 1) * RS_T + 16 * sg) = (u32x4){rtv1[0], rtv1[1], rtv1[2], rtv1[3]};
    {
      const int pbase = 32 * (sg >> 2) + 16 * (sg & 1) + 4 * ((sg & 3) >> 1);
      bf16_t* kp = G.KHT + (size_t)item * 8192;
      *(u32x2*)(kp + col * 64 + pbase) = (u32x2){kh0[0], kh0[1]}; *(u32x2*)(kp + col * 64 + pbase + 8) = (u32x2){kh0[2], kh0[3]};
      *(u32x2*)(kp + (col + 1) * 64 + pbase) = (u32x2){kh1[0], kh1[1]}; *(u32x2*)(kp + (col + 1) * 64 + pbase + 8) = (u32x2){kh1[2], kh1[3]}; }
    if (tid == 0) { G.GEND[item] = Gend; qit[1] = (int)tk; }
    __syncthreads();
    const int nxt = qit[1];
    if (tid == 0) tk = atomicAdd(q2, 1u);
    if (nxt < GD_NITEM) gdn_phaseB_load(R, proj, gbf, nxt, tid);
    if (PROBE_PH >= 0 && blockIdx.x == 0 && tid == 0) { const unsigned long long t_ = __builtin_amdgcn_s_memrealtime(); tsq[14] += t_ - tq0; tq0 = t_; }
#pragma unroll
    for (int rep = 0; rep < 2; ++rep) { const int id = w + 8 * rep;
        if (id < 10) { int st, tt; if (id < 4) { st = 0; tt = id; } else if (id < 7) { st = 1; tt = id - 3; } else if (id < 9) { st = 2; tt = id - 5; } else { st = 3; tt = 3; }
            f32x4 acc = (f32x4){0.f, 0.f, 0.f, 0.f};
#pragma unroll
            for (int ks = 0; ks < 4; ++ks) { const bf16x8 a = *(const LAS bf16x8*)(lds + GB_KN + (16 * st + c) * RS_K + (32 * ks + 8 * q) * 2); const bf16x8 bq = *(const LAS bf16x8*)(lds + GB_KN + (16 * tt + c) * RS_K + (32 * ks + 8 * q) * 2); acc = mfma16(a, bq, acc); }
            const int tq = 16 * tt + c, s0 = 16 * st + 4 * q;
            const float Gt = __shfl(Gl, tq), bt = __shfl(betal, tq);
            f32x4 o;
#pragma unroll
            for (int i = 0; i < 4; ++i) { const float Gs = __shfl(Gl, s0 + i); o[i] = bt * __expf(fminf(Gt - Gs, 0.f)) * acc[i]; }
            *(LAS f32x4*)(Lm + tq * LST + s0) = o; } }
    __syncthreads();
    if (PROBE_PH >= 0 && blockIdx.x == 0 && tid == 0) tq0 = __builtin_amdgcn_s_memrealtime();
    LAS float* Tf = (LAS float*)(lds + GB_TF); LAS float* Xs = (LAS float*)(lds + GB_XS);
    if (w == 0) {
        const int bb = lane >> 4, cl = lane & 15;
        f32x4 lr[16][4];
#pragma unroll
        for (int i = 1; i < 16; ++i)
#pragma unroll
            for (int j = 0; j < i; j += 4) lr[i][j >> 2] = *(const LAS f32x4*)(Lm + (16 * bb + i) * LST + 16 * bb + j);
        float Dc[16];
#pragma unroll
        for (int i = 0; i < 16; ++i) { float acc = (i == cl) ? 1.0f : 0.0f;
#pragma unroll
            for (int j = 0; j < i; ++j) acc -= lr[i][j >> 2][j & 3] * Dc[j];
            Dc[i] = acc; }
#pragma unroll
        for (int i = 0; i < 16; ++i) Tf[(16 * bb + i) * LST + 16 * bb + cl] = Dc[i];
    } else {
        bf16_t* at = G.AT + (size_t)item * 4096;
        for (int id = w - 1; id < 16; id += 7) { const int st = id >> 2, tt = id & 3;
            f32x4 acc = (f32x4){0.f, 0.f, 0.f, 0.f};
            if (st <= tt) {
#pragma unroll
                for (int ks = 0; ks < 4; ++ks) { const bf16x8 a = *(const LAS bf16x8*)(lds + GB_KN + (16 * st + c) * RS_K + (32 * ks + 8 * q) * 2); const bf16x8 bq = *(const LAS bf16x8*)(lds + GB_QN + (16 * tt + c) * RS_K + (32 * ks + 8 * q) * 2); acc = mfma16(a, bq, acc); } }
            const int tq = 16 * tt + c, s0 = 16 * st + 4 * q;
            const float Gt = __shfl(Gl, tq);
            float o[4];
#pragma unroll
            for (int i = 0; i < 4; ++i) { const float Gs = __shfl(Gl, s0 + i); o[i] = (s0 + i <= tq) ? __expf(fminf(Gt - Gs, 0.f)) * acc[i] : 0.f; }
            *(u32x2*)(at + tq * 64 + 32 * (st >> 1) + 8 * q + 4 * (st & 1)) = (u32x2){cvt_pk_bf16(o[0], o[1]), cvt_pk_bf16(o[2], o[3])}; }
    }
    __syncthreads();
#pragma unroll
    for (int d = 1; d < 4; ++d) {
        if (w < 4 - d) { const int I = w + d, J = w;
            f32x4 X = (f32x4){0.f, 0.f, 0.f, 0.f};
            for (int M = J; M < I; ++M) {
#pragma unroll
                for (int m = 0; m < 4; ++m) X = __builtin_amdgcn_mfma_f32_16x16x4f32(Lm[(16 * I + c) * LST + 16 * M + 4 * m + q], Tf[(16 * M + 4 * m + q) * LST + 16 * J + c], X, 0, 0, 0); }
#pragma unroll
            for (int i = 0; i < 4; ++i) Xs[w * 256 + (4 * q + i) * 16 + c] = X[i];
            f32x4 Tb = (f32x4){0.f, 0.f, 0.f, 0.f};
#pragma unroll
            for (int m = 0; m < 4; ++m) Tb = __builtin_amdgcn_mfma_f32_16x16x4f32(Tf[(16 * I + c) * LST + 16 * I + 4 * m + q], Xs[w * 256 + (4 * m + q) * 16 + c], Tb, 0, 0, 0);
#pragma unroll
            for (int i = 0; i < 4; ++i) Tf[(16 * I + 4 * q + i) * LST + 16 * J + c] = -Tb[i]; }
        __syncthreads();
    }
    {
      const int row = tid >> 3, c8 = (tid & 7) * 8;
      f32x4 t0 = *(const LAS f32x4*)(Tf + row * LST + c8), t1 = *(const LAS f32x4*)(Tf + row * LST + c8 + 4);
      if ((c8 >> 4) > (row >> 4)) { t0 = (f32x4){0.f, 0.f, 0.f, 0.f}; t1 = t0; }
      *(LAS u32x4*)(lds + GB_TM + row * RS_T + c8 * 2) = (u32x4){cvt_pk_bf16(t0[0], t0[1]), cvt_pk_bf16(t0[2], t0[3]), cvt_pk_bf16(t1[0], t1[1]), cvt_pk_bf16(t1[2], t1[3])}; }
    __syncthreads();
    if (PROBE_PH >= 0 && blockIdx.x == 0 && tid == 0) tsq[15] += __builtin_amdgcn_s_memrealtime() - tq0;
    { bf16_t* wp = G.WP + (size_t)item * 8192; bf16_t* u0 = G.U0T + (size_t)item * 8192;
#pragma unroll
      for (int tt = 0; tt < 4; ++tt) {
          f32x4 aw = (f32x4){0.f, 0.f, 0.f, 0.f}, au = (f32x4){0.f, 0.f, 0.f, 0.f};
#pragma unroll
          for (int ss = 0; ss < 2; ++ss) { if (ss == 1 && tt < 2) continue;
              const bf16x8 tb = *(const LAS bf16x8*)(lds + GB_TM + (16 * tt + c) * RS_T + (32 * ss + 8 * q) * 2);
              const bf16x8 ak = *(const LAS bf16x8*)(lds + GB_RTK + (16 * w + c) * RS_T + (32 * ss + 8 * q) * 2);
              const bf16x8 bv = *(const LAS bf16x8*)(lds + GB_RTV + (16 * w + c) * RS_T + (32 * ss + 8 * q) * 2);
              aw = mfma16(ak, tb, aw);
              au = mfma16(tb, bv, au); }
          *(u32x2*)(wp + (16 * tt + c) * 128 + 32 * (w >> 1) + 8 * q + 4 * (w & 1)) = (u32x2){cvt_pk_bf16(aw[0], aw[1]), cvt_pk_bf16(aw[2], aw[3])};
          *(u32x2*)(u0 + (16 * w + c) * 64 + 32 * (tt >> 1) + 8 * q + 4 * (tt & 1)) = (u32x2){cvt_pk_bf16(au[0], au[1]), cvt_pk_bf16(au[2], au[3])}; } }
    return nxt;
}

__device__ __forceinline__ bf16_t* snt_ptr(bf16_t* proj, int r0, int h, int v) { return proj + (size_t)(r0 + (v & 63)) * NPROJ + (v < 64 ? C_GQ : C_GK) + h * 128; }

__device__ __forceinline__ void gdn_scan(LAS unsigned char* lds, bf16_t* proj, const GdnBufs& G, int unit) {
    const int tid = threadIdx.x, w = __builtin_amdgcn_readfirstlane(tid >> 6), lane = tid & 63, c = lane & 15, q = lane >> 4;
    const int bh = unit >> 3, slice = unit & 7, b = bh >> 2, h = bh & 3;
    constexpr int SLOT = 32768, OW = 0, OK_ = 16384, OU = 3 * SLOT, OATAB = OU + 6 * 2048, OFLAG = OATAB + 1024;
    const int item0 = (b * 129) * 4 + h;
    LAS float* atab = (LAS float*)(lds + OATAB);
    volatile LAS unsigned* rdy = (volatile LAS unsigned*)(lds + OFLAG);
    volatile LAS unsigned* prog = (volatile LAS unsigned*)(lds + OFLAG + 64);
    __syncthreads();
    if (tid < 129) atab[tid] = __expf(G.GEND[item0 + 4 * tid]);
    if (tid < 16) rdy[tid] = 0u; if (tid >= 16 && tid < 20) prog[tid - 16] = 0u;
    asm volatile("s_waitcnt vmcnt(0) lgkmcnt(0)" ::: "memory");
    __syncthreads();
    if (w >= 4) {
        const int j = w - 4;
        u32x4 R[32];
#define GS_LD(m_) do { const int it_ = item0 + 4 * (m_); const char* wp_ = (const char*)(G.WP + (size_t)it_ * 8192); const char* kp_ = (const char*)(G.KHT + (size_t)it_ * 8192); const char* up_ = (const char*)(G.U0T + (size_t)it_ * 8192) + slice * 2048; \
        _Pragma("unroll") for (int i = 0; i < 16; ++i) { const int rw = 4 * i + (lane >> 4); R[i] = *(const u32x4*)(wp_ + rw * 256 + (((lane & 15) ^ (rw & 15)) << 4)); \
            const int rk = 8 * i + (lane >> 3); R[16 + i] = *(const u32x4*)(kp_ + rk * 128 + (((lane & 7) ^ (rk & 7)) << 4)); } \
        LAS unsigned char* ud_ = lds + OU + ((m_) % 6) * 2048; \
        _Pragma("unroll") for (int i = 0; i < 2; ++i) __builtin_amdgcn_global_load_lds((const unsigned*)(up_ + (lane + 64 * i) * 16), (LAS unsigned*)(ud_ + i * 1024), 16, 0, 0); } while (0)
#define GS_ST(slot_) do { LAS unsigned char* d_ = lds + (slot_) * SLOT + lane * 16; \
        _Pragma("unroll") for (int i = 0; i < 16; ++i) { *(LAS u32x4*)(d_ + OW + i * 1024) = R[i]; *(LAS u32x4*)(d_ + OK_ + i * 1024) = R[16 + i]; } } while (0)
#define GS_WAIT_PROG(need_) do { const unsigned nd_ = (unsigned)(need_); while (prog[0] < nd_) __builtin_amdgcn_s_sleep(1); asm volatile("" ::: "memory"); } while (0)
        GS_LD(j);
        for (int m = j; m <= 128; m += 4) {
            if (m >= 3) GS_WAIT_PROG(m - 2);
            asm volatile("s_waitcnt vmcnt(0)" ::: "memory");
            GS_ST(m % 3);
            asm volatile("s_waitcnt lgkmcnt(0)" ::: "memory");
            if (lane == 0) rdy[m & 7] = (unsigned)(m + 1);
            if (m + 4 <= 128) { if (m >= 2) GS_WAIT_PROG(m - 1);
                GS_LD(m + 4); }
        }
        asm volatile("s_waitcnt vmcnt(0) lgkmcnt(0)" ::: "memory");
#undef GS_LD
#undef GS_ST
#undef GS_WAIT_PROG
    } else if (w == 0) {
        const int vl = c, v = 16 * slice + vl;
        f32x4 Sacc[8];
#pragma unroll
        for (int kt = 0; kt < 8; ++kt) Sacc[kt] = (f32x4){0.f, 0.f, 0.f, 0.f};
        int slot = 0;
        for (int n = 0; n < 129; ++n) {
            const int item = item0 + 4 * n, r0 = b * LP + n * 64;
            while (rdy[n & 7] != (unsigned)(n + 1)) __builtin_amdgcn_s_sleep(1);
            asm volatile("" ::: "memory");
            LAS unsigned char* cur = lds + slot * SLOT;
            const float a = atab[n];
            bf16_t* sp = snt_ptr(proj, r0, h, v) + 8 * q;
            f32x4 u[4];
#pragma unroll
            for (int tt = 0; tt < 4; ++tt) u[tt] = (f32x4){0.f, 0.f, 0.f, 0.f};
#pragma unroll
            for (int ks = 0; ks < 4; ++ks) { const bf16x8 sb = pack8(Sacc[2 * ks], Sacc[2 * ks + 1]);
                *(bf16x8*)(sp + 32 * ks) = sb;
#pragma unroll
                for (int tt = 0; tt < 4; ++tt) { const bf16x8 aw = *(const LAS bf16x8*)(cur + OW + (16 * tt + c) * 256 + (((4 * ks + q) ^ c) << 4)); u[tt] = mfma16(aw, sb, u[tt]); } }
            bf16_t* up = G.U0T + (size_t)item * 8192 + v * 64 + 8 * q;
#pragma unroll
            for (int kt = 0; kt < 8; ++kt) Sacc[kt] = Sacc[kt] * a;
#pragma unroll
            for (int ts = 0; ts < 2; ++ts) { const u32x4 u0w = *(const LAS u32x4*)(lds + OU + (n % 6) * 2048 + vl * 128 + (32 * ts + 8 * q) * 2);
                f32x4 ua, ub_;
                ua[0] = bf_lo(u0w.x) - u[2 * ts][0]; ua[1] = bf_hi(u0w.x) - u[2 * ts][1]; ua[2] = bf_lo(u0w.y) - u[2 * ts][2]; ua[3] = bf_hi(u0w.y) - u[2 * ts][3];
                ub_[0] = bf_lo(u0w.z) - u[2 * ts + 1][0]; ub_[1] = bf_hi(u0w.z) - u[2 * ts + 1][1]; ub_[2] = bf_lo(u0w.w) - u[2 * ts + 1][2]; ub_[3] = bf_hi(u0w.w) - u[2 * ts + 1][3];
                const bf16x8 ub = pack8(ua, ub_);
                *(bf16x8*)(up + 32 * ts) = ub;
#pragma unroll
                for (int kt = 0; kt < 8; ++kt) { const bf16x8 ak = *(const LAS bf16x8*)(cur + OK_ + (16 * kt + c) * 128 + (((4 * ts + q) ^ (c & 7)) << 4)); Sacc[kt] = mfma16(ak, ub, Sacc[kt]); } }
            asm volatile("s_waitcnt lgkmcnt(0)" ::: "memory");
            if (lane == 0) prog[0] = (unsigned)(n + 1);
            slot = slot + 1; if (slot >= 3) slot -= 3;
            if (PROBE_PH >= 0 && blockIdx.x == 0 && tid == 0) { LAS unsigned long long* tsw_ = (LAS unsigned long long*)(lds + LDS_BYTES - 256); if (n == 63) tsw_[12] = __builtin_amdgcn_s_memrealtime(); if (n == 128) tsw_[13] = __builtin_amdgcn_s_memrealtime(); }
        }
    }
    __syncthreads();
}

struct GdnDRegs { u32x4 q0, q1, a0; bf16x8 as_[4], au_[2]; u32x2 gz[4]; };
__device__ __forceinline__ void gdn_phaseD_load(GdnDRegs& R, bf16_t* proj, const GdnBufs& G, int item, int tid) {
    const int w = tid >> 6, lane = tid & 63, c = lane & 15, q = lane >> 4;
    const int h = item & 3, bc = item >> 2, b = bc / 129, ch = bc % 129, r0 = b * LP + ch * 64, v = 16 * w + c;
    const u32x4* qp = (const u32x4*)(G.QT + (size_t)item * 8192); const u32x4* ap = (const u32x4*)(G.AT + (size_t)item * 4096);
    R.q0 = qp[tid]; R.q1 = qp[tid + 512]; R.a0 = ap[tid];
    const bf16_t* sp = snt_ptr(proj, r0, h, v) + 8 * q; const bf16_t* up = G.U0T + (size_t)item * 8192 + v * 64 + 8 * q;
#pragma unroll
    for (int ks = 0; ks < 4; ++ks) R.as_[ks] = *(const bf16x8*)(sp + 32 * ks);
#pragma unroll
    for (int ss = 0; ss < 2; ++ss) R.au_[ss] = *(const bf16x8*)(up + 32 * ss);
#pragma unroll
    for (int tt = 0; tt < 4; ++tt) R.gz[tt] = *(const u32x2*)(proj + (size_t)(r0 + 16 * tt + c) * NPROJ + h * 128 + 16 * w + 4 * q + C_GZ);
}
__device__ __forceinline__ int gdn_d_next(int it, int stride) { it += stride; while (it < GD_NITEM && (it >> 2) % 129 == 0) it += stride; return it; }
__device__ __forceinline__ void gdn_phaseD_all(LAS unsigned char* lds, bf16_t* proj, const GdnBufs& G, const float* gn, int first, int stride, bf16_t* ob) {
    int tid_ = threadIdx.x; asm volatile("" : "+v"(tid_));
    const int tid = tid_, w = tid >> 6, lane = tid & 63, c = lane & 15, q = lane >> 4;
    constexpr int OQ = 0, OA = 17408, OP = 26624;
    LAS float* part = (LAS float*)(lds + OP);
    int it = first - stride; it = gdn_d_next(it, stride);
    GdnDRegs R;
    if (it < GD_NITEM) gdn_phaseD_load(R, proj, G, it, tid);
    while (it < GD_NITEM) {
        const int item = it, h = item & 3, bc = item >> 2, b = bc / 129, ch = bc % 129, r0 = b * LP + ch * 64;
        __syncthreads();
        *(LAS u32x4*)(lds + OQ + (tid >> 4) * RS_K + (tid & 15) * 16) = R.q0; *(LAS u32x4*)(lds + OQ + ((tid + 512) >> 4) * RS_K + (tid & 15) * 16) = R.q1;
        *(LAS u32x4*)(lds + OA + (tid >> 3) * RS_T + (tid & 7) * 16) = R.a0;
        bf16x8 as_[4], au_[2]; u32x2 gz[4];
#pragma unroll
        for (int ks = 0; ks < 4; ++ks) as_[ks] = R.as_[ks];
#pragma unroll
        for (int ss = 0; ss < 2; ++ss) au_[ss] = R.au_[ss];
#pragma unroll
        for (int tt = 0; tt < 4; ++tt) gz[tt] = R.gz[tt];
        it = gdn_d_next(it, stride);
        if (it < GD_NITEM) gdn_phaseD_load(R, proj, G, it, tid);
        __syncthreads();
        f32x4 oacc[4];
#pragma unroll
        for (int tt = 0; tt < 4; ++tt) oacc[tt] = (f32x4){0.f, 0.f, 0.f, 0.f};
#pragma unroll
        for (int ks = 0; ks < 4; ++ks)
#pragma unroll
            for (int tt = 0; tt < 4; ++tt) { const bf16x8 bq = *(const LAS bf16x8*)(lds + OQ + (16 * tt + c) * RS_K + (32 * ks + 8 * q) * 2); oacc[tt] = mfma16(as_[ks], bq, oacc[tt]); }
#pragma unroll
        for (int ss = 0; ss < 2; ++ss)
#pragma unroll
            for (int tt = 0; tt < 4; ++tt) { const bf16x8 bq = *(const LAS bf16x8*)(lds + OA + (16 * tt + c) * RS_T + (32 * ss + 8 * q) * 2); oacc[tt] = mfma16(au_[ss], bq, oacc[tt]); }
#pragma unroll
        for (int tt = 0; tt < 4; ++tt) { float p = oacc[tt][0] * oacc[tt][0] + oacc[tt][1] * oacc[tt][1] + oacc[tt][2] * oacc[tt][2] + oacc[tt][3] * oacc[tt][3];
            p += __shfl_xor(p, 16); p += __shfl_xor(p, 32); if (q == 0) part[w * 64 + 16 * tt + c] = p; }
        __syncthreads();
        const f32x4 gnv = *(const f32x4*)(gn + 16 * w + 4 * q);
#pragma unroll
        for (int tt = 0; tt < 4; ++tt) { float tot = 0.f;
#pragma unroll
            for (int ww = 0; ww < 8; ++ww) tot += part[ww * 64 + 16 * tt + c];
            const float rstd = rsqrtf(tot * (1.0f / 128.0f) + EPS);
            const u32x2 gw = gz[tt];
            u32x2 o; o.x = cvt_pk_bf16(oacc[tt][0] * rstd * gnv[0] * bf_lo(gw.x), oacc[tt][1] * rstd * gnv[1] * bf_hi(gw.x));
            o.y = cvt_pk_bf16(oacc[tt][2] * rstd * gnv[2] * bf_lo(gw.y), oacc[tt][3] * rstd * gnv[3] * bf_hi(gw.y));
            *(u32x2*)(ob + (size_t)(b * SEQ + (ch - 1) * 64 + 16 * tt + c) * 512 + h * 128 + 16 * w + 4 * q) = o; }
    }
    __syncthreads();
}

constexpr int RW_ST = 1040, RW_OLG = 73 * RW_ST, RW_OCN = RW_OLG + 8 * 16 * 52 * 4;
__device__ __forceinline__ void p_router(LAS unsigned char* lds, const bf16_t* h1b, const float* g2, const float* rgw, const float* rgb, const float* rew, const float* reb, int* cnt, int* list, float* rs, int* asg) {
    LAS int* lcnt = (LAS int*)(lds + RW_OCN);
    LAS int* dec = lcnt + 64;
    const int tid = threadIdx.x, wv = tid >> 6, l = tid & 63, c = l & 15, q = l >> 4;
    const int rows_cap = (T + (int)gridDim.x - 1) / (int)gridDim.x;
    const int rbase = blockIdx.x * rows_cap; const int rend = (rbase + rows_cap <= T) ? rbase + rows_cap : T;
    LAS float* lg = (LAS float*)(lds + RW_OLG) + wv * 16 * 52;
    for (int p0 = rbase; p0 < rend; p0 += 128) {
        const int rows_per = (rend - p0) < 128 ? (rend - p0) : 128;
        __syncthreads();
        if (tid < 64) lcnt[tid] = 0;
        const bool valid = (wv * 16 + c) < rows_per;
        const int row = valid ? p0 + wv * 16 + c : p0;
        u32x4 xa[16][2];
#pragma unroll
        for (int j = 0; j < 16; ++j)
#pragma unroll
            for (int s_ = 0; s_ < 2; ++s_) xa[j][s_] = *(const u32x4*)(h1b + (size_t)row * D + 64 * j + 16 * q + 8 * s_);
        f32x4 acc[3], accS = (f32x4){0.f, 0.f, 0.f, 0.f};
#pragma unroll
        for (int ct = 0; ct < 3; ++ct) acc[ct] = (f32x4){0.f, 0.f, 0.f, 0.f};
        int rhi[3], rlo[3];
#pragma unroll
        for (int ct = 0; ct < 3; ++ct) { const int n = 16 * ct + c; rhi[ct] = (n < 36 ? n : 72) * RW_ST + 32 * q; rlo[ct] = (n < 36 ? 36 + n : 72) * RW_ST + 32 * q; }
#pragma unroll
        for (int half = 0; half < 2; ++half) {
            if (half) __syncthreads();
            const int k0 = 512 * half;
            for (int i = tid; i < 512; i += NTHR) { const int k = k0 + i; const f32x4 g = *(const f32x4*)(rgw + 4 * k); const float gg = g2[k];
#pragma unroll
                for (int n = 0; n < 4; ++n) { const float w = g[n] * gg; const bf16_t hi = f2bf(w); *(LAS bf16_t*)(lds + n * RW_ST + i * 2) = hi; *(LAS bf16_t*)(lds + (36 + n) * RW_ST + i * 2) = f2bf(w - bf2f(hi)); } }
            for (int i = tid; i < 512 * 8; i += NTHR) { const int kk = i >> 3, j = (i & 7) * 4; const f32x4 g = *(const f32x4*)(rew + (size_t)(k0 + kk) * 32 + j); const float gg = g2[k0 + kk];
#pragma unroll
                for (int n = 0; n < 4; ++n) { const float w = g[n] * gg; const bf16_t hi = f2bf(w); *(LAS bf16_t*)(lds + (4 + j + n) * RW_ST + kk * 2) = hi; *(LAS bf16_t*)(lds + (40 + j + n) * RW_ST + kk * 2) = f2bf(w - bf2f(hi)); } }
            if (tid < RW_ST / 16) *(LAS u32x4*)(lds + 72 * RW_ST + tid * 16) = (u32x4){0u, 0u, 0u, 0u};
            __syncthreads();
#pragma unroll
            for (int jj = 0; jj < 8; ++jj)
#pragma unroll
                for (int s_ = 0; s_ < 2; ++s_) { const bf16x8 a = __builtin_bit_cast(bf16x8, xa[8 * half + jj][s_]);
                    accS = mfma16(a, a, accS);
#pragma unroll
                    for (int ct = 0; ct < 3; ++ct) { const bf16x8 bh = *(const LAS bf16x8*)(lds + rhi[ct] + 128 * jj + 16 * s_); const bf16x8 bl = *(const LAS bf16x8*)(lds + rlo[ct] + 128 * jj + 16 * s_);
                        acc[ct] = mfma16(a, bh, acc[ct]); acc[ct] = mfma16(a, bl, acc[ct]); } }
        }
        const float sd = (c & 3) == 0 ? accS[0] : (c & 3) == 1 ? accS[1] : (c & 3) == 2 ? accS[2] : accS[3];
        const float ssq = __shfl(sd, c + 16 * (c >> 2));
        const float rstd = rsqrtf(ssq * (1.0f / D) + EPS);
#pragma unroll
        for (int ct = 0; ct < 3; ++ct)
#pragma unroll
            for (int i = 0; i < 4; ++i) lg[(4 * q + i) * 52 + 16 * ct + c] = acc[ct][i];
        asm volatile("s_waitcnt lgkmcnt(0)" ::: "memory");
        if (q == 0 && valid) {
            const LAS float* lr_ = lg + c * 52;
            float gl[4];
#pragma unroll
            for (int i = 0; i < 4; ++i) gl[i] = lr_[i] * rstd + rgb[i];
            int grp = 0; float gm = gl[0];
#pragma unroll
            for (int i = 1; i < 4; ++i) if (gl[i] > gm) { gm = gl[i]; grp = i; }
            float gs = 0.f;
#pragma unroll
            for (int i = 0; i < 4; ++i) gs += __expf(gl[i] - gm);
            const float pg = 1.0f / gs;
            float el[8];
#pragma unroll
            for (int j = 0; j < 8; ++j) el[j] = lr_[4 + grp * 8 + j] * rstd + reb[grp * 8 + j];
            int i1 = 0; float m1 = el[0];
#pragma unroll
            for (int j = 1; j < 8; ++j) if (el[j] > m1) { m1 = el[j]; i1 = j; }
            int i2 = (i1 == 0) ? 1 : 0; float m2 = -3.0e38f;
#pragma unroll
            for (int j = 0; j < 8; ++j) if (j != i1 && el[j] > m2) { m2 = el[j]; i2 = j; }
            const float p2 = __expf(m2 - m1);
            const float w1 = pg / (1.0f + p2), w2 = pg * p2 / (1.0f + p2);
            const int e1 = grp * 8 + i1, e2 = grp * 8 + i2;
            LAS int* dd = dec + (wv * 16 + c) * 8;
            dd[0] = e1; dd[1] = e2; dd[2] = atomicAdd((int*)(lcnt + e1), 1); dd[3] = atomicAdd((int*)(lcnt + e2), 1); dd[4] = __float_as_int(w1); dd[5] = __float_as_int(w2); dd[6] = __float_as_int(rstd);
        }
        __syncthreads();
        if (tid < NEXP) lcnt[32 + tid] = atomicAdd(&cnt[tid], lcnt[tid]);
        __syncthreads();
        for (int lr = tid; lr < rows_per; lr += NTHR) {
            const int row_ = p0 + lr; LAS int* dd = dec + lr * 8;
            const int e1 = dd[0], e2 = dd[1], pos1 = lcnt[32 + e1] + dd[2], pos2 = lcnt[32 + e2] + dd[3];
            list[e1 * ECAP + pos1] = row_; list[e2 * ECAP + pos2] = row_;
            rs[e1 * ECAP + pos1] = __int_as_float(dd[6]); rs[e2 * ECAP + pos2] = __int_as_float(dd[6]);
            int* a = asg + (size_t)row_ * 6;
            a[0] = e1; a[1] = pos1; a[2] = dd[4]; a[3] = e2; a[4] = pos2; a[5] = dd[5];
        }
    }
    __syncthreads();
}
__device__ __forceinline__ void p_final(LAS unsigned char* lds, const bf16_t* h1b, float* out, const bf16_t* Y, const int* cnt, const int* asg, const float* gf) {
    LAS int* offr = (LAS int*)lds;
    __syncthreads();
    if (threadIdx.x == 0) { int s = 0; for (int e = 0; e < NEXP; ++e) { offr[e] = s * 256; s += (cnt[e] + 255) >> 8; } }
    __syncthreads();
    const int wv = threadIdx.x >> 6, l = threadIdx.x & 63;
    constexpr int NR = 4;
    const int rstep = (int)gridDim.x * 8;
    f32x4 gv[4];
#pragma unroll
    for (int i = 0; i < 4; ++i) gv[i] = ((const f32x4*)gf)[l + 64 * i];
    for (int row0 = blockIdx.x * 8 + wv; row0 < T; row0 += rstep * NR) {
        u32x2 ag[NR][3];
#pragma unroll
        for (int r = 0; r < NR; ++r) { const int row = (row0 + r * rstep < T) ? row0 + r * rstep : row0; const u32x2* a2 = (const u32x2*)(asg + (size_t)row * 6); ag[r][0] = a2[0]; ag[r][1] = a2[1]; ag[r][2] = a2[2]; }
        u32x2 hw[NR][4], y1[NR][4], y2[NR][4];
#pragma unroll
        for (int r = 0; r < NR; ++r) { const int row = (row0 + r * rstep < T) ? row0 + r * rstep : row0;
#pragma unroll
            for (int i = 0; i < 4; ++i) hw[r][i] = *(const u32x2*)(h1b + (size_t)row * D + 4 * (l + 64 * i)); }
#pragma unroll
        for (int r = 0; r < NR; ++r) { const int s1 = offr[ag[r][0].x] + (int)ag[r][0].y, s2 = offr[ag[r][1].y] + (int)ag[r][2].x;
#pragma unroll
            for (int i = 0; i < 4; ++i) { y1[r][i] = *(const u32x2*)(Y + (size_t)s1 * D + 4 * (l + 64 * i)); y2[r][i] = *(const u32x2*)(Y + (size_t)s2 * D + 4 * (l + 64 * i)); } }
#pragma unroll
        for (int r = 0; r < NR; ++r) { const int row = row0 + r * rstep; if (row >= T) break;
            const float w1 = __uint_as_float(ag[r][1].x), w2 = __uint_as_float(ag[r][2].y);
            f32x4 v[4]; float ss = 0.f;
#pragma unroll
            for (int i = 0; i < 4; ++i) {
                v[i][0] = bf_lo(hw[r][i].x) + w1 * bf_lo(y1[r][i].x) + w2 * bf_lo(y2[r][i].x); v[i][1] = bf_hi(hw[r][i].x) + w1 * bf_hi(y1[r][i].x) + w2 * bf_hi(y2[r][i].x);
                v[i][2] = bf_lo(hw[r][i].y) + w1 * bf_lo(y1[r][i].y) + w2 * bf_lo(y2[r][i].y); v[i][3] = bf_hi(hw[r][i].y) + w1 * bf_hi(y1[r][i].y) + w2 * bf_hi(y2[r][i].y);
                ss += v[i][0] * v[i][0] + v[i][1] * v[i][1] + v[i][2] * v[i][2] + v[i][3] * v[i][3]; }
            ss = wave_sum(ss);
            const float rstd = rsqrtf(ss * (1.0f / D) + EPS);
            f32x4* xr = (f32x4*)(out + (size_t)row * D);
#pragma unroll
            for (int i = 0; i < 4; ++i) xr[l + 64 * i] = v[i] * rstd * gv[i]; }
    }
}

__device__ __forceinline__ void run_dense(LAS unsigned char* lds, const char* A, unsigned lda2, int K, const char* Bt, int M, int N, int rowmap, int mode, void* o0, const void* i0, const float* aux) {
    SchedDense S; S.so.init(M, N, (int)gridDim.x, (int)blockIdx.x); S.A = A; S.lda2 = lda2; S.K = K; S.Bt = Bt; S.rowmap = rowmap;
    if (mode == 0) { EpiProj E{(bf16_t*)o0, (const float*)i0, aux}; pg8::gemm_phase<EpiProj, SchedDense>(lds, S, E); }
    else { EpiResid E{(const float*)i0, (bf16_t*)o0}; pg8::gemm_phase<EpiResid, SchedDense>(lds, S, E); }
}
__device__ __forceinline__ void run_moe(LAS unsigned char* lds, const char* A, unsigned lda2, int K, const char* Bt, size_t bstride, const int* cnt, const int* list, int mode, void* out, const float* rs) {
    LAS int* pref = (LAS int*)(lds + pg8::STAGE_BYTES);
    __syncthreads();
    if (threadIdx.x == 0) { int s = 0, sf = 0, sh = 0; for (int e = 0; e < NEXP; ++e) { const int n = cnt[e], nt_ = (n + 255) >> 8, rem = n & 255, hh = (rem != 0 && rem <= 128) ? 1 : 0;
            pref[e] = s; pref[33 + e] = sf; pref[66 + e] = sh; s += nt_; sf += nt_ - hh; sh += hh; } pref[NEXP] = s; pref[33 + NEXP] = sf; pref[66 + NEXP] = sh; }
    __syncthreads();
    SchedMoe S; S.cnt = cnt; S.list = list; S.pref = pref; S.A = A; S.lda2 = lda2; S.K = K; S.Bt = Bt; S.bstride = bstride; S.gather = (mode == 0); S.G = (int)gridDim.x; S.c = ((gridDim.x & 7) == 0) ? (int)((blockIdx.x & 7) * (gridDim.x >> 3) + (blockIdx.x >> 3)) : (int)blockIdx.x;
    if (mode == 0) { EpiSwiglu E{(bf16_t*)out, rs}; pg8::gemm_phase<EpiSwiglu, SchedMoe>(lds, S, E); }
    else { EpiY E{(bf16_t*)out}; pg8::gemm_phase<EpiY, SchedMoe>(lds, S, E); }
}

__global__ void __launch_bounds__(NTHR, 2) mega(Args a) {
    extern __shared__ __attribute__((aligned(16))) unsigned char shm[];
    LAS unsigned char* lds = (LAS unsigned char*)shm;
    cg::grid_group grid = cg::this_grid();
    const float* x = a.in[0]; const float* meta = a.in[1]; const float* lbl = a.in[2]; const float* g1 = a.in[3];
    const float* w_in = a.in[4]; const float* convw = a.in[5]; const float* A_log = a.in[6]; const float* dt_bias = a.in[7];
    const float* hg_ng = a.in[8]; const float* gd_ng = a.in[9]; const float* hg_up = a.in[10]; const float* gd_up = a.in[11];
    const float* w_out = a.in[12]; const float* g2 = a.in[13]; const float* rgw = a.in[14]; const float* rgb = a.in[15];
    const float* rew = a.in[16]; const float* reb = a.in[17]; const float* w_gate = a.in[18]; const float* w_up = a.in[19];
    const float* w_down = a.in[20]; const float* gf = a.in[21];
    char* ws = a.ws; float* out = a.out;
    bf16_t* proj = (bf16_t*)(ws + OFF_PROJ); bf16_t* Win = (bf16_t*)(ws + OFF_WIN); bf16_t* Whg = (bf16_t*)(ws + OFF_WHG); bf16_t* Wgd = (bf16_t*)(ws + OFF_WGD); bf16_t* Wout = (bf16_t*)(ws + OFF_WOUT);
    float* gbf = (float*)(ws + OFF_GBF); float* lbt = (float*)(ws + OFF_MISC + MISC_LBT); int* cnt = (int*)(ws + OFF_MISC + MISC_CNT);
    bf16_t* tmp = (bf16_t*)(ws + OFF_TMP);
    bf16_t* xb = (bf16_t*)(ws + OFF_QKVN); float* rsx = (float*)(ws + OFF_RSX); float* mpb = (float*)(ws + OFF_MP);
    bf16_t* h1b = (bf16_t*)(ws + OFF_XN); float* rsl = (float*)(ws + OFF_RS); bf16_t* We1 = (bf16_t*)(ws + OFF_WE1); bf16_t* We2 = (bf16_t*)(ws + OFF_WE2); bf16_t* Hb = (bf16_t*)(ws + OFF_H); bf16_t* Yb = (bf16_t*)(ws + OFF_Y);
    int* list = (int*)(ws + OFF_LIST); int* asg = (int*)(ws + OFF_ASG);
    bf16_t* oab = (bf16_t*)((char*)a.out + DO_OA); bf16_t* obb = (bf16_t*)((char*)a.out + DO_OB); bf16_t* mgb = (bf16_t*)(ws + OFF_MG);
    float* arun = (float*)((char*)a.out + DO_ARUN); float* drun = arun + (size_t)256 * 16384;
    GdnBufs GB; GB.QT = (bf16_t*)(ws + OFF_QT); GB.AT = (bf16_t*)(ws + OFF_AT); GB.KHT = (bf16_t*)(ws + OFF_KHT); GB.GEND = (float*)(ws + OFF_GEND); GB.WP = (bf16_t*)((char*)a.out + DO_WP); GB.U0T = (bf16_t*)((char*)a.out + DO_U0T);
    const int lo = a.ph_lo, hi = a.ph_hi;
#define IN(k) (lo <= (k) && (k) < hi)
    LAS unsigned long long* tsw = (LAS unsigned long long*)(lds + LDS_BYTES - 256);
#define STAMP(k) do { if (PROBE_PH >= 0 && blockIdx.x == PROBE_BLK && threadIdx.x == 0) tsw[k] = __builtin_amdgcn_s_memrealtime(); } while (0)
    volatile LAS unsigned* xbst = (volatile LAS unsigned*)(lds + LDS_BYTES - 128);
    if (threadIdx.x == 0) { xbst[0] = 0u; xbst[1] = 0u; }
    __syncthreads();
    const XcdBarrier xbar = xcd_barrier_post((unsigned*)(ws + OFF_BAR), xbst);
#define SEAM(k) do { if (IN(k) && IN((k) + 1)) { if ((k) == 0) grid.sync(); else xcd_barrier(xbar); } STAMP((k) + 1); } while (0)
    if (PROBE_PH >= 0 && threadIdx.x == 0) { tsw[14] = 0; tsw[15] = 0; }
    STAMP(0);
    if (IN(0)) {
        if (blockIdx.x == 0) {
            const int i = threadIdx.x;
            { const float aa = lbl[i], bb = lbl[512 + i]; const float m = fmaxf(aa, bb); const float ea = __expf(aa - m), eb = __expf(bb - m); lbt[i] = ea / (ea + eb); }
            if (i < NEXP) cnt[i] = 0;
        }
        {
          const TrJob jw{w_in, nullptr, Win, 0, 1024, WIN_LD, NPROJ, 1, 0, 0, g1}, jh{hg_up, nullptr, Whg, 1, 512, 1024, 1024, 1, 0, 0, nullptr}, jg{gd_up, nullptr, Wgd, 1, 512, 1024, 1024, 1, 0, 0, nullptr}, jo{w_out, nullptr, Wout, 1, 1024, 1024, 1024, 1, 0, 0, nullptr};
          const int b_ = (int)blockIdx.x; const bool even = (gridDim.x == 256);
          int id0, id1, id2, id3;
          if (even) { if (b_ >= META_WG) { const int bb = b_ - META_WG, nw = 256 - META_WG; id0 = bb; id1 = bb + nw; id2 = bb + 2 * nw < 512 ? bb + 2 * nw : -1; id3 = bb + 3 * nw < 512 ? bb + 3 * nw : -1; } else { id0 = -1; id1 = -1; id2 = -1; id3 = -1; } }
          else { id0 = -1; id1 = -1; id2 = -1; id3 = -1; }
#define TR_LOAD_ID(v_, id_) do { if ((id_) >= 0) { if ((id_) < 384) tr_load(v_, jw, (id_)); else if ((id_) < 416) tr_load(v_, jh, (id_) - 384); else if ((id_) < 448) tr_load(v_, jg, (id_) - 416); else tr_load(v_, jo, (id_) - 448); } } while (0)
#define TR_STORE_ID(v_, id_) do { if ((id_) >= 0) { if ((id_) < 384) tr_store((LAS float*)lds, v_, jw, (id_)); else if ((id_) < 416) tr_store((LAS float*)lds, v_, jh, (id_) - 384); else if ((id_) < 448) tr_store((LAS float*)lds, v_, jg, (id_) - 416); else tr_store((LAS float*)lds, v_, jo, (id_) - 448); } } while (0)
          if (even && b_ < META_WG) p0_meta(lds, meta, g1, w_in, mpb);
          else if (even) {
              f32x4 t0[8], t1[8];
              TR_LOAD_ID(t0, id0); TR_LOAD_ID(t1, id1); TR_STORE_ID(t0, id0); TR_LOAD_ID(t0, id2); TR_STORE_ID(t1, id1); TR_LOAD_ID(t1, id3); TR_STORE_ID(t0, id2); TR_STORE_ID(t1, id3);
              __syncthreads(); }
          else p0_meta(lds, meta, g1, w_in, mpb);
          p0_zero(proj, gbf);
          if (!even) { run_tr(lds, jw, b_, (int)gridDim.x); run_tr(lds, jh, b_, (int)gridDim.x); run_tr(lds, jg, b_, (int)gridDim.x); run_tr(lds, jo, b_, (int)gridDim.x); }
#undef TR_LOAD_ID
#undef TR_STORE_ID
        }
        p0_prep_x(lds, x, g1, w_in, A_log, dt_bias, xb, gbf, rsx);
    }
    SEAM(0);
    if (IN(1)) run_dense(lds, (const char*)xb, D * 2, 1024, (const char*)Win, T, NPROJ, 0, 0, proj, lbt, rsx);
    if (IN(1)) meta_finalize((const float*)(ws + OFF_MP), lbl, A_log, dt_bias, proj, gbf);
    SEAM(1);
    if (IN(2)) {
        unsigned* q2 = (unsigned*)(ws + OFF_BAR) + 32;
        LAS int* qit = (LAS int*)(lds + LDS_BYTES - 64);
        unsigned tk = 0; if (threadIdx.x == 0) tk = atomicAdd(q2, 1u);
        for (int it = blockIdx.x; it < 256; it += gridDim.x) hgrn_run<false>(lds, proj, arun, drun, hg_ng, it, oab);
        for (int i = threadIdx.x; i < 6144 / 4; i += NTHR) *(LAS f32x4*)(lds + GB_CW + i * 16) = *(const f32x4*)(convw + 4 * i);
        if (threadIdx.x == 0) qit[0] = (int)tk;
        __syncthreads();
        int cur = qit[0];
        if (threadIdx.x == 0) tk = atomicAdd(q2, 1u);
        GdnBRegs R;
        if (cur < GD_NITEM) gdn_phaseB_load(R, proj, gbf, cur, threadIdx.x);
        while (cur < GD_NITEM) cur = gdn_phaseB(lds, proj, gbf, GB, cur, R, q2, tk);
    }
    SEAM(2);
    if (IN(3)) {
        unsigned* hq = (unsigned*)(ws + OFF_BAR);
        unsigned* scan_done = hq + 64;
        if (blockIdx.x < 128) { const int lab = blockIdx.x & 7, kk = blockIdx.x >> 3; gdn_scan(lds, proj, GB, (2 * lab + (kk >> 3)) * 8 + (kk & 7));
            asm volatile("s_waitcnt vmcnt(0)" ::: "memory");
            __syncthreads();
            if (threadIdx.x == 0) { __builtin_amdgcn_fence(__ATOMIC_RELEASE, "agent"); asm volatile("s_waitcnt vmcnt(0)" ::: "memory"); __hip_atomic_fetch_add(scan_done, 1u, __ATOMIC_RELAXED, __HIP_MEMORY_SCOPE_AGENT); } }
        {
          LAS int* qit = (LAS int*)(lds + LDS_BYTES - 64);
          bool acquired = false;
          for (;;) { __syncthreads(); if (threadIdx.x == 0) *qit = (int)atomicAdd(hq, 1u); __syncthreads(); const int it = *qit; if (it >= 512) break;
              if (it < 256) hgrn_run<true>(lds, proj, arun, drun, hg_ng, ((it & 15) * 16) + (it >> 4), oab);
              else {
                  if (!acquired) { if (threadIdx.x == 0) { while (__hip_atomic_load(scan_done, __ATOMIC_RELAXED, __HIP_MEMORY_SCOPE_AGENT) < 128u) __builtin_amdgcn_s_sleep(8);
                                       __builtin_amdgcn_fence(__ATOMIC_ACQUIRE, "agent"); asm volatile("s_waitcnt vmcnt(0)" ::: "memory"); }
                                   __syncthreads(); acquired = true; }
                  gdn_phaseD_all(lds, proj, GB, gd_ng, it - 256, 256, obb); } }
          if (PROBE_BLK != 0) STAMP(12); }
    }
    if (IN(3) && IN(4)) STAMP(4);
    SEAM(4);
    if (IN(5)) { SchedMerge S; S.so.init(T, 1024, (int)gridDim.x, (int)blockIdx.x); S.base = (const char*)a.out; S.offA = (unsigned)DO_OA; S.offB = (unsigned)DO_OB; S.K = 512; S.Whg = (const char*)Whg; S.Wgd = (const char*)Wgd;
        EpiMerge E{proj, mgb}; pg8::gemm_phase<EpiMerge, SchedMerge>(lds, S, E); }
    SEAM(5);
    if (IN(6)) run_dense(lds, (const char*)mgb, D * 2, 1024, (const char*)Wout, T, 1024, 0, 3, h1b, x, nullptr);
    SEAM(6);
    if (IN(7)) {
        { TrJob j{w_gate, w_up, We1, 2, 1024, 512, 1024, NEXP, (size_t)1024 * 512, (size_t)1024 * 1024, g2}; run_tr(lds, j, (int)blockIdx.x, (int)gridDim.x); }
        { TrJob j{w_down, nullptr, We2, 1, 512, 1024, 1024, NEXP, (size_t)512 * 1024, (size_t)1024 * 512}; run_tr(lds, j, (int)blockIdx.x, (int)gridDim.x); }
        p_router(lds, h1b, g2, rgw, rgb, rew, reb, cnt, list, rsl, asg);
    }
    SEAM(7);
    if (IN(8)) run_moe(lds, (const char*)h1b, D * 2, 1024, (const char*)We1, (size_t)1024 * 1024 * 2, cnt, list, 0, Hb, rsl);
    SEAM(8);
    if (IN(9)) run_moe(lds, (const char*)Hb, 512 * 2, 512, (const char*)We2, (size_t)1024 * 512 * 2, cnt, list, 1, Yb, nullptr);
    SEAM(9);
    if (IN(10)) p_final(lds, h1b, out, Yb, cnt, asg, gf);
    if (PROBE_PH >= 0) {
        __syncthreads();
        if (blockIdx.x == PROBE_BLK && threadIdx.x == 0) { const unsigned long long t1 = __builtin_amdgcn_s_memrealtime(); if (PROBE_PH == 10) tsw[11] = t1;
            const unsigned long long dt = (PROBE_PH == 14 ? tsw[14] : PROBE_PH == 15 ? tsw[15] : PROBE_PH == 13 ? (tsw[13] - tsw[12]) : PROBE_PH == 12 ? (tsw[12] - tsw[3]) : (tsw[PROBE_PH + 1] - tsw[PROBE_PH])) * PROBE_K; while (__builtin_amdgcn_s_memrealtime() - t1 < dt) __builtin_amdgcn_s_sleep(32); }
    }
#undef IN
#undef SEAM
}

#ifndef N_LAUNCH_SPLIT
#define N_LAUNCH_SPLIT 0
#endif
constexpr int NPHASE = 11;
extern "C" void kernel_launch(void* const* d_in, const int* in_sizes, int n_in, void* d_out, int out_size, void* d_ws, size_t ws_size, hipStream_t stream) {
    static int grid = 0;
    if (grid == 0) {
        if (n_in != 22 || in_sizes[0] != T * D || out_size != T * D || ws_size < WS_END) { fprintf(stderr, "kernel_launch: unexpected shapes (n_in %d in0 %d out %d ws %zu need %zu)\n", n_in, n_in > 0 ? in_sizes[0] : -1, out_size, ws_size, (size_t)WS_END); grid = -1; }
        else {
            int dev = 0, cus = 0, per_cu = 0;
            if (hipGetDevice(&dev) != hipSuccess || hipDeviceGetAttribute(&cus, hipDeviceAttributeMultiprocessorCount, dev) != hipSuccess) grid = -1;
            else if (hipFuncSetAttribute((const void*)mega, hipFuncAttributeMaxDynamicSharedMemorySize, LDS_BYTES) != hipSuccess) { fprintf(stderr, "kernel_launch: hipFuncSetAttribute failed\n"); grid = -1; }
            else if (hipOccupancyMaxActiveBlocksPerMultiprocessor(&per_cu, (const void*)mega, NTHR, LDS_BYTES) != hipSuccess || per_cu < 1) { fprintf(stderr, "kernel_launch: occupancy query says %d\n", per_cu); grid = -1; }
            else grid = cus;
            (void)hipGetLastError();
        }
    }
    if (grid < 0) return;
    if (hipMemsetAsync((char*)d_ws + OFF_BAR, 0, XCD_BAR_WORDS * 4, stream) != hipSuccess) { fprintf(stderr, "kernel_launch: memset of the barrier words failed\n"); return; }
    Args a{};
    for (int i = 0; i < 22; ++i) a.in[i] = (const float*)d_in[i];
    a.out = (float*)d_out; a.ws = (char*)d_ws;
#if N_LAUNCH_SPLIT
    for (int p = 0; p < NPHASE; ++p) { a.ph_lo = p; a.ph_hi = p + 1; hipLaunchKernelGGL(mega, dim3(grid), dim3(NTHR), LDS_BYTES, stream, a); }
#else
    a.ph_lo = 0; a.ph_hi = NPHASE;
    void* args[] = {&a};
    hipError_t e = hipLaunchCooperativeKernel((const void*)mega, dim3(grid), dim3(NTHR), args, LDS_BYTES, stream);
    if (e != hipSuccess) fprintf(stderr, "cooperative launch failed: %s (grid %d)\n", hipGetErrorString(e), grid);
#endif
}
```

```cpp
#include <hip/hip_runtime.h>
#include <hip/hip_cooperative_groups.h>
namespace cg = cooperative_groups;
#include <cstdio>
#include <cstdint>

#define LAS __attribute__((address_space(3)))
#ifndef PROBE_PH
#define PROBE_PH -1
#endif
#define PROBE_K 4
#ifndef PROBE_BLK
#define PROBE_BLK 0
#endif
typedef unsigned short bf16_t;
typedef short bf16x8 __attribute__((ext_vector_type(8)));
typedef float f32x4 __attribute__((ext_vector_type(4)));
typedef unsigned u32x4 __attribute__((ext_vector_type(4)));
typedef unsigned u32x2 __attribute__((ext_vector_type(2)));

constexpr int D = 1024, NB = 4, SEQ = 8192, NMETA = 16, T = NB * SEQ;
constexpr int LP = 8256;
constexpr int TP = NB * LP;
constexpr int NPROJ = 6144;
constexpr int WIN_LD = 6152;
constexpr float EPS = 1e-6f;
constexpr int NEXP = 32, ECAP = 32768, HROWS = 73728;
constexpr int C_QA = 0, C_LF = 512, C_VA = 1024, C_HG = 1536, C_GQ = 2048, C_GK = 2560, C_GV = 3072, C_GZ = 3584, C_PA = 4096, C_PB = 5120;

constexpr size_t OFF_PROJ = 0;
constexpr size_t SZ_PROJ = (size_t)TP * NPROJ * 2;
constexpr size_t OFF_WIN = OFF_PROJ + SZ_PROJ;
constexpr size_t OFF_WHG = OFF_WIN + (size_t)NPROJ * D * 2;
constexpr size_t OFF_WGD = OFF_WHG + (size_t)1024 * 512 * 2;
constexpr size_t OFF_WOUT = OFF_WGD + (size_t)1024 * 512 * 2;
constexpr size_t OFF_GBF = OFF_WOUT + (size_t)1024 * 1024 * 2;
constexpr size_t OFF_MISC = OFF_GBF + (size_t)TP * 8 * 4;
constexpr size_t OFF_QKVN = OFF_MISC + 8192;
constexpr size_t GD_SZ16 = (size_t)NB * 129 * 4 * 16384;
constexpr size_t OFF_KHT = OFF_QKVN, OFF_QT = OFF_KHT + GD_SZ16, OFF_AT = OFF_QT + GD_SZ16, OFF_GEND = OFF_AT + GD_SZ16 / 2;
constexpr size_t OFF_BAR = OFF_GEND + 16384;
constexpr size_t OFF_RSX = OFF_BAR + 16384;
constexpr size_t OFF_MP = OFF_RSX + (size_t)T * 4;
constexpr size_t WS_END = OFF_MP + (size_t)2 * 16 * WIN_LD * 4;
static_assert(WS_END <= ((size_t)512 << 20), "workspace");
constexpr size_t OFF_TMP = OFF_QKVN;
constexpr size_t DO_WP = 0, DO_U0T = GD_SZ16, DO_ARUN = (size_t)68 << 20, DO_OA = (size_t)90 << 20, DO_OB = 0;
constexpr size_t OFF_MG = OFF_QKVN;
constexpr size_t OFF_XN = 0;
constexpr size_t OFF_WE1 = OFF_XN + (size_t)T * D * 2;
constexpr size_t OFF_WE2 = OFF_WE1 + (size_t)NEXP * 1024 * 1024 * 2;
constexpr size_t OFF_H = OFF_WE2 + (size_t)NEXP * 1024 * 512 * 2;
constexpr size_t OFF_Y = OFF_H + (size_t)HROWS * 512 * 2;
constexpr size_t OFF_LIST = OFF_Y + (size_t)HROWS * 1024 * 2;
constexpr size_t OFF_ASG = OFF_LIST + (size_t)NEXP * ECAP * 4;
constexpr size_t OFF_RS = OFF_ASG + (size_t)T * 2 * 12;
constexpr size_t MOE_END = OFF_RS + (size_t)NEXP * ECAP * 4;
static_assert(MOE_END <= SZ_PROJ, "moe scratch must fit in the dead proj region");
constexpr size_t MISC_LBT = 0, MISC_CNT = 4096;

typedef __bf16 bf16x2_t __attribute__((ext_vector_type(2)));
typedef float f32x2_t __attribute__((ext_vector_type(2)));
__device__ __forceinline__ unsigned cvt_pk_bf16(float lo, float hi) { const f32x2_t f = {lo, hi}; const bf16x2_t b = __builtin_convertvector(f, bf16x2_t); return __builtin_bit_cast(unsigned, b); }
__device__ __forceinline__ float bf_lo(unsigned w) { return __uint_as_float(w << 16); }
__device__ __forceinline__ float bf_hi(unsigned w) { return __uint_as_float(w & 0xffff0000u); }
__device__ __forceinline__ float bf2f(bf16_t b) { return __uint_as_float(((unsigned)b) << 16); }
__device__ __forceinline__ bf16_t f2bf(float f) { return (bf16_t)(cvt_pk_bf16(f, 0.f) & 0xffffu); }
__device__ __forceinline__ float sigmoidf_(float x) { return __builtin_amdgcn_rcpf(1.0f + __expf(-x)); }
__device__ __forceinline__ float siluf_(float x) { return x * __builtin_amdgcn_rcpf(1.0f + __expf(-x)); }
__device__ __forceinline__ float wave_sum(float v) {
    v += __builtin_bit_cast(float, __builtin_amdgcn_update_dpp(0, __builtin_bit_cast(int, v), 0xB1, 0xF, 0xF, true));
    v += __builtin_bit_cast(float, __builtin_amdgcn_update_dpp(0, __builtin_bit_cast(int, v), 0x4E, 0xF, 0xF, true));
    v += __builtin_bit_cast(float, __builtin_amdgcn_update_dpp(0, __builtin_bit_cast(int, v), 0x141, 0xF, 0xF, true));
    v += __builtin_bit_cast(float, __builtin_amdgcn_update_dpp(0, __builtin_bit_cast(int, v), 0x140, 0xF, 0xF, true));
    v += __builtin_bit_cast(float, __builtin_amdgcn_update_dpp(0, __builtin_bit_cast(int, v), 0x142, 0xA, 0xF, false));
    v += __builtin_bit_cast(float, __builtin_amdgcn_update_dpp(0, __builtin_bit_cast(int, v), 0x143, 0xC, 0xF, false));
    return __builtin_bit_cast(float, __builtin_amdgcn_readlane(__builtin_bit_cast(int, v), 63));
}
__device__ __forceinline__ float wave_incl_scan(float v) {
    v += __builtin_bit_cast(float, __builtin_amdgcn_update_dpp(0, __builtin_bit_cast(int, v), 0x111, 0xF, 0xF, true));
    v += __builtin_bit_cast(float, __builtin_amdgcn_update_dpp(0, __builtin_bit_cast(int, v), 0x112, 0xF, 0xF, true));
    v += __builtin_bit_cast(float, __builtin_amdgcn_update_dpp(0, __builtin_bit_cast(int, v), 0x114, 0xF, 0xF, true));
    v += __builtin_bit_cast(float, __builtin_amdgcn_update_dpp(0, __builtin_bit_cast(int, v), 0x118, 0xF, 0xF, true));
    v += __builtin_bit_cast(float, __builtin_amdgcn_update_dpp(0, __builtin_bit_cast(int, v), 0x142, 0xA, 0xF, false));
    v += __builtin_bit_cast(float, __builtin_amdgcn_update_dpp(0, __builtin_bit_cast(int, v), 0x143, 0xC, 0xF, false));
    return v;
}
__device__ __forceinline__ int prow_of(int r) { return (r >> 13) * LP + 64 + (r & 8191); }

namespace pg8 {
constexpr int BM = 256, BK = 64, HALF = 128, HTB = HALF * BK * 2, STAGE_BYTES = 8 * HTB, NXCD = 8, WGM = 4;
__host__ __device__ __forceinline__ int lds_byte(int r, int c) { const int st = (r >> 4) * 2 + (c >> 5), rr = r & 15, cc = c & 31, ob = rr * 64 + cc * 2; return st * 1024 + (ob ^ (((ob >> 9) & 1) << 5)); }
__host__ __device__ __forceinline__ void stage_rc(int b, int& R, int& C) { const int st = b / 1024, sb = b % 1024, swz = sb ^ (((sb >> 9) & 1) << 5); R = (st >> 1) * 16 + swz / 64; C = (st & 1) * 32 + (swz % 64) / 2; }
__host__ __device__ __forceinline__ int perm32(int rho) { const int n = rho >> 4, i = rho & 15; return 8 * (i >> 2) + 4 * n + (i & 3); }

struct Unit { int pm, pn, e, t, s; };

struct StaticOrder {
    int nM, nN, nwg, G, c;
    __device__ void init(int M, int N, int G_, int c_) { nM = M / BM; nN = N / BM; nwg = nM * nN; G = G_; c = c_; }
    __device__ bool next(int i, Unit& u) const {
        const long L = (long)i * G + c; if (L >= nwg) return false;
        int wgid = (int)L; { const int q = nwg / NXCD, r = nwg % NXCD, xcd = wgid % NXCD, off = wgid / NXCD; wgid = (xcd < r ? xcd * (q + 1) : r * (q + 1) + (xcd - r) * q) + off; }
        const int nig = WGM * nN, gid = wgid / nig, fm = gid * WGM, gsz = (nM - fm) < WGM ? (nM - fm) : WGM;
        u.pm = fm + ((wgid % nig) % gsz); u.pn = (wgid % nig) / gsz; u.e = 0; u.t = 0; u.s = 0; return true;
    }
};

template <class Epi, class Sched>
__device__ __forceinline__ void gemm_phase(LAS unsigned char* lds, const Sched& S, const Epi& E) {
    const int tid = threadIdx.x, wid = __builtin_amdgcn_readfirstlane(tid >> 6), lane = tid & 63, wr = wid >> 2, wc = wid & 3, fr = lane & 15, fq = lane >> 4;
    const int K = S.K, nt = K / BK;
    int Rr[2]; unsigned ccA[2], voffB[2];
#pragma unroll
    for (int i = 0; i < 2; ++i) { int R, C; stage_rc(tid * 16 + i * 8192, R, C); const int Rb = Epi::PERM ? ((R & ~31) + perm32(R & 31)) : R;
        Rr[i] = R; ccA[i] = (unsigned)C * 2u; voffB[i] = (unsigned)(Rb * K + C) * 2u; }
    const size_t kstep = (size_t)(BK * 2);
    const size_t hstepB = (size_t)HALF * K * 2;
    const unsigned ldsw = (unsigned)wid * 1024u;
    const int aoff = lds_byte(wr * 64 + fr, fq * 8), boff = lds_byte(wc * 32 + fr, fq * 8);
#define PG8_SA(b, h) (((b) * 2 + (h)) * HTB)
#define PG8_SB(b, h) ((4 + (b) * 2 + (h)) * HTB)
#define PG8_STAGE(bufoff, gbase, voff) do { _Pragma("unroll") for (int _i = 0; _i < 2; ++_i) \
        __builtin_amdgcn_global_load_lds((const unsigned*)((const char*)(gbase) + (voff)[_i]), (LAS unsigned*)(lds + (bufoff) + ldsw + _i * 8192), 16, 0, 0); } while (0)
#define PG8_LDA(dst, b, h) do { _Pragma("unroll") for (int m = 0; m < 4; ++m) _Pragma("unroll") for (int k = 0; k < 2; ++k) dst[m][k] = *(const LAS bf16x8*)(lds + PG8_SA(b, h) + aoff + m * 2048 + k * 1024); } while (0)
#define PG8_LDB(dst, b, h) do { _Pragma("unroll") for (int n = 0; n < 2; ++n) _Pragma("unroll") for (int k = 0; k < 2; ++k) dst[n][k] = *(const LAS bf16x8*)(lds + PG8_SB(b, h) + boff + n * 2048 + k * 1024); } while (0)
#define PG8_MMA(ai, bj, At, Bt) do { __builtin_amdgcn_s_setprio(1); _Pragma("unroll") for (int m = 0; m < 4; ++m) _Pragma("unroll") for (int n = 0; n < 2; ++n) _Pragma("unroll") for (int k = 0; k < 2; ++k) \
        acc[ai][bj][m][n] = __builtin_amdgcn_mfma_f32_16x16x32_bf16(Bt[n][k], At[m][k], acc[ai][bj][m][n], 0, 0, 0); __builtin_amdgcn_s_setprio(0); } while (0)
#define PG8_WAIT_V(n) asm volatile("s_waitcnt vmcnt(" #n ")" ::: "memory")
#define PG8_WAIT_L(n) asm volatile("s_waitcnt lgkmcnt(" #n ")" ::: "memory")
#define PG8_BAR __builtin_amdgcn_s_barrier()
#define PG8_SCHED __builtin_amdgcn_sched_barrier(0)
    Unit cur, nxt; int ui = 0;
    if (!S.next(0, cur)) return;
    f32x4 acc[2][2][4][2];
#pragma unroll
    for (int a = 0; a < 2; ++a)
#pragma unroll
        for (int b = 0; b < 2; ++b)
#pragma unroll
            for (int m = 0; m < 4; ++m)
#pragma unroll
                for (int n = 0; n < 2; ++n) acc[a][b][m][n] = (f32x4){0.f, 0.f, 0.f, 0.f};
    bf16x8 At[4][2], B0[2][2], B1[2][2];
    unsigned vAc[2][2], vAn[2][2];
#pragma unroll
    for (int h = 0; h < 2; ++h)
#pragma unroll
        for (int i = 0; i < 2; ++i) vAc[h][i] = S.a_off(cur, Rr[i] + HALF * h) + ccA[i];
    const char* gA = S.a_base();
    const char* cB = S.b_ptr(cur);
    PG8_STAGE(PG8_SB(0, 0), cB, voffB); PG8_STAGE(PG8_SB(0, 1), cB + hstepB, voffB); PG8_STAGE(PG8_SA(0, 0), gA, vAc[0]); PG8_STAGE(PG8_SA(0, 1), gA, vAc[1]);
    if (wr == 1) PG8_BAR;
    PG8_WAIT_V(2); PG8_BAR;
    PG8_STAGE(PG8_SB(1, 0), cB + kstep, voffB); PG8_STAGE(PG8_SA(1, 0), gA + kstep, vAc[0]); PG8_STAGE(PG8_SB(1, 1), cB + hstepB + kstep, voffB);
    PG8_WAIT_V(6); PG8_BAR;
    for (;;) {
        const bool has_next = S.next(ui + 1, nxt);
        const bool hf = S.half(cur);
        const char* nB = has_next ? S.b_ptr(nxt) : cB;
#pragma unroll
        for (int h = 0; h < 2; ++h)
#pragma unroll
            for (int i = 0; i < 2; ++i) vAn[h][i] = has_next ? (S.a_off(nxt, Rr[i] + HALF * h) + ccA[i]) : vAc[h][i];
        for (int t = 0; t < nt; t += 2) {
            const bool last = (t == nt - 2);
            const char* a1 = gA + (size_t)(t + 1) * kstep;
            const char* a2 = last ? gA : gA + (size_t)(t + 2) * kstep; const char* b2 = last ? nB : cB + (size_t)(t + 2) * kstep;
            const char* a3 = a2 + kstep; const char* b3 = b2 + kstep;
            unsigned w0[2], w1[2];
#pragma unroll
            for (int i = 0; i < 2; ++i) { w0[i] = last ? vAn[0][i] : vAc[0][i]; w1[i] = last ? vAn[1][i] : vAc[1][i]; }
            PG8_LDB(B0, 0, 0); PG8_LDB(B1, 0, 1); PG8_SCHED; PG8_LDA(At, 0, 0); PG8_STAGE(PG8_SA(1, 1), a1, vAc[1]);
            PG8_WAIT_V(8); PG8_WAIT_L(0); PG8_BAR; PG8_MMA(0, 0, At, B0); PG8_MMA(0, 1, At, B1); PG8_BAR; PG8_SCHED;
            if (!hf) PG8_LDA(At, 0, 1); PG8_STAGE(PG8_SB(0, 0), b2, voffB); PG8_STAGE(PG8_SB(0, 1), b2 + hstepB, voffB); PG8_STAGE(PG8_SA(0, 0), a2, w0);
            PG8_WAIT_V(8); PG8_WAIT_L(0); PG8_BAR; if (!hf) { PG8_MMA(1, 0, At, B0); PG8_MMA(1, 1, At, B1); } PG8_BAR; PG8_SCHED;
            PG8_LDB(B0, 1, 0); PG8_LDB(B1, 1, 1); PG8_SCHED; PG8_LDA(At, 1, 0); PG8_STAGE(PG8_SA(0, 1), a2, w1);
            PG8_WAIT_V(8); PG8_WAIT_L(0); PG8_BAR; PG8_MMA(0, 0, At, B0); PG8_MMA(0, 1, At, B1); PG8_BAR; PG8_SCHED;
            if (!hf) PG8_LDA(At, 1, 1); PG8_STAGE(PG8_SB(1, 0), b3, voffB); PG8_STAGE(PG8_SB(1, 1), b3 + hstepB, voffB); PG8_STAGE(PG8_SA(1, 0), a3, w0);
            PG8_WAIT_V(8); PG8_WAIT_L(0); PG8_BAR; if (!hf) { PG8_MMA(1, 0, At, B0); PG8_MMA(1, 1, At, B1); } PG8_BAR; PG8_SCHED;
        }
        if (wr == 0) PG8_BAR;
        E(acc, cur, wr, wc, fr, fq);
        if (!has_next) break;
        if (!S.keep(cur)) {
#pragma unroll
        for (int a = 0; a < 2; ++a)
#pragma unroll
            for (int b = 0; b < 2; ++b)
#pragma unroll
                for (int m = 0; m < 4; ++m)
#pragma unroll
                    for (int n = 0; n < 2; ++n) acc[a][b][m][n] = (f32x4){0.f, 0.f, 0.f, 0.f};
        }
        cur = nxt; cB = nB; ++ui;
#pragma unroll
        for (int h = 0; h < 2; ++h)
#pragma unroll
            for (int i = 0; i < 2; ++i) vAc[h][i] = vAn[h][i];
        if (wr == 1) PG8_BAR;
    }
    PG8_WAIT_V(0);
    PG8_BAR;
#undef PG8_SA
#undef PG8_SB
#undef PG8_STAGE
#undef PG8_LDA
#undef PG8_LDB
#undef PG8_MMA
#undef PG8_WAIT_V
#undef PG8_WAIT_L
#undef PG8_BAR
#undef PG8_SCHED
}
}

struct SchedDense {
    pg8::StaticOrder so; const char* A; unsigned lda2; int K; const char* Bt; int rowmap;
    __device__ bool next(int i, pg8::Unit& u) const { return so.next(i, u); }
    __device__ const char* a_base() const { return A; }
    __device__ unsigned a_off(const pg8::Unit& u, int r) const { const int row = u.pm * 256 + r; return (unsigned)(rowmap ? prow_of(row) : row) * lda2; }
    __device__ const char* b_ptr(const pg8::Unit& u) const { return Bt + (size_t)u.pn * 256 * K * 2; }
    __device__ bool keep(const pg8::Unit&) const { return false; }
    __device__ bool half(const pg8::Unit&) const { return false; }
};
struct SchedMerge {
    pg8::StaticOrder so; const char* base; unsigned offA, offB; int K; const char* Whg; const char* Wgd;
    __device__ bool next(int i, pg8::Unit& u) const { const bool ok = so.next(i >> 1, u); u.e = i & 1; return ok; }
    __device__ const char* a_base() const { return base; }
    __device__ unsigned a_off(const pg8::Unit& u, int r) const { return (u.e ? offB : offA) + (unsigned)(u.pm * 256 + r) * 1024u; }
    __device__ const char* b_ptr(const pg8::Unit& u) const { return (u.e ? Wgd : Whg) + (size_t)u.pn * 256 * K * 2; }
    __device__ bool keep(const pg8::Unit& u) const { return u.e == 0; }
    __device__ bool half(const pg8::Unit&) const { return false; }
};
struct SchedMoe {
    const int* list; LAS const int* pref;
    const char* A; unsigned lda2; int K; const char* Bt; size_t bstride; int gather; int G, c;
    __device__ bool compute(int i, pg8::Unit& u) const {
        const int L = i * G + c; const int nF = pref[33 + NEXP] * 4, nH = pref[66 + NEXP] * 4; if (L >= nF + nH) return false;
        int e = 0;
        if (L < nF) {
            { int lo = 0, hi = NEXP - 1;
#pragma unroll 1
              while (lo < hi) { const int mid = (lo + hi + 1) >> 1; if (pref[33 + mid] * 4 <= L) lo = mid; else hi = mid - 1; } e = lo; }
            const int q = L - pref[33 + e] * 4, nte = pref[33 + e + 1] - pref[33 + e];
            u.e = e; u.pn = q / nte; u.t = q % nte;
        } else {
            const int Lh = L - nF;
            { int lo = 0, hi = NEXP - 1;
#pragma unroll 1
              while (lo < hi) { const int mid = (lo + hi + 1) >> 1; if (pref[66 + mid] * 4 <= Lh) lo = mid; else hi = mid - 1; } e = lo; }
            u.e = e; u.pn = Lh - pref[66 + e] * 4; u.t = (pref[e + 1] - pref[e]) - 1;
        }
        u.pm = pref[u.e] + u.t; return true;
    }
    __device__ bool next(int i, pg8::Unit& u) const { if (i >= 8) return false; const LAS int* q = pref + 136 + 8 * i; u.pm = q[1]; u.pn = q[2]; u.e = q[3]; u.t = q[4]; u.s = i; return q[0] != 0; }
    __device__ const char* a_base() const { return A; }
    __device__ unsigned a_off(const pg8::Unit& u, int r) const {
        if (gather) return (unsigned)pref[256 + u.s * 256 + r] * lda2;
        return (unsigned)(u.pm * 256 + r) * lda2;
    }
    __device__ const char* b_ptr(const pg8::Unit& u) const { return Bt + (size_t)u.e * bstride + (size_t)u.pn * 256 * K * 2; }
    __device__ bool keep(const pg8::Unit&) const { return false; }
    __device__ bool half(const pg8::Unit& u) const { const int rem = pref[100 + u.e] & 255; return rem != 0 && rem <= 128 && u.t == (pref[u.e + 1] - pref[u.e]) - 1; }
};

struct EpiProj {
    static constexpr bool PERM = true;
    bf16_t* proj; const float* lbt; const float* rsx;
    __device__ __forceinline__ void operator()(const f32x4 (&acc)[2][2][4][2], const pg8::Unit& u, int wr, int wc, int fr, int fq) const {
        const int seg = u.pn >> 1;
        float rv[2][4];
#pragma unroll
        for (int ai = 0; ai < 2; ++ai)
#pragma unroll
            for (int m = 0; m < 4; ++m) rv[ai][m] = rsx[u.pm * 256 + wr * 64 + fr + ai * 128 + m * 16];
        const int row0 = prow_of(u.pm * 256) + wr * 64 + fr, col0 = u.pn * 256 + wc * 32 + 8 * fq;
        const int mode = (seg == 0 || seg == 3 || seg == 7) ? 1 : (seg == 1 ? 2 : 0);
        float lb[2][8];
#pragma unroll
        for (int bj = 0; bj < 2; ++bj)
#pragma unroll
            for (int j = 0; j < 8; ++j) lb[bj][j] = (mode == 2) ? lbt[col0 + bj * 128 + j - C_LF] : 0.f;
#pragma unroll
        for (int ai = 0; ai < 2; ++ai)
#pragma unroll
            for (int m = 0; m < 4; ++m) { bf16_t* rowp = proj + (size_t)(row0 + ai * 128 + m * 16) * NPROJ + col0;
#pragma unroll
                for (int bj = 0; bj < 2; ++bj) { float v[8];
#pragma unroll
                    for (int j = 0; j < 4; ++j) { v[j] = acc[ai][bj][m][0][j] * rv[ai][m]; v[4 + j] = acc[ai][bj][m][1][j] * rv[ai][m]; }
                    if (mode == 1) {
#pragma unroll
                        for (int j = 0; j < 8; ++j) v[j] = siluf_(v[j]);
                    } else if (mode == 2) {
#pragma unroll
                        for (int j = 0; j < 8; ++j) v[j] = __logf(lb[bj][j] + (1.0f - lb[bj][j]) * sigmoidf_(v[j]));
                    }
                    u32x4 w; w.x = cvt_pk_bf16(v[0], v[1]); w.y = cvt_pk_bf16(v[2], v[3]); w.z = cvt_pk_bf16(v[4], v[5]); w.w = cvt_pk_bf16(v[6], v[7]);
                    *(u32x4*)(rowp + bj * 128) = w; } }
    }
};
struct EpiMerge {
    static constexpr bool PERM = true;
    bf16_t* proj; bf16_t* mg;
    __device__ __forceinline__ void operator()(f32x4 (&acc)[2][2][4][2], const pg8::Unit& u, int wr, int wc, int fr, int fq) const {
        const int prow0 = prow_of(u.pm * 256) + wr * 64 + fr, row0 = u.pm * 256 + wr * 64 + fr, col0 = u.pn * 256 + wc * 32 + 8 * fq;
#pragma unroll
        for (int ai = 0; ai < 2; ++ai) {
            u32x4 gbw[4][2], gaw[4][2];
#pragma unroll
            for (int m = 0; m < 4; ++m) { const bf16_t* rp = proj + (size_t)(prow0 + ai * 128 + m * 16) * NPROJ + col0;
#pragma unroll
                for (int bj = 0; bj < 2; ++bj) { gbw[m][bj] = *(const u32x4*)(rp + C_PB + bj * 128); gaw[m][bj] = (u.e == 0) ? *(const u32x4*)(rp + C_PA + bj * 128) : (u32x4){0u, 0u, 0u, 0u}; } }
#pragma unroll
            for (int m = 0; m < 4; ++m)
#pragma unroll
                for (int bj = 0; bj < 2; ++bj) {
                    const u32x4 gb = gbw[m][bj], ga = gaw[m][bj];
                    const float gbv[8] = {bf_lo(gb.x), bf_hi(gb.x), bf_lo(gb.y), bf_hi(gb.y), bf_lo(gb.z), bf_hi(gb.z), bf_lo(gb.w), bf_hi(gb.w)};
                    if (u.e == 0) {
                        const float gav[8] = {bf_lo(ga.x), bf_hi(ga.x), bf_lo(ga.y), bf_hi(ga.y), bf_lo(ga.z), bf_hi(ga.z), bf_lo(ga.w), bf_hi(ga.w)};
#pragma unroll
                        for (int j = 0; j < 4; ++j) { acc[ai][bj][m][0][j] *= (1.0f + __expf(-gbv[j])) * __builtin_amdgcn_rcpf(1.0f + __expf(-gav[j])); acc[ai][bj][m][1][j] *= (1.0f + __expf(-gbv[4 + j])) * __builtin_amdgcn_rcpf(1.0f + __expf(-gav[4 + j])); }
                    } else {
                        float v[8];
#pragma unroll
                        for (int j = 0; j < 4; ++j) { v[j] = acc[ai][bj][m][0][j] * sigmoidf_(gbv[j]); v[4 + j] = acc[ai][bj][m][1][j] * sigmoidf_(gbv[4 + j]); }
                        u32x4 w; w.x = cvt_pk_bf16(v[0], v[1]); w.y = cvt_pk_bf16(v[2], v[3]); w.z = cvt_pk_bf16(v[4], v[5]); w.w = cvt_pk_bf16(v[6], v[7]);
                        *(u32x4*)(mg + (size_t)(row0 + ai * 128 + m * 16) * D + col0 + bj * 128) = w; }
                }
            asm volatile("" ::: "memory"); }
    }
};
struct EpiResid {
    static constexpr bool PERM = true;
    const float* x; bf16_t* h1b;
    __device__ __forceinline__ void operator()(const f32x4 (&acc)[2][2][4][2], const pg8::Unit& u, int wr, int wc, int fr, int fq) const {
        const int row0 = u.pm * 256 + wr * 64 + fr, col0 = u.pn * 256 + wc * 32 + 8 * fq;
#pragma unroll
        for (int ai = 0; ai < 2; ++ai) {
            f32x4 xv[4][2][2];
#pragma unroll
            for (int m = 0; m < 4; ++m) { const size_t off = (size_t)(row0 + ai * 128 + m * 16) * D + col0;
#pragma unroll
                for (int bj = 0; bj < 2; ++bj)
#pragma unroll
                    for (int n = 0; n < 2; ++n) xv[m][bj][n] = *(const f32x4*)(x + off + bj * 128 + n * 4); }
#pragma unroll
            for (int m = 0; m < 4; ++m) { const size_t off = (size_t)(row0 + ai * 128 + m * 16) * D + col0;
#pragma unroll
                for (int bj = 0; bj < 2; ++bj) { const f32x4 a = xv[m][bj][0] + acc[ai][bj][m][0], b = xv[m][bj][1] + acc[ai][bj][m][1];
                    u32x4 w; w.x = cvt_pk_bf16(a[0], a[1]); w.y = cvt_pk_bf16(a[2], a[3]); w.z = cvt_pk_bf16(b[0], b[1]); w.w = cvt_pk_bf16(b[2], b[3]);
                    *(u32x4*)(h1b + off + bj * 128) = w; } }
            asm volatile("" ::: "memory"); }
    }
};
struct EpiSwiglu {
    static constexpr bool PERM = true;
    bf16_t* H; const float* rs;
    __device__ __forceinline__ void operator()(const f32x4 (&acc)[2][2][4][2], const pg8::Unit& u, int wr, int wc, int fr, int fq) const {
        const int row0 = u.pm * 256 + wr * 64 + fr, col0 = u.pn * 128 + wc * 32 + 8 * fq;
        const float* rsp = rs + (size_t)u.e * ECAP + u.t * 256 + wr * 64 + fr;
        float rv[2][4];
#pragma unroll
        for (int ai = 0; ai < 2; ++ai)
#pragma unroll
            for (int m = 0; m < 4; ++m) rv[ai][m] = rsp[ai * 128 + m * 16];
#pragma unroll
        for (int ai = 0; ai < 2; ++ai)
#pragma unroll
            for (int m = 0; m < 4; ++m) { const float r = rv[ai][m];
                const f32x4 g0 = acc[ai][0][m][0] * r, g1 = acc[ai][0][m][1] * r, u0 = acc[ai][1][m][0] * r, u1 = acc[ai][1][m][1] * r;
                u32x4 w; w.x = cvt_pk_bf16(siluf_(g0[0]) * u0[0], siluf_(g0[1]) * u0[1]); w.y = cvt_pk_bf16(siluf_(g0[2]) * u0[2], siluf_(g0[3]) * u0[3]);
                w.z = cvt_pk_bf16(siluf_(g1[0]) * u1[0], siluf_(g1[1]) * u1[1]); w.w = cvt_pk_bf16(siluf_(g1[2]) * u1[2], siluf_(g1[3]) * u1[3]);
                *(u32x4*)(H + (size_t)(row0 + ai * 128 + m * 16) * 512 + col0) = w; }
    }
};
struct EpiY {
    static constexpr bool PERM = true;
    bf16_t* Y;
    __device__ __forceinline__ void operator()(const f32x4 (&acc)[2][2][4][2], const pg8::Unit& u, int wr, int wc, int fr, int fq) const {
        const int row0 = u.pm * 256 + wr * 64 + fr, col0 = u.pn * 256 + wc * 32 + 8 * fq;
#pragma unroll
        for (int ai = 0; ai < 2; ++ai)
#pragma unroll
            for (int m = 0; m < 4; ++m) { bf16_t* rowp = Y + (size_t)(row0 + ai * 128 + m * 16) * D + col0;
#pragma unroll
                for (int bj = 0; bj < 2; ++bj) { const f32x4 a = acc[ai][bj][m][0], b = acc[ai][bj][m][1];
                    u32x4 w; w.x = cvt_pk_bf16(a[0], a[1]); w.y = cvt_pk_bf16(a[2], a[3]); w.z = cvt_pk_bf16(b[0], b[1]); w.w = cvt_pk_bf16(b[2], b[3]);
                    *(u32x4*)(rowp + bj * 128) = w; } }
    }
};


#define XB_TMO      128
#define XB_XCNT(j)  (256  + 64 * (j))
#define XB_XSUB(j)  (1280 + 64 * (j))
#define XB_XGEN(j)  (2304 + 64 * (j))
#define XB_TOP      3328
#define XB_TOPGEN   3392
#define XCD_BAR_WORDS 3456
#define XB_SPIN_CAP (1u << 22)
__device__ __forceinline__ unsigned xb_ld(unsigned* p)              { return __hip_atomic_load(p, __ATOMIC_RELAXED, __HIP_MEMORY_SCOPE_AGENT); }
__device__ __forceinline__ unsigned xb_add(unsigned* p, unsigned v) { return __hip_atomic_fetch_add(p, v, __ATOMIC_RELAXED, __HIP_MEMORY_SCOPE_AGENT); }
__device__ __forceinline__ unsigned xb_xcc_id() { return (unsigned)__builtin_amdgcn_s_getreg((3 << 11) | 20) & 0xFu; }
#define XB_SPIN(cond, bar) do { unsigned _sp = 0; while (cond) { __builtin_amdgcn_s_sleep(1); \
    if ((++_sp & 255u) == 0u) { if (xb_ld(&(bar)[XB_TMO])) break; if (_sp > XB_SPIN_CAP) { atomicAdd(&(bar)[XB_TMO], 1u); break; } } } } while (0)
struct XcdBarrier { unsigned* bar; unsigned x; volatile LAS unsigned* st; };
__device__ __forceinline__ XcdBarrier xcd_barrier_post(unsigned* bar, volatile LAS unsigned* st) {
    XcdBarrier b; b.bar = bar; b.x = xb_xcc_id(); b.st = st;
    if (threadIdx.x == 0) (void)xb_add(&bar[XB_XCNT(b.x)], 1u);
    return b;
}
__device__ __forceinline__ void xcd_barrier_complete(unsigned* bar, unsigned x, unsigned& nloc, unsigned& nx) {
    const unsigned G = gridDim.x * gridDim.y * gridDim.z;
    unsigned sum, cnt, mine, sp = 0u;
    for (;;) {
        sum = 0u; cnt = 0u; mine = 0u;
#pragma unroll
        for (unsigned j = 0; j < 16; ++j) { const unsigned c = xb_ld(&bar[XB_XCNT(j)]); sum += c; cnt += (c > 0u) ? 1u : 0u; mine = (j == x) ? c : mine; }
        if (sum == G) break;
        __builtin_amdgcn_s_sleep(1);
        if ((++sp & 255u) == 0u) { if (xb_ld(&bar[XB_TMO])) break; if (sp > XB_SPIN_CAP) { atomicAdd(&bar[XB_TMO], 1u); break; } }
    }
    nloc = mine > 0u ? mine : 1u; nx = cnt > 0u ? cnt : 1u;
}
__device__ __forceinline__ void xcd_barrier(const XcdBarrier& b) {
    asm volatile("s_waitcnt vmcnt(0)" ::: "memory");
    __syncthreads();
    if (threadIdx.x == 0) {
        unsigned* bar = b.bar;
        __builtin_amdgcn_s_waitcnt(0);
        unsigned nloc = b.st[0], nx = b.st[1];
        if (nloc == 0u) { xcd_barrier_complete(bar, b.x, nloc, nx); b.st[0] = nloc; b.st[1] = nx; }
        const unsigned old = xb_add(&bar[XB_XSUB(b.x)], 1u);
        const unsigned gen = old / nloc;
        if (old + 1u == (gen + 1u) * nloc) {
            __builtin_amdgcn_fence(__ATOMIC_RELEASE, "agent");
            asm volatile("s_waitcnt vmcnt(0)" ::: "memory");
            const unsigned og = xb_add(&bar[XB_TOP], 1u);
            const unsigned tg = og / nx;
            if (og + 1u == (tg + 1u) * nx) xb_add(&bar[XB_TOPGEN], 1u);
            else XB_SPIN(xb_ld(&bar[XB_TOPGEN]) == tg, bar);
            __builtin_amdgcn_fence(__ATOMIC_ACQUIRE, "agent");
            xb_add(&bar[XB_XGEN(b.x)], 1u);
            asm volatile("s_waitcnt vmcnt(0)" ::: "memory");
        } else {
            XB_SPIN(xb_ld(&bar[XB_XGEN(b.x)]) == gen, bar);
            __builtin_amdgcn_fence(__ATOMIC_ACQUIRE, "agent");
            asm volatile("s_waitcnt vmcnt(0)" ::: "memory");
        }
    }
    __syncthreads();
}

constexpr int LDS_BYTES = 150 * 1024;
constexpr int NTHR = 512;
struct Args {
    const float* in[22]; float* out; char* ws; int ph_lo, ph_hi;
};

__device__ __forceinline__ f32x4 mfma16(bf16x8 a, bf16x8 b, f32x4 c) { return __builtin_amdgcn_mfma_f32_16x16x32_bf16(a, b, c, 0, 0, 0); }
struct TrJob { const float* s0; const float* s1; bf16_t* dst; int mode, K, ld, ndst, nb; size_t sbatch, dbatch; const float* ks; };
__device__ __forceinline__ void tr_load(f32x4 (&v)[8], float (&sc)[8], const TrJob& j, int t) {
    const int tk = j.K / 64, tn = j.ndst / 256, per = tk * tn; const int e = t / per, r = t % per, k0 = (r % tk) * 64, n0 = (r / tk) * 256;
    const float* a = j.s0 + (size_t)e * j.sbatch; const float* b = j.s1 ? j.s1 + (size_t)e * j.sbatch : nullptr;
    const int tid = threadIdx.x;
#pragma unroll
    for (int i = 0; i < 8; ++i) { const int idx = tid + NTHR * i, row = idx >> 6, j4 = idx & 63, n = n0 + 4 * j4;
        const float* p;
        if (j.mode == 0) p = a + (n < 4096 ? n : n + 8);
        else if (j.mode == 1) p = a + n;
        else { const int grp = n >> 8, w = n & 255; p = (w < 128 ? a : b) + grp * 128 + (w & 127); }
        v[i] = *(const f32x4*)(p + (size_t)(k0 + row) * j.ld); sc[i] = j.ks ? j.ks[k0 + row] : 1.0f; }
}
__device__ __forceinline__ void tr_store(LAS float* tile  , const f32x4 (&v)[8], const float (&sc)[8], const TrJob& j, int t) {
    const int tk = j.K / 64, tn = j.ndst / 256, per = tk * tn; const int e = t / per, r = t % per, k0 = (r % tk) * 64, n0 = (r / tk) * 256;
    bf16_t* dst = j.dst + (size_t)e * j.dbatch; const int K = j.K;
    const int tid = threadIdx.x;
    __syncthreads();
#pragma unroll
    for (int i = 0; i < 8; ++i) { const int idx = tid + NTHR * i, row = idx >> 6, j4 = idx & 63; *(LAS f32x4*)(tile + row * 260 + 4 * j4) = v[i] * sc[i]; }
    __syncthreads();
#pragma unroll
    for (int i = 0; i < 4; ++i) { const int ch = tid + NTHR * i, n = ch >> 3, kq = (ch & 7) * 8;
        unsigned w[4];
#pragma unroll
        for (int jx = 0; jx < 4; ++jx) w[jx] = cvt_pk_bf16(tile[(kq + 2 * jx) * 260 + n], tile[(kq + 2 * jx + 1) * 260 + n]);
        *(u32x4*)(dst + (size_t)(n0 + n) * K + k0 + kq) = (u32x4){w[0], w[1], w[2], w[3]}; }
}
__device__ __forceinline__ void run_tr(LAS unsigned char* lds, const TrJob& j, int first, int stride) {
    const int total = (j.K / 64) * (j.ndst / 256) * j.nb;
    f32x4 va[8], vb[8]; float sa[8], sb[8];
    int t = first;
    if (t < total) tr_load(va, sa, j, t);
    while (t < total) {
        int tn = t + stride;
        if (tn < total) tr_load(vb, sb, j, tn);
        tr_store((LAS float*)lds, va, sa, j, t);
        t = tn; if (t >= total) break;
        tn = t + stride;
        if (tn < total) tr_load(va, sa, j, tn);
        tr_store((LAS float*)lds, vb, sb, j, t);
        t = tn;
    }
    __syncthreads();
}
__device__ __forceinline__ float softplusf_(float x) { return x > 20.f ? x : log1pf(__expf(x)); }

constexpr int PX_ST = 2064;
__device__ __forceinline__ void p0_prep_x(LAS unsigned char* lds, const float* x, const float* g1, const float* w_in, const float* A_log, const float* dt_bias, bf16_t* xb, float* gbf, float* rsx) {
    const int tid = threadIdx.x, wv = tid >> 6, l = tid & 63, c = l & 15, q = l >> 4;
    __syncthreads();
    for (int i = tid; i < 2048; i += NTHR) { const int k = i >> 1, j4 = (i & 1) * 4; const f32x4 g = *(const f32x4*)(w_in + (size_t)k * WIN_LD + 4096 + j4); const float gg = g1[k];
#pragma unroll
        for (int n = 0; n < 4; ++n) { const float w = g[n] * gg; const bf16_t hi = f2bf(w); *(LAS bf16_t*)(lds + (j4 + n) * PX_ST + k * 2) = hi; *(LAS bf16_t*)(lds + (8 + j4 + n) * PX_ST + k * 2) = f2bf(w - bf2f(hi)); } }
    if (tid < PX_ST / 16) *(LAS u32x4*)(lds + 16 * PX_ST + tid * 16) = (u32x4){0u, 0u, 0u, 0u};
    __syncthreads();
    const int ohi = (c < 8 ? c : 16) * PX_ST + 32 * q, olo = (c < 8 ? 8 + c : 16) * PX_ST + 32 * q;
    for (int tile = blockIdx.x * 8 + wv; tile * 16 < T; tile += gridDim.x * 8) {
        const int row = tile * 16 + c;
        const float* xr = x + (size_t)row * D + 16 * q;
        bf16_t* xo = xb + (size_t)row * D + 16 * q;
        f32x4 acc = (f32x4){0.f, 0.f, 0.f, 0.f}; float ss = 0.f;
#pragma unroll 8
        for (int j = 0; j < 16; ++j) {
            f32x4 a[4];
#pragma unroll
            for (int e = 0; e < 4; ++e) a[e] = *(const f32x4*)(xr + 64 * j + 4 * e);
#pragma unroll
            for (int e = 0; e < 4; ++e) ss += a[e][0] * a[e][0] + a[e][1] * a[e][1] + a[e][2] * a[e][2] + a[e][3] * a[e][3];
            u32x4 hi[2], lo[2];
#pragma unroll
            for (int s_ = 0; s_ < 2; ++s_) { const f32x4 p = a[2 * s_], r = a[2 * s_ + 1];
                hi[s_].x = cvt_pk_bf16(p[0], p[1]); hi[s_].y = cvt_pk_bf16(p[2], p[3]); hi[s_].z = cvt_pk_bf16(r[0], r[1]); hi[s_].w = cvt_pk_bf16(r[2], r[3]);
                lo[s_].x = cvt_pk_bf16(p[0] - bf_lo(hi[s_].x), p[1] - bf_hi(hi[s_].x)); lo[s_].y = cvt_pk_bf16(p[2] - bf_lo(hi[s_].y), p[3] - bf_hi(hi[s_].y));
                lo[s_].z = cvt_pk_bf16(r[0] - bf_lo(hi[s_].z), r[1] - bf_hi(hi[s_].z)); lo[s_].w = cvt_pk_bf16(r[2] - bf_lo(hi[s_].w), r[3] - bf_hi(hi[s_].w)); }
            *(u32x4*)(xo + 64 * j) = hi[0]; *(u32x4*)(xo + 64 * j + 8) = hi[1];
#pragma unroll
            for (int s_ = 0; s_ < 2; ++s_) { const bf16x8 ah = __builtin_bit_cast(bf16x8, hi[s_]), al = __builtin_bit_cast(bf16x8, lo[s_]);
                const bf16x8 bh = *(const LAS bf16x8*)(lds + ohi + 128 * j + 16 * s_), bl = *(const LAS bf16x8*)(lds + olo + 128 * j + 16 * s_);
                acc = mfma16(ah, bh, acc); acc = mfma16(ah, bl, acc); acc = mfma16(al, bh, acc); }
        }
        ss += __shfl_xor(ss, 16); ss += __shfl_xor(ss, 32);
        const float rstd = rsqrtf(ss * (1.0f / D) + EPS);
        if (q == 0) rsx[row] = rstd;
#pragma unroll
        for (int i = 0; i < 4; ++i) { const float rr = __shfl(rstd, 4 * q + i); const float v = acc[i] * rr;
            if (c < 8) { const int cj = c & 3; const float o = c < 4 ? sigmoidf_(v) : -__expf(A_log[cj]) * softplusf_(v + dt_bias[cj]);
                gbf[(size_t)prow_of(tile * 16 + 4 * q + i) * 8 + c] = o; } }
    }
    __syncthreads();
}
constexpr int META_CG = (WIN_LD + 127) / 128, META_WG = 2 * META_CG;
__device__ __forceinline__ void p0_meta(LAS unsigned char* lds, const float* meta, const float* g1, const float* w_in, float* mp) {
    LAS float* hn = (LAS float*)lds;
    LAS float* red = (LAS float*)lds;
    const int wv = threadIdx.x >> 6, l = threadIdx.x & 63;
    if (blockIdx.x < META_WG) {
        const int cg = blockIdx.x >> 1, kh = blockIdx.x & 1;
        __syncthreads();
        for (int r = wv; r < 16; r += 8) {
            const f32x4* xr = (const f32x4*)(meta + (size_t)r * D);
            f32x4 v[4]; float ss = 0.f;
#pragma unroll
            for (int i = 0; i < 4; ++i) { v[i] = xr[l + 64 * i]; ss += v[i][0] * v[i][0] + v[i][1] * v[i][1] + v[i][2] * v[i][2] + v[i][3] * v[i][3]; }
            ss = wave_sum(ss);
            const float rstd = rsqrtf(ss * (1.0f / D) + EPS);
#pragma unroll
            for (int i = 0; i < 4; ++i) { const f32x4 gv = ((const f32x4*)g1)[l + 64 * i];
#pragma unroll
                for (int c = 0; c < 4; ++c) hn[(4 * (l + 64 * i) + c) * 16 + r] = v[i][c] * rstd * gv[c]; }
        }
        __syncthreads();
        const int cl = threadIdx.x & 31, kg = threadIdx.x >> 5;
        const int n0 = cg * 128 + 4 * cl, ncl = n0 < WIN_LD ? n0 : 0, kbase = 512 * kh + 32 * kg;
        f32x4 acc[16];
#pragma unroll
        for (int i = 0; i < 16; ++i) acc[i] = (f32x4){0.f, 0.f, 0.f, 0.f};
#pragma unroll 1
        for (int kb = 0; kb < 2; ++kb) {
            f32x4 wq[16];
            const float* wrow = w_in + (size_t)(kbase + kb * 16) * WIN_LD + ncl;
#pragma unroll
            for (int kk = 0; kk < 16; ++kk) wq[kk] = *(const f32x4*)(wrow + (size_t)kk * WIN_LD);
            const LAS float* hrow = hn + (kbase + kb * 16) * 16;
#pragma unroll
            for (int kk = 0; kk < 16; ++kk) {
#pragma unroll
                for (int i4 = 0; i4 < 4; ++i4) { const f32x4 h = *(const LAS f32x4*)&hrow[kk * 16 + 4 * i4]; acc[4 * i4] += wq[kk] * h[0]; acc[4 * i4 + 1] += wq[kk] * h[1]; acc[4 * i4 + 2] += wq[kk] * h[2]; acc[4 * i4 + 3] += wq[kk] * h[3]; } } }
        __syncthreads();
#pragma unroll
        for (int i = 0; i < 16; ++i)
#pragma unroll
            for (int cc = 0; cc < 4; ++cc) red[(kg * 128 + 4 * cl + cc) * 17 + i] = acc[i][cc];
        __syncthreads();
#pragma unroll 1
        for (int e = 0; e < 4; ++e) { const int o = threadIdx.x + NTHR * e, i = o >> 7, col = o & 127;
          float v = 0.f;
#pragma unroll
          for (int g = 0; g < 16; ++g) v += red[(g * 128 + col) * 17 + i];
          const int n = cg * 128 + col;
          if (n < WIN_LD) mp[((size_t)kh * 16 + i) * WIN_LD + n] = v; }
        __syncthreads();
    }
}
__device__ __forceinline__ void meta_finalize(const float* mp, const float* lbl, const float* A_log, const float* dt_bias, bf16_t* proj, float* gbf) {
    for (int o = blockIdx.x * NTHR + threadIdx.x; o < 16 * WIN_LD; o += gridDim.x * NTHR) { const int i = o / WIN_LD, n = o % WIN_LD;
        float v = mp[(size_t)i * WIN_LD + n] + mp[(size_t)(16 + i) * WIN_LD + n];
        if (n < 4096 || n >= 4104) {
            const int pc = n < 4096 ? n : n - 8, seg = pc >> 9;
            if (seg == 0 || seg == 3 || seg == 7) v = siluf_(v);
            else if (seg == 1) { const float a = lbl[pc - C_LF], bq = lbl[512 + pc - C_LF]; const float m = fmaxf(a, bq); const float ea = __expf(a - m), eb = __expf(bq - m); const float lb = ea / (ea + eb); v = __logf(lb + (1.0f - lb) * sigmoidf_(v)); }
            const bf16_t ob = f2bf(v);
            for (int b = 0; b < NB; ++b) proj[(size_t)(b * LP + 48 + i) * NPROJ + pc] = ob;
        } else {
            const int j = n - 4096;
            const float ov = j < 4 ? sigmoidf_(v) : -__expf(A_log[j - 4]) * softplusf_(v + dt_bias[j - 4]);
            for (int b = 0; b < NB; ++b) gbf[(size_t)(b * LP + 48 + i) * 8 + j] = ov;
        } }
}
__device__ __forceinline__ void p0_zero(bf16_t* proj, float* gbf) {
    for (size_t i = (size_t)blockIdx.x * NTHR + threadIdx.x; i < (size_t)NB * 48 * (NPROJ / 8); i += (size_t)gridDim.x * NTHR) {
        const int b = (int)(i / (48 * (NPROJ / 8))), rem = (int)(i % (48 * (NPROJ / 8))), r = rem / (NPROJ / 8), c8 = rem % (NPROJ / 8);
        *(u32x4*)(proj + (size_t)(b * LP + r) * NPROJ + c8 * 8) = (u32x4){0u, 0u, 0u, 0u};
    }
    for (int i = blockIdx.x * NTHR + threadIdx.x; i < NB * 48 * 8; i += gridDim.x * NTHR) { const int b = i / (48 * 8), rem = i % (48 * 8); gbf[(size_t)(b * LP) * 8 + rem] = 0.f; }
}

constexpr int HG_QDP = 0, HG_QS = 17408, HG_KS = 34816, HG_KHT = 52224, HG_VT = 70656, HG_AT = 89088, HG_SEG = 98304, HG_DEND = 102400, HG_PART = 102912;
constexpr int RS_K = 272, RS_T = 144;
__device__ __forceinline__ int kperm(int k) { const int w = k & 31; return (k & ~31) + 8 * ((w >> 2) & 3) + 4 * (w >> 4) + (w & 3); }
__device__ __forceinline__ bf16x8 pack8(const f32x4& lo, const f32x4& hi) {
    u32x4 p; p.x = cvt_pk_bf16(lo[0], lo[1]); p.y = cvt_pk_bf16(lo[2], lo[3]); p.z = cvt_pk_bf16(hi[0], hi[1]); p.w = cvt_pk_bf16(hi[2], hi[3]);
    return __builtin_bit_cast(bf16x8, p);
}
__device__ __forceinline__ float expc(float x) { return __expf(fminf(x, 80.0f)); }

template <bool OUT>
__device__ __forceinline__ void hgrn_run(LAS unsigned char* lds, bf16_t* proj, float* arun, float* drun, const float* gn, int item, bf16_t* oa) {
    const int tid = threadIdx.x, w = tid >> 6, lane = tid & 63, c = lane & 15, q = lane >> 4;
    const int bh = item >> 4, run = item & 15, b = bh >> 2, h = bh & 3;
    const int ch0 = run == 0 ? 0 : 9 + 8 * (run - 1), nc = run == 0 ? 9 : 8;
    LAS float* seg = (LAS float*)(lds + HG_SEG); LAS float* dend = (LAS float*)(lds + HG_DEND); LAS float* part = (LAS float*)(lds + HG_PART);
    f32x4 Sacc[8];
#pragma unroll
    for (int kt = 0; kt < 8; ++kt) Sacc[kt] = (f32x4){0.f, 0.f, 0.f, 0.f};
    if (OUT) {
        for (int m = 0; m < run; ++m) { const int im = bh * 16 + m;
#pragma unroll
            for (int kt = 0; kt < 8; ++kt) { const f32x4 d4 = *(const f32x4*)(drun + (size_t)im * 128 + 16 * kt + 4 * q); const f32x4 a4 = *(const f32x4*)(arun + (((size_t)im * 8 + w) * 8 + kt) * 256 + lane * 4); Sacc[kt] = Sacc[kt] * d4 + a4; } }
    }
    float dp = 1.0f;
    const int col = 2 * lane, sg = w;
    const f32x4 gnv = OUT ? *(const f32x4*)(gn + 16 * w + 4 * q) : (f32x4){0.f, 0.f, 0.f, 0.f};
    unsigned lfw[8], qw[8], vw[8];
#define HG_LOAD(ci_) do { const bf16_t* base_ = proj + (size_t)(b * LP + (ch0 + (ci_)) * 64 + 8 * sg) * NPROJ + h * 128 + col; \
        _Pragma("unroll") for (int j = 0; j < 8; ++j) { lfw[j] = *(const unsigned*)(base_ + (size_t)j * NPROJ + C_LF); vw[j] = *(const unsigned*)(base_ + (size_t)j * NPROJ + C_VA); qw[j] = OUT ? *(const unsigned*)(base_ + (size_t)j * NPROJ + C_QA) : 0u; } } while (0)
    HG_LOAD(0);
    for (int ci = 0; ci < nc; ++ci) {
        const int r0 = b * LP + (ch0 + ci) * 64;
        __syncthreads();
        u32x2 gwp[4];
        if (OUT) {
#pragma unroll
            for (int tt = 0; tt < 4; ++tt) gwp[tt] = *(const u32x2*)(proj + (size_t)(r0 + 16 * tt + c) * NPROJ + h * 128 + 16 * w + 4 * q + C_HG);
        }
        float cs0[8], cs1[8]; { float s0 = 0.f, s1 = 0.f;
#pragma unroll
            for (int j = 0; j < 8; ++j) { s0 += bf_lo(lfw[j]); cs0[j] = s0; s1 += bf_hi(lfw[j]); cs1[j] = s1; }
            seg[sg * 128 + col] = s0; seg[sg * 128 + col + 1] = s1; }
        __syncthreads();
        float base0 = 0.f, base1 = 0.f, bend0 = 0.f, bend1 = 0.f, bref0 = 0.f, bref1 = 0.f;
#pragma unroll
        for (int g = 0; g < 8; ++g) { const float a0 = seg[g * 128 + col], a1 = seg[g * 128 + col + 1]; if (g < sg) { base0 += a0; base1 += a1; } if (g < 4) { bref0 += a0; bref1 += a1; } bend0 += a0; bend1 += a1; }
        unsigned khw0[4], khw1[4];
        float kh0p = 0.f, kh1p = 0.f;
#pragma unroll
        for (int j = 0; j < 8; ++j) {
            const int t = 8 * sg + j;
            const float b0 = base0 + cs0[j], b1 = base1 + cs1[j];
            const float kk0 = 1.0f - __expf(bf_lo(lfw[j])), kk1 = 1.0f - __expf(bf_hi(lfw[j]));
            const float kh0 = kk0 * __expf(bend0 - b0), kh1 = kk1 * __expf(bend1 - b1);
            if (j & 1) { khw0[j >> 1] = cvt_pk_bf16(kh0p, kh0); khw1[j >> 1] = cvt_pk_bf16(kh1p, kh1); } else { kh0p = kh0; kh1p = kh1; }
            if (OUT) {
                const float q0 = bf_lo(qw[j]), q1 = bf_hi(qw[j]);
                *(LAS unsigned*)(lds + HG_QDP + t * RS_K + kperm(col) * 2) = cvt_pk_bf16(q0 * __expf(b0), q1 * __expf(b1));
                *(LAS unsigned*)(lds + HG_QS + t * RS_K + col * 2) = cvt_pk_bf16(q0 * expc(b0 - bref0), q1 * expc(b1 - bref1));
                *(LAS unsigned*)(lds + HG_KS + t * RS_K + col * 2) = cvt_pk_bf16(kk0 * expc(bref0 - b0), kk1 * expc(bref1 - b1));
            }
        }
        *(LAS u32x4*)(lds + HG_KHT + col * RS_T + 16 * sg) = (u32x4){khw0[0], khw0[1], khw0[2], khw0[3]};
        *(LAS u32x4*)(lds + HG_KHT + (col + 1) * RS_T + 16 * sg) = (u32x4){khw1[0], khw1[1], khw1[2], khw1[3]};
        { u32x4 v0, v1;
          v0.x = (vw[0] & 0xffffu) | (vw[1] << 16); v0.y = (vw[2] & 0xffffu) | (vw[3] << 16); v0.z = (vw[4] & 0xffffu) | (vw[5] << 16); v0.w = (vw[6] & 0xffffu) | (vw[7] << 16);
          v1.x = (vw[0] >> 16) | (vw[1] & 0xffff0000u); v1.y = (vw[2] >> 16) | (vw[3] & 0xffff0000u); v1.z = (vw[4] >> 16) | (vw[5] & 0xffff0000u); v1.w = (vw[6] >> 16) | (vw[7] & 0xffff0000u);
          *(LAS u32x4*)(lds + HG_VT + col * RS_T + 16 * sg) = v0; *(LAS u32x4*)(lds + HG_VT + (col + 1) * RS_T + 16 * sg) = v1; }
        if (sg == 7) { dend[col] = __expf(bend0); dend[col + 1] = __expf(bend1); }
        if (ci + 1 < nc) HG_LOAD(ci + 1);
        __syncthreads();
        if (!OUT) { if (tid < 128) dp *= dend[tid]; }
        if (OUT) {
#pragma unroll
            for (int rep = 0; rep < 2; ++rep) { const int id = w + 8 * rep, st = id >> 2, tt = id & 3;
                f32x4 acc = (f32x4){0.f, 0.f, 0.f, 0.f};
                if (st <= tt) {
#pragma unroll
                    for (int ks = 0; ks < 4; ++ks) { const bf16x8 a = *(const LAS bf16x8*)(lds + HG_KS + (16 * st + c) * RS_K + (32 * ks + 8 * q) * 2); const bf16x8 bq = *(const LAS bf16x8*)(lds + HG_QS + (16 * tt + c) * RS_K + (32 * ks + 8 * q) * 2); acc = mfma16(a, bq, acc); }
                }
                const int tq = 16 * tt + c, s0 = 16 * st + 4 * q;
                u32x2 o; o.x = cvt_pk_bf16(s0 <= tq ? acc[0] : 0.f, s0 + 1 <= tq ? acc[1] : 0.f); o.y = cvt_pk_bf16(s0 + 2 <= tq ? acc[2] : 0.f, s0 + 3 <= tq ? acc[3] : 0.f);
                *(LAS u32x2*)(lds + HG_AT + tq * RS_T + s0 * 2) = o; }
            __syncthreads();
            f32x4 oacc[4];
#pragma unroll
            for (int tt = 0; tt < 4; ++tt) oacc[tt] = (f32x4){0.f, 0.f, 0.f, 0.f};
#pragma unroll
            for (int ks = 0; ks < 4; ++ks) { const bf16x8 a = pack8(Sacc[2 * ks], Sacc[2 * ks + 1]);
#pragma unroll
                for (int tt = 0; tt < 4; ++tt) { const bf16x8 bq = *(const LAS bf16x8*)(lds + HG_QDP + (16 * tt + c) * RS_K + (32 * ks + 8 * q) * 2); oacc[tt] = mfma16(a, bq, oacc[tt]); } }
#pragma unroll
            for (int ss = 0; ss < 2; ++ss) { const bf16x8 a = *(const LAS bf16x8*)(lds + HG_VT + (16 * w + c) * RS_T + (32 * ss + 8 * q) * 2);
#pragma unroll
                for (int tt = 0; tt < 4; ++tt) { const bf16x8 bq = *(const LAS bf16x8*)(lds + HG_AT + (16 * tt + c) * RS_T + (32 * ss + 8 * q) * 2); oacc[tt] = mfma16(a, bq, oacc[tt]); } }
            float pn_[4];
#pragma unroll
            for (int tt = 0; tt < 4; ++tt) pn_[tt] = oacc[tt][0] * oacc[tt][0] + oacc[tt][1] * oacc[tt][1] + oacc[tt][2] * oacc[tt][2] + oacc[tt][3] * oacc[tt][3];
#pragma unroll
            for (int tt = 0; tt < 4; ++tt) pn_[tt] += __shfl_xor(pn_[tt], 16);
#pragma unroll
            for (int tt = 0; tt < 4; ++tt) pn_[tt] += __shfl_xor(pn_[tt], 32);
            if (q == 0) {
#pragma unroll
                for (int tt = 0; tt < 4; ++tt) part[w * 64 + 16 * tt + c] = pn_[tt]; }
            __syncthreads();
#pragma unroll
            for (int tt = 0; tt < 4; ++tt) { float tot = 0.f;
#pragma unroll
                for (int ww = 0; ww < 8; ++ww) tot += part[ww * 64 + 16 * tt + c];
                const float rstd = rsqrtf(tot * (1.0f / 128.0f) + EPS);
                bf16_t* rp = proj + (size_t)(r0 + 16 * tt + c) * NPROJ + h * 128 + 16 * w + 4 * q;
                const u32x2 gw = gwp[tt];
                u32x2 o; o.x = cvt_pk_bf16(oacc[tt][0] * rstd * gnv[0] * bf_lo(gw.x), oacc[tt][1] * rstd * gnv[1] * bf_hi(gw.x));
                o.y = cvt_pk_bf16(oacc[tt][2] * rstd * gnv[2] * bf_lo(gw.y), oacc[tt][3] * rstd * gnv[3] * bf_hi(gw.y));
                if (ch0 + ci >= 1) *(u32x2*)(oa + (size_t)(b * SEQ + (ch0 + ci - 1) * 64 + 16 * tt + c) * 512 + h * 128 + 16 * w + 4 * q) = o; }
        }
#pragma unroll
        for (int kt = 0; kt < 8; ++kt) { const f32x4 d4 = *(const LAS f32x4*)(dend + 16 * kt + 4 * q); Sacc[kt] = Sacc[kt] * d4;
#pragma unroll
            for (int ts = 0; ts < 2; ++ts) { const bf16x8 a = *(const LAS bf16x8*)(lds + HG_KHT + (16 * kt + c) * RS_T + (32 * ts + 8 * q) * 2); const bf16x8 bq = *(const LAS bf16x8*)(lds + HG_VT + (16 * w + c) * RS_T + (32 * ts + 8 * q) * 2); Sacc[kt] = mfma16(a, bq, Sacc[kt]); } }
    }
    if (!OUT) {
#pragma unroll
        for (int kt = 0; kt < 8; ++kt) *(f32x4*)(arun + (((size_t)item * 8 + w) * 8 + kt) * 256 + lane * 4) = Sacc[kt];
        if (tid < 128) drun[(size_t)item * 128 + tid] = dp;
    }
    __syncthreads();
#undef HG_LOAD
}


constexpr int GB_KN = 0, GB_QN = 17408, GB_RTK = 34816, GB_RTV = 53248, GB_TM = 71680, GB_LM = 80896, GB_TF = 98304, GB_XS = 115712, LST = 68;
constexpr int GD_NITEM = NB * 129 * 4;
struct GdnBufs { bf16_t* QT; bf16_t* AT; bf16_t* WP; bf16_t* U0T; bf16_t* KHT; float* GEND; };

__device__ __forceinline__ void head_norm_store(f32x4 (&oacc)[4], LAS float* part, bf16_t* proj, int r0, int h, int cgate, int cout, const float* gn, int w, int c, int q) {
#pragma unroll
    for (int tt = 0; tt < 4; ++tt) { float p = oacc[tt][0] * oacc[tt][0] + oacc[tt][1] * oacc[tt][1] + oacc[tt][2] * oacc[tt][2] + oacc[tt][3] * oacc[tt][3];
        p += __shfl_xor(p, 16); p += __shfl_xor(p, 32); if (q == 0) part[w * 64 + 16 * tt + c] = p; }
    __syncthreads();
    const f32x4 gnv = *(const f32x4*)(gn + 16 * w + 4 * q);
#pragma unroll
    for (int tt = 0; tt < 4; ++tt) { float tot = 0.f;
#pragma unroll
        for (int ww = 0; ww < 8; ++ww) tot += part[ww * 64 + 16 * tt + c];
        const float rstd = rsqrtf(tot * (1.0f / 128.0f) + EPS);
        bf16_t* rp = proj + (size_t)(r0 + 16 * tt + c) * NPROJ + h * 128 + 16 * w + 4 * q;
        const u32x2 gw = *(const u32x2*)(rp + cgate);
        u32x2 o; o.x = cvt_pk_bf16(oacc[tt][0] * rstd * gnv[0] * bf_lo(gw.x), oacc[tt][1] * rstd * gnv[1] * bf_hi(gw.x));
        o.y = cvt_pk_bf16(oacc[tt][2] * rstd * gnv[2] * bf_lo(gw.y), oacc[tt][3] * rstd * gnv[3] * bf_hi(gw.y));
        *(u32x2*)(rp + cout) = o; }
}

constexpr int GB_CW = 118784;
struct GdnBRegs { unsigned xq[11], xk[11], xv[11]; float Gl, betal; };
__device__ __forceinline__ void gdn_phaseB_load(GdnBRegs& R, const bf16_t* proj, const float* gbf, int item, int tid) {
    const int sg = __builtin_amdgcn_readfirstlane(tid >> 6), lane = tid & 63, col = 2 * lane;
    const int h = item & 3, bc = item >> 2, b = bc / 129, ch = bc % 129, r0 = b * LP + ch * 64;
    R.Gl = gbf[(size_t)(r0 + lane) * 8 + 4 + h]; R.betal = gbf[(size_t)(r0 + lane) * 8 + h];
#pragma unroll
    for (int i = 0; i < 11; ++i) { const int pp = ch * 64 + 8 * sg - 3 + i;
        if (pp >= 48) { const bf16_t* rp = proj + (size_t)(b * LP + pp) * NPROJ + h * 128 + col; R.xq[i] = *(const unsigned*)(rp + C_GQ); R.xk[i] = *(const unsigned*)(rp + C_GK); R.xv[i] = *(const unsigned*)(rp + C_GV); }
        else { R.xq[i] = 0u; R.xk[i] = 0u; R.xv[i] = 0u; } }
}

__device__ __forceinline__ int gdn_phaseB(LAS unsigned char* lds, const bf16_t* proj, const float* gbf, const GdnBufs& G, int item, GdnBRegs& R, unsigned* q2, unsigned& tk) {
    int tid_ = threadIdx.x; asm volatile("" : "+v"(tid_));
    const int tid = tid_, w = __builtin_amdgcn_readfirstlane(tid >> 6), lane = tid & 63, c = lane & 15, q = lane >> 4;
    const int h = item & 3, bc = item >> 2, b = bc / 129, ch = bc % 129;
    const int r0 = b * LP + ch * 64;
    const int col = 2 * lane, sg = w;
    LAS float* Lm = (LAS float*)(lds + GB_LM);
    LAS int* qit = (LAS int*)(lds + LDS_BYTES - 64);
    __syncthreads();
    LAS unsigned long long* tsq = (LAS unsigned long long*)(lds + LDS_BYTES - 256);
    unsigned long long tq0 = 0; if (PROBE_PH >= 0 && blockIdx.x == 0 && tid == 0) tq0 = __builtin_amdgcn_s_memrealtime();
    float Gl = R.Gl; const float betal = R.betal;
    Gl = wave_incl_scan(Gl);
    const float Gend = __builtin_bit_cast(float, __builtin_amdgcn_readlane(__builtin_bit_cast(int, Gl), 63));
    float cq[4][2], ck[4][2], cv[4][2];
#pragma unroll
    for (int j = 0; j < 4; ++j) { const LAS float* p = (const LAS float*)(lds + GB_CW) + j * 1536 + h * 128 + col; const f32x2_t a = *(const LAS f32x2_t*)p, bq = *(const LAS f32x2_t*)(p + 512), cc = *(const LAS f32x2_t*)(p + 1024);
        cq[j][0] = a[0]; cq[j][1] = a[1]; ck[j][0] = bq[0]; ck[j][1] = bq[1]; cv[j][0] = cc[0]; cv[j][1] = cc[1]; }
    unsigned xq[11], xk[11], xv[11];
#pragma unroll
    for (int i = 0; i < 11; ++i) { xq[i] = R.xq[i]; xk[i] = R.xk[i]; xv[i] = R.xv[i]; }
    unsigned rtk0[4], rtk1[4], rtv0[4], rtv1[4], kh0[4], kh1[4];
    float pk0 = 0.f, pk1 = 0.f, pv0 = 0.f, pv1 = 0.f, ph0 = 0.f, ph1 = 0.f;
    bf16_t* qt = G.QT + (size_t)item * 8192;
#pragma unroll
    for (int j = 0; j < 8; ++j) {
        const int t = 8 * sg + j;
        float q0 = 0.f, q1 = 0.f, k0 = 0.f, k1 = 0.f, v0 = 0.f, v1 = 0.f;
#pragma unroll
        for (int jj = 0; jj < 4; ++jj) { q0 += cq[jj][0] * bf_lo(xq[j + jj]); q1 += cq[jj][1] * bf_hi(xq[j + jj]); k0 += ck[jj][0] * bf_lo(xk[j + jj]); k1 += ck[jj][1] * bf_hi(xk[j + jj]); v0 += cv[jj][0] * bf_lo(xv[j + jj]); v1 += cv[jj][1] * bf_hi(xv[j + jj]); }
        q0 = siluf_(q0); q1 = siluf_(q1); k0 = siluf_(k0); k1 = siluf_(k1); v0 = siluf_(v0); v1 = siluf_(v1);
        const float sq = rsqrtf(wave_sum(q0 * q0 + q1 * q1) + EPS) * 0.08838834764831845f, sk = rsqrtf(wave_sum(k0 * k0 + k1 * k1) + EPS);
        q0 *= sq; q1 *= sq; k0 *= sk; k1 *= sk;
        const float Gt = __builtin_bit_cast(float, __builtin_amdgcn_readlane(__builtin_bit_cast(int, Gl), t)), bt = __builtin_bit_cast(float, __builtin_amdgcn_readlane(__builtin_bit_cast(int, betal), t));
        const float eg = __expf(Gt), eh = __expf(Gend - Gt);
        *(LAS unsigned*)(lds + GB_KN + t * RS_K + col * 2) = cvt_pk_bf16(k0, k1);
        *(LAS unsigned*)(lds + GB_QN + t * RS_K + col * 2) = cvt_pk_bf16(q0, q1);
        *(unsigned*)(qt + t * 128 + kperm(col)) = cvt_pk_bf16(q0 * eg, q1 * eg);
        const float rk0 = bt * eg * k0, rk1 = bt * eg * k1, rv0 = bt * v0, rv1 = bt * v1, h0 = k0 * eh, h1 = k1 * eh;
        if (j & 1) { rtk0[j >> 1] = cvt_pk_bf16(pk0, rk0); rtk1[j >> 1] = cvt_pk_bf16(pk1, rk1); rtv0[j >> 1] = cvt_pk_bf16(pv0, rv0); rtv1[j >> 1] = cvt_pk_bf16(pv1, rv1); kh0[j >> 1] = cvt_pk_bf16(ph0, h0); kh1[j >> 1] = cvt_pk_bf16(ph1, h1); }
        else { pk0 = rk0; pk1 = rk1; pv0 = rv0; pv1 = rv1; ph0 = h0; ph1 = h1; }
    }
    *(LAS u32x4*)(lds + GB_RTK + col * RS_T + 16 * sg) = (u32x4){rtk0[0], rtk0[1], rtk0[2], rtk0[3]};
    *(LAS u32x4*)(lds + GB_RTK + (col + 1) * RS_T + 16 * sg) = (u32x4){rtk1[0], rtk1[1], rtk1[2], rtk1[3]};
    *(LAS u32x4*)(lds + GB_RTV + col * RS_T + 16 * sg) = (u32x4){rtv0[0], rtv0[1], rtv0[2], rtv0[3]};
    *(LAS u32x4*)(lds + GB_RTV + (col + 1) * RS_T + 16 * sg) = (u32x4){rtv1[0], rtv1[1], rtv1[2], rtv1[3]};
    {
      const int pbase = 32 * (sg >> 2) + 16 * (sg & 1) + 4 * ((sg & 3) >> 1);
      bf16_t* kp = G.KHT + (size_t)item * 8192;
      *(u32x2*)(kp + col * 64 + pbase) = (u32x2){kh0[0], kh0[1]}; *(u32x2*)(kp + col * 64 + pbase + 8) = (u32x2){kh0[2], kh0[3]};
      *(u32x2*)(kp + (col + 1) * 64 + pbase) = (u32x2){kh1[0], kh1[1]}; *(u32x2*)(kp + (col + 1) * 64 + pbase + 8) = (u32x2){kh1[2], kh1[3]}; }
    if (tid == 0) { G.GEND[item] = Gend; qit[1] = (int)tk; }
    __syncthreads();
    const int nxt = qit[1];
    if (tid == 0) tk = atomicAdd(q2, 1u);
    if (nxt < GD_NITEM) gdn_phaseB_load(R, proj, gbf, nxt, tid);
    if (PROBE_PH >= 0 && blockIdx.x == 0 && tid == 0) { const unsigned long long t_ = __builtin_amdgcn_s_memrealtime(); tsq[14] += t_ - tq0; tq0 = t_; }
#pragma unroll
    for (int rep = 0; rep < 2; ++rep) { const int id = w + 8 * rep;
        if (id < 10) { int st, tt; if (id < 4) { st = 0; tt = id; } else if (id < 7) { st = 1; tt = id - 3; } else if (id < 9) { st = 2; tt = id - 5; } else { st = 3; tt = 3; }
            f32x4 acc = (f32x4){0.f, 0.f, 0.f, 0.f};
#pragma unroll
            for (int ks = 0; ks < 4; ++ks) { const bf16x8 a = *(const LAS bf16x8*)(lds + GB_KN + (16 * st + c) * RS_K + (32 * ks + 8 * q) * 2); const bf16x8 bq = *(const LAS bf16x8*)(lds + GB_KN + (16 * tt + c) * RS_K + (32 * ks + 8 * q) * 2); acc = mfma16(a, bq, acc); }
            const int tq = 16 * tt + c, s0 = 16 * st + 4 * q;
            const float Gt = __shfl(Gl, tq), bt = __shfl(betal, tq);
            f32x4 o;
#pragma unroll
            for (int i = 0; i < 4; ++i) { const float Gs = __shfl(Gl, s0 + i); o[i] = bt * __expf(fminf(Gt - Gs, 0.f)) * acc[i]; }
            *(LAS f32x4*)(Lm + tq * LST + s0) = o; } }
    __syncthreads();
    if (PROBE_PH >= 0 && blockIdx.x == 0 && tid == 0) tq0 = __builtin_amdgcn_s_memrealtime();
    LAS float* Tf = (LAS float*)(lds + GB_TF); LAS float* Xs = (LAS float*)(lds + GB_XS);
    if (w == 0) {
        const int bb = lane >> 4, cl = lane & 15;
        f32x4 lr[16][4];
#pragma unroll
        for (int i = 1; i < 16; ++i)
#pragma unroll
            for (int j = 0; j < i; j += 4) lr[i][j >> 2] = *(const LAS f32x4*)(Lm + (16 * bb + i) * LST + 16 * bb + j);
        float Dc[16];
#pragma unroll
        for (int i = 0; i < 16; ++i) { float acc = (i == cl) ? 1.0f : 0.0f;
#pragma unroll
            for (int j = 0; j < i; ++j) acc -= lr[i][j >> 2][j & 3] * Dc[j];
            Dc[i] = acc; }
#pragma unroll
        for (int i = 0; i < 16; ++i) Tf[(16 * bb + i) * LST + 16 * bb + cl] = Dc[i];
    } else {
        bf16_t* at = G.AT + (size_t)item * 4096;
        for (int id = w - 1; id < 16; id += 7) { const int st = id >> 2, tt = id & 3;
            f32x4 acc = (f32x4){0.f, 0.f, 0.f, 0.f};
            if (st <= tt) {
#pragma unroll
                for (int ks = 0; ks < 4; ++ks) { const bf16x8 a = *(const LAS bf16x8*)(lds + GB_KN + (16 * st + c) * RS_K + (32 * ks + 8 * q) * 2); const bf16x8 bq = *(const LAS bf16x8*)(lds + GB_QN + (16 * tt + c) * RS_K + (32 * ks + 8 * q) * 2); acc = mfma16(a, bq, acc); } }
            const int tq = 16 * tt + c, s0 = 16 * st + 4 * q;
            const float Gt = __shfl(Gl, tq);
            float o[4];
#pragma unroll
            for (int i = 0; i < 4; ++i) { const float Gs = __shfl(Gl, s0 + i); o[i] = (s0 + i <= tq) ? __expf(fminf(Gt - Gs, 0.f)) * acc[i] : 0.f; }
            *(u32x2*)(at + tq * 64 + 32 * (st >> 1) + 8 * q + 4 * (st & 1)) = (u32x2){cvt_pk_bf16(o[0], o[1]), cvt_pk_bf16(o[2], o[3])}; }
    }
    __syncthreads();
#pragma unroll
    for (int d = 1; d < 4; ++d) {
        if (w < 4 - d) { const int I = w + d, J = w;
            f32x4 X = (f32x4){0.f, 0.f, 0.f, 0.f};
            for (int M = J; M < I; ++M) {
#pragma unroll
                for (int m = 0; m < 4; ++m) X = __builtin_amdgcn_mfma_f32_16x16x4f32(Lm[(16 * I + c) * LST + 16 * M + 4 * m + q], Tf[(16 * M + 4 * m + q) * LST + 16 * J + c], X, 0, 0, 0); }
#pragma unroll
            for (int i = 0; i < 4; ++i) Xs[w * 256 + (4 * q + i) * 16 + c] = X[i];
            f32x4 Tb = (f32x4){0.f, 0.f, 0.f, 0.f};
#pragma unroll
            for (int m = 0; m < 4; ++m) Tb = __builtin_amdgcn_mfma_f32_16x16x4f32(Tf[(16 * I + c) * LST + 16 * I + 4 * m + q], Xs[w * 256 + (4 * m + q) * 16 + c], Tb, 0, 0, 0);
#pragma unroll
            for (int i = 0; i < 4; ++i) Tf[(16 * I + 4 * q + i) * LST + 16 * J + c] = -Tb[i]; }
        __syncthreads();
    }
    {
      const int row = tid >> 3, c8 = (tid & 7) * 8;
      f32x4 t0 = *(const LAS f32x4*)(Tf + row * LST + c8), t1 = *(const LAS f32x4*)(Tf + row * LST + c8 + 4);
      if ((c8 >> 4) > (row >> 4)) { t0 = (f32x4){0.f, 0.f, 0.f, 0.f}; t1 = t0; }
      *(LAS u32x4*)(lds + GB_TM + row * RS_T + c8 * 2) = (u32x4){cvt_pk_bf16(t0[0], t0[1]), cvt_pk_bf16(t0[2], t0[3]), cvt_pk_bf16(t1[0], t1[1]), cvt_pk_bf16(t1[2], t1[3])}; }
    __syncthreads();
    if (PROBE_PH >= 0 && blockIdx.x == 0 && tid == 0) tsq[15] += __builtin_amdgcn_s_memrealtime() - tq0;
    { bf16_t* wp = G.WP + (size_t)item * 8192; bf16_t* u0 = G.U0T + (size_t)item * 8192;
#pragma unroll
      for (int tt = 0; tt < 4; ++tt) {
          f32x4 aw = (f32x4){0.f, 0.f, 0.f, 0.f}, au = (f32x4){0.f, 0.f, 0.f, 0.f};
#pragma unroll
          for (int ss = 0; ss < 2; ++ss) { if (ss == 1 && tt < 2) continue;
              const bf16x8 tb = *(const LAS bf16x8*)(lds + GB_TM + (16 * tt + c) * RS_T + (32 * ss + 8 * q) * 2);
              const bf16x8 ak = *(const LAS bf16x8*)(lds + GB_RTK + (16 * w + c) * RS_T + (32 * ss + 8 * q) * 2);
              const bf16x8 bv = *(const LAS bf16x8*)(lds + GB_RTV + (16 * w + c) * RS_T + (32 * ss + 8 * q) * 2);
              aw = mfma16(ak, tb, aw);
              au = mfma16(tb, bv, au); }
          *(u32x2*)(wp + (16 * tt + c) * 128 + 32 * (w >> 1) + 8 * q + 4 * (w & 1)) = (u32x2){cvt_pk_bf16(aw[0], aw[1]), cvt_pk_bf16(aw[2], aw[3])};
          *(u32x2*)(u0 + (16 * w + c) * 64 + 32 * (tt >> 1) + 8 * q + 4 * (tt & 1)) = (u32x2){cvt_pk_bf16(au[0], au[1]), cvt_pk_bf16(au[2], au[3])}; } }
    return nxt;
}

__device__ __forceinline__ bf16_t* snt_ptr(bf16_t* proj, int r0, int h, int v) { return proj + (size_t)(r0 + (v & 63)) * NPROJ + (v < 64 ? C_GQ : C_GK) + h * 128; }

__device__ __forceinline__ void gdn_scan(LAS unsigned char* lds, bf16_t* proj, const GdnBufs& G, int unit) {
    const int tid = threadIdx.x, w = __builtin_amdgcn_readfirstlane(tid >> 6), lane = tid & 63, c = lane & 15, q = lane >> 4;
    const int bh = unit >> 3, slice = unit & 7, b = bh >> 2, h = bh & 3;
    constexpr int SLOT = 32768, OW = 0, OK_ = 16384, OU = 3 * SLOT, OATAB = OU + 6 * 2048, OFLAG = OATAB + 1024;
    const int item0 = (b * 129) * 4 + h;
    LAS float* atab = (LAS float*)(lds + OATAB);
    volatile LAS unsigned* rdy = (volatile LAS unsigned*)(lds + OFLAG);
    volatile LAS unsigned* prog = (volatile LAS unsigned*)(lds + OFLAG + 64);
    __syncthreads();
    if (tid < 129) atab[tid] = __expf(G.GEND[item0 + 4 * tid]);
    if (tid < 16) rdy[tid] = 0u; if (tid >= 16 && tid < 20) prog[tid - 16] = 0u;
    asm volatile("s_waitcnt vmcnt(0) lgkmcnt(0)" ::: "memory");
    __syncthreads();
    if (w >= 4) {
        const int j = w - 4;
        u32x4 R[32];
#define GS_LD(m_) do { const int it_ = item0 + 4 * (m_); const char* wp_ = (const char*)(G.WP + (size_t)it_ * 8192); const char* kp_ = (const char*)(G.KHT + (size_t)it_ * 8192); const char* up_ = (const char*)(G.U0T + (size_t)it_ * 8192) + slice * 2048; \
        _Pragma("unroll") for (int i = 0; i < 16; ++i) { const int rw = 4 * i + (lane >> 4); R[i] = *(const u32x4*)(wp_ + rw * 256 + (((lane & 15) ^ (rw & 15)) << 4)); \
            const int rk = 8 * i + (lane >> 3); R[16 + i] = *(const u32x4*)(kp_ + rk * 128 + (((lane & 7) ^ (rk & 7)) << 4)); } \
        LAS unsigned char* ud_ = lds + OU + ((m_) % 6) * 2048; \
        _Pragma("unroll") for (int i = 0; i < 2; ++i) __builtin_amdgcn_global_load_lds((const unsigned*)(up_ + (lane + 64 * i) * 16), (LAS unsigned*)(ud_ + i * 1024), 16, 0, 0); } while (0)
#define GS_ST(slot_) do { LAS unsigned char* d_ = lds + (slot_) * SLOT + lane * 16; \
        _Pragma("unroll") for (int i = 0; i < 16; ++i) { *(LAS u32x4*)(d_ + OW + i * 1024) = R[i]; *(LAS u32x4*)(d_ + OK_ + i * 1024) = R[16 + i]; } } while (0)
#define GS_WAIT_PROG(need_) do { const unsigned nd_ = (unsigned)(need_); while (prog[0] < nd_) __builtin_amdgcn_s_sleep(1); asm volatile("" ::: "memory"); } while (0)
        GS_LD(j);
        for (int m = j; m <= 128; m += 4) {
            if (m >= 3) GS_WAIT_PROG(m - 2);
            asm volatile("s_waitcnt vmcnt(0)" ::: "memory");
            GS_ST(m % 3);
            asm volatile("s_waitcnt lgkmcnt(0)" ::: "memory");
            if (lane == 0) rdy[m & 7] = (unsigned)(m + 1);
            if (m + 4 <= 128) { if (m >= 2) GS_WAIT_PROG(m - 1);
                GS_LD(m + 4); }
        }
        asm volatile("s_waitcnt vmcnt(0) lgkmcnt(0)" ::: "memory");
#undef GS_LD
#undef GS_ST
#undef GS_WAIT_PROG
    } else if (w == 0) {
        const int vl = c, v = 16 * slice + vl;
        f32x4 Sacc[8];
#pragma unroll
        for (int kt = 0; kt < 8; ++kt) Sacc[kt] = (f32x4){0.f, 0.f, 0.f, 0.f};
        int slot = 0;
        for (int n = 0; n < 129; ++n) {
            const int item = item0 + 4 * n, r0 = b * LP + n * 64;
            while (rdy[n & 7] != (unsigned)(n + 1)) __builtin_amdgcn_s_sleep(1);
            asm volatile("" ::: "memory");
            LAS unsigned char* cur = lds + slot * SLOT;
            const float a = atab[n];
            bf16_t* sp = snt_ptr(proj, r0, h, v) + 8 * q;
            f32x4 u[4];
#pragma unroll
            for (int tt = 0; tt < 4; ++tt) u[tt] = (f32x4){0.f, 0.f, 0.f, 0.f};
#pragma unroll
            for (int ks = 0; ks < 4; ++ks) { const bf16x8 sb = pack8(Sacc[2 * ks], Sacc[2 * ks + 1]);
                *(bf16x8*)(sp + 32 * ks) = sb;
#pragma unroll
                for (int tt = 0; tt < 4; ++tt) { const bf16x8 aw = *(const LAS bf16x8*)(cur + OW + (16 * tt + c) * 256 + (((4 * ks + q) ^ c) << 4)); u[tt] = mfma16(aw, sb, u[tt]); } }
            bf16_t* up = G.U0T + (size_t)item * 8192 + v * 64 + 8 * q;
#pragma unroll
            for (int kt = 0; kt < 8; ++kt) Sacc[kt] = Sacc[kt] * a;
#pragma unroll
            for (int ts = 0; ts < 2; ++ts) { const u32x4 u0w = *(const LAS u32x4*)(lds + OU + (n % 6) * 2048 + vl * 128 + (32 * ts + 8 * q) * 2);
                f32x4 ua, ub_;
                ua[0] = bf_lo(u0w.x) - u[2 * ts][0]; ua[1] = bf_hi(u0w.x) - u[2 * ts][1]; ua[2] = bf_lo(u0w.y) - u[2 * ts][2]; ua[3] = bf_hi(u0w.y) - u[2 * ts][3];
                ub_[0] = bf_lo(u0w.z) - u[2 * ts + 1][0]; ub_[1] = bf_hi(u0w.z) - u[2 * ts + 1][1]; ub_[2] = bf_lo(u0w.w) - u[2 * ts + 1][2]; ub_[3] = bf_hi(u0w.w) - u[2 * ts + 1][3];
                const bf16x8 ub = pack8(ua, ub_);
                *(bf16x8*)(up + 32 * ts) = ub;
#pragma unroll
                for (int kt = 0; kt < 8; ++kt) { const bf16x8 ak = *(const LAS bf16x8*)(cur + OK_ + (16 * kt + c) * 128 + (((4 * ts + q) ^ (c & 7)) << 4)); Sacc[kt] = mfma16(ak, ub, Sacc[kt]); } }
            asm volatile("s_waitcnt lgkmcnt(0)" ::: "memory");
            if (lane == 0) prog[0] = (unsigned)(n + 1);
            slot = slot + 1; if (slot >= 3) slot -= 3;
            if (PROBE_PH >= 0 && blockIdx.x == 0 && tid == 0) { LAS unsigned long long* tsw_ = (LAS unsigned long long*)(lds + LDS_BYTES - 256); if (n == 63) tsw_[12] = __builtin_amdgcn_s_memrealtime(); if (n == 128) tsw_[13] = __builtin_amdgcn_s_memrealtime(); }
        }
    }
    __syncthreads();
}

struct GdnDRegs { u32x4 q0, q1, a0, sn[4], gzs[2]; bf16x8 au_[2]; };
__device__ __forceinline__ void gdn_phaseD_load(GdnDRegs& R, bf16_t* proj, const GdnBufs& G, int item, int tid) {
    const int w = tid >> 6, lane = tid & 63, c = lane & 15, q = lane >> 4;
    const int h = item & 3, bc = item >> 2, b = bc / 129, ch = bc % 129, r0 = b * LP + ch * 64, v = 16 * w + c;
    const u32x4* qp = (const u32x4*)(G.QT + (size_t)item * 8192); const u32x4* ap = (const u32x4*)(G.AT + (size_t)item * 4096);
    R.q0 = qp[tid]; R.q1 = qp[tid + 512]; R.a0 = ap[tid];
#pragma unroll
    for (int j = 0; j < 4; ++j) { const int p = tid + 512 * j; R.sn[j] = *(const u32x4*)(snt_ptr(proj, r0, h, p >> 4) + 8 * (p & 15)); }
#pragma unroll
    for (int j = 0; j < 2; ++j) { const int p = tid + 512 * j; R.gzs[j] = *(const u32x4*)(proj + (size_t)(r0 + (p >> 4)) * NPROJ + h * 128 + C_GZ + 8 * (p & 15)); }
    const bf16_t* up = G.U0T + (size_t)item * 8192 + v * 64 + 8 * q;
#pragma unroll
    for (int ss = 0; ss < 2; ++ss) R.au_[ss] = *(const bf16x8*)(up + 32 * ss);
}
__device__ __forceinline__ int gdn_d_next(int it, int stride) { it += stride; while (it < GD_NITEM && (it >> 2) % 129 == 0) it += stride; return it; }
__device__ __forceinline__ void gdn_phaseD_all(LAS unsigned char* lds, bf16_t* proj, const GdnBufs& G, const float* gn, int first, int stride, bf16_t* ob) {
    int tid_ = threadIdx.x; asm volatile("" : "+v"(tid_));
    const int tid = tid_, w = tid >> 6, lane = tid & 63, c = lane & 15, q = lane >> 4;
    constexpr int OQ = 0, OA = 17408, OP = 26624, OSN = 28672, OGZ = 63488;
    LAS float* part = (LAS float*)(lds + OP);
    const f32x4 gnv = *(const f32x4*)(gn + 16 * w + 4 * q);
#define PD_ITEM(R, item_, nxt_) do { \
        const int item = (item_), h = item & 3, bc = item >> 2, b = bc / 129, ch = bc % 129; \
        __syncthreads(); \
        *(LAS u32x4*)(lds + OQ + (tid >> 4) * RS_K + (tid & 15) * 16) = R.q0; *(LAS u32x4*)(lds + OQ + ((tid + 512) >> 4) * RS_K + (tid & 15) * 16) = R.q1; \
        *(LAS u32x4*)(lds + OA + (tid >> 3) * RS_T + (tid & 7) * 16) = R.a0; \
        _Pragma("unroll") for (int j = 0; j < 4; ++j) { const int p = tid + 512 * j; *(LAS u32x4*)(lds + OSN + (p >> 4) * RS_K + (p & 15) * 16) = R.sn[j]; } \
        _Pragma("unroll") for (int j = 0; j < 2; ++j) { const int p = tid + 512 * j; *(LAS u32x4*)(lds + OGZ + (p >> 4) * RS_K + (p & 15) * 16) = R.gzs[j]; } \
        bf16x8 as_[4], au_[2]; u32x2 gz[4]; \
        _Pragma("unroll") for (int ss = 0; ss < 2; ++ss) au_[ss] = R.au_[ss]; \
        if ((nxt_) < GD_NITEM) gdn_phaseD_load(R, proj, G, (nxt_), tid); \
        __syncthreads(); \
        _Pragma("unroll") for (int ks = 0; ks < 4; ++ks) as_[ks] = *(const LAS bf16x8*)(lds + OSN + (16 * w + c) * RS_K + (32 * ks + 8 * q) * 2); \
        _Pragma("unroll") for (int tt = 0; tt < 4; ++tt) gz[tt] = *(const LAS u32x2*)(lds + OGZ + (16 * tt + c) * RS_K + (16 * w + 4 * q) * 2); \
        f32x4 oacc[4]; \
        _Pragma("unroll") for (int tt = 0; tt < 4; ++tt) oacc[tt] = (f32x4){0.f, 0.f, 0.f, 0.f}; \
        _Pragma("unroll") for (int ks = 0; ks < 4; ++ks) \
            _Pragma("unroll") for (int tt = 0; tt < 4; ++tt) { const bf16x8 bq = *(const LAS bf16x8*)(lds + OQ + (16 * tt + c) * RS_K + (32 * ks + 8 * q) * 2); oacc[tt] = mfma16(as_[ks], bq, oacc[tt]); } \
        _Pragma("unroll") for (int ss = 0; ss < 2; ++ss) \
            _Pragma("unroll") for (int tt = 0; tt < 4; ++tt) { const bf16x8 bq = *(const LAS bf16x8*)(lds + OA + (16 * tt + c) * RS_T + (32 * ss + 8 * q) * 2); oacc[tt] = mfma16(au_[ss], bq, oacc[tt]); } \
        { float p_[4]; \
          _Pragma("unroll") for (int tt = 0; tt < 4; ++tt) p_[tt] = oacc[tt][0] * oacc[tt][0] + oacc[tt][1] * oacc[tt][1] + oacc[tt][2] * oacc[tt][2] + oacc[tt][3] * oacc[tt][3]; \
          _Pragma("unroll") for (int tt = 0; tt < 4; ++tt) p_[tt] += __shfl_xor(p_[tt], 16); \
          _Pragma("unroll") for (int tt = 0; tt < 4; ++tt) p_[tt] += __shfl_xor(p_[tt], 32); \
          if (q == 0) { _Pragma("unroll") for (int tt = 0; tt < 4; ++tt) part[w * 64 + 16 * tt + c] = p_[tt]; } } \
        __syncthreads(); \
        _Pragma("unroll") for (int tt = 0; tt < 4; ++tt) { float tot = 0.f; \
            _Pragma("unroll") for (int ww = 0; ww < 8; ++ww) tot += part[ww * 64 + 16 * tt + c]; \
            const float rstd = rsqrtf(tot * (1.0f / 128.0f) + EPS); \
            const u32x2 gw = gz[tt]; \
            u32x2 o; o.x = cvt_pk_bf16(oacc[tt][0] * rstd * gnv[0] * bf_lo(gw.x), oacc[tt][1] * rstd * gnv[1] * bf_hi(gw.x)); \
            o.y = cvt_pk_bf16(oacc[tt][2] * rstd * gnv[2] * bf_lo(gw.y), oacc[tt][3] * rstd * gnv[3] * bf_hi(gw.y)); \
            *(u32x2*)(ob + (size_t)(b * SEQ + (ch - 1) * 64 + 16 * tt + c) * 512 + h * 128 + 16 * w + 4 * q) = o; } \
    } while (0)
    int ita = gdn_d_next(first - stride, stride), itb = gdn_d_next(ita, stride);
    GdnDRegs RA, RB;
    if (ita < GD_NITEM) gdn_phaseD_load(RA, proj, G, ita, tid);
    if (itb < GD_NITEM) gdn_phaseD_load(RB, proj, G, itb, tid);
    while (ita < GD_NITEM) {
        const int itc = gdn_d_next(itb, stride);
        PD_ITEM(RA, ita, itc);
        if (itb >= GD_NITEM) break;
        const int itd = gdn_d_next(itc, stride);
        PD_ITEM(RB, itb, itd);
        ita = itc; itb = itd;
    }
#undef PD_ITEM
    __syncthreads();
}

constexpr int RW_ST = 1040, RW_OLG = 73 * RW_ST, RW_OCN = RW_OLG + 8 * 16 * 52 * 4;
__device__ __forceinline__ void p_router(LAS unsigned char* lds, const bf16_t* h1b, const float* g2, const float* rgw, const float* rgb, const float* rew, const float* reb, int* cnt, int* list, float* rs, int* asg) {
    LAS int* lcnt = (LAS int*)(lds + RW_OCN);
    LAS int* dec = lcnt + 64;
    const int tid = threadIdx.x, wv = tid >> 6, l = tid & 63, c = l & 15, q = l >> 4;
    const int rows_cap = (T + (int)gridDim.x - 1) / (int)gridDim.x;
    const int rbase = blockIdx.x * rows_cap; const int rend = (rbase + rows_cap <= T) ? rbase + rows_cap : T;
    LAS float* lg = (LAS float*)(lds + RW_OLG) + wv * 16 * 52;
    for (int p0 = rbase; p0 < rend; p0 += 128) {
        const int rows_per = (rend - p0) < 128 ? (rend - p0) : 128;
        __syncthreads();
        if (tid < 64) lcnt[tid] = 0;
        const bool valid = (wv * 16 + c) < rows_per;
        const int row = valid ? p0 + wv * 16 + c : p0;
        u32x4 xa[16][2];
#pragma unroll
        for (int j = 0; j < 16; ++j)
#pragma unroll
            for (int s_ = 0; s_ < 2; ++s_) xa[j][s_] = *(const u32x4*)(h1b + (size_t)row * D + 64 * j + 16 * q + 8 * s_);
        f32x4 acc[3], accS = (f32x4){0.f, 0.f, 0.f, 0.f};
#pragma unroll
        for (int ct = 0; ct < 3; ++ct) acc[ct] = (f32x4){0.f, 0.f, 0.f, 0.f};
        int rhi[3], rlo[3];
#pragma unroll
        for (int ct = 0; ct < 3; ++ct) { const int n = 16 * ct + c; rhi[ct] = (n < 36 ? n : 72) * RW_ST + 32 * q; rlo[ct] = (n < 36 ? 36 + n : 72) * RW_ST + 32 * q; }
#pragma unroll
        for (int half = 0; half < 2; ++half) {
            if (half) __syncthreads();
            const int k0 = 512 * half;
            for (int i = tid; i < 512; i += NTHR) { const int k = k0 + i; const f32x4 g = *(const f32x4*)(rgw + 4 * k); const float gg = g2[k];
#pragma unroll
                for (int n = 0; n < 4; ++n) { const float w = g[n] * gg; const bf16_t hi = f2bf(w); *(LAS bf16_t*)(lds + n * RW_ST + i * 2) = hi; *(LAS bf16_t*)(lds + (36 + n) * RW_ST + i * 2) = f2bf(w - bf2f(hi)); } }
            for (int i = tid; i < 512 * 8; i += NTHR) { const int kk = i >> 3, j = (i & 7) * 4; const f32x4 g = *(const f32x4*)(rew + (size_t)(k0 + kk) * 32 + j); const float gg = g2[k0 + kk];
#pragma unroll
                for (int n = 0; n < 4; ++n) { const float w = g[n] * gg; const bf16_t hi = f2bf(w); *(LAS bf16_t*)(lds + (4 + j + n) * RW_ST + kk * 2) = hi; *(LAS bf16_t*)(lds + (40 + j + n) * RW_ST + kk * 2) = f2bf(w - bf2f(hi)); } }
            if (tid < RW_ST / 16) *(LAS u32x4*)(lds + 72 * RW_ST + tid * 16) = (u32x4){0u, 0u, 0u, 0u};
            __syncthreads();
#pragma unroll
            for (int jj = 0; jj < 8; ++jj)
#pragma unroll
                for (int s_ = 0; s_ < 2; ++s_) { const bf16x8 a = __builtin_bit_cast(bf16x8, xa[8 * half + jj][s_]);
                    accS = mfma16(a, a, accS);
#pragma unroll
                    for (int ct = 0; ct < 3; ++ct) { const bf16x8 bh = *(const LAS bf16x8*)(lds + rhi[ct] + 128 * jj + 16 * s_); const bf16x8 bl = *(const LAS bf16x8*)(lds + rlo[ct] + 128 * jj + 16 * s_);
                        acc[ct] = mfma16(a, bh, acc[ct]); acc[ct] = mfma16(a, bl, acc[ct]); } }
        }
        const float sd = (c & 3) == 0 ? accS[0] : (c & 3) == 1 ? accS[1] : (c & 3) == 2 ? accS[2] : accS[3];
        const float ssq = __shfl(sd, c + 16 * (c >> 2));
        const float rstd = rsqrtf(ssq * (1.0f / D) + EPS);
#pragma unroll
        for (int ct = 0; ct < 3; ++ct)
#pragma unroll
            for (int i = 0; i < 4; ++i) lg[(4 * q + i) * 52 + 16 * ct + c] = acc[ct][i];
        asm volatile("s_waitcnt lgkmcnt(0)" ::: "memory");
        if (q == 0 && valid) {
            const LAS float* lr_ = lg + c * 52;
            float gl[4];
#pragma unroll
            for (int i = 0; i < 4; ++i) gl[i] = lr_[i] * rstd + rgb[i];
            int grp = 0; float gm = gl[0];
#pragma unroll
            for (int i = 1; i < 4; ++i) if (gl[i] > gm) { gm = gl[i]; grp = i; }
            float gs = 0.f;
#pragma unroll
            for (int i = 0; i < 4; ++i) gs += __expf(gl[i] - gm);
            const float pg = 1.0f / gs;
            float el[8];
#pragma unroll
            for (int j = 0; j < 8; ++j) el[j] = lr_[4 + grp * 8 + j] * rstd + reb[grp * 8 + j];
            int i1 = 0; float m1 = el[0];
#pragma unroll
            for (int j = 1; j < 8; ++j) if (el[j] > m1) { m1 = el[j]; i1 = j; }
            int i2 = (i1 == 0) ? 1 : 0; float m2 = -3.0e38f;
#pragma unroll
            for (int j = 0; j < 8; ++j) if (j != i1 && el[j] > m2) { m2 = el[j]; i2 = j; }
            const float p2 = __expf(m2 - m1);
            const float w1 = pg / (1.0f + p2), w2 = pg * p2 / (1.0f + p2);
            const int e1 = grp * 8 + i1, e2 = grp * 8 + i2;
            LAS int* dd = dec + (wv * 16 + c) * 8;
            dd[0] = e1; dd[1] = e2; dd[2] = atomicAdd((int*)(lcnt + e1), 1); dd[3] = atomicAdd((int*)(lcnt + e2), 1); dd[4] = __float_as_int(w1); dd[5] = __float_as_int(w2); dd[6] = __float_as_int(rstd);
        }
        __syncthreads();
        if (tid < NEXP) lcnt[32 + tid] = atomicAdd(&cnt[tid], lcnt[tid]);
        __syncthreads();
        for (int lr = tid; lr < rows_per; lr += NTHR) {
            const int row_ = p0 + lr; LAS int* dd = dec + lr * 8;
            const int e1 = dd[0], e2 = dd[1], pos1 = lcnt[32 + e1] + dd[2], pos2 = lcnt[32 + e2] + dd[3];
            list[e1 * ECAP + pos1] = row_; list[e2 * ECAP + pos2] = row_;
            rs[e1 * ECAP + pos1] = __int_as_float(dd[6]); rs[e2 * ECAP + pos2] = __int_as_float(dd[6]);
            int* a = asg + (size_t)row_ * 6;
            a[0] = e1; a[1] = pos1; a[2] = dd[4]; a[3] = e2; a[4] = pos2; a[5] = dd[5];
        }
    }
    __syncthreads();
}
__device__ __forceinline__ void p_final(LAS unsigned char* lds, const bf16_t* h1b, float* out, const bf16_t* Y, const int* cnt, const int* asg, const float* gf) {
    LAS int* offr = (LAS int*)lds;
    __syncthreads();
    if (threadIdx.x < NEXP) offr[64 + threadIdx.x] = cnt[threadIdx.x];
    __syncthreads();
    if (threadIdx.x == 0) { int s = 0; for (int e = 0; e < NEXP; ++e) { offr[e] = s * 256; s += (offr[64 + e] + 255) >> 8; } }
    __syncthreads();
    const int wv = threadIdx.x >> 6, l = threadIdx.x & 63;
    constexpr int NR = 4;
    const int rstep = (int)gridDim.x * 8;
    f32x4 gv[4];
#pragma unroll
    for (int i = 0; i < 4; ++i) gv[i] = ((const f32x4*)gf)[l + 64 * i];
    for (int row0 = blockIdx.x * 8 + wv; row0 < T; row0 += rstep * NR) {
        u32x2 ag[NR][3];
#pragma unroll
        for (int r = 0; r < NR; ++r) { const int row = (row0 + r * rstep < T) ? row0 + r * rstep : row0; const u32x2* a2 = (const u32x2*)(asg + (size_t)row * 6); ag[r][0] = a2[0]; ag[r][1] = a2[1]; ag[r][2] = a2[2]; }
        u32x2 hw[NR][4], y1[NR][4], y2[NR][4];
#pragma unroll
        for (int r = 0; r < NR; ++r) { const int row = (row0 + r * rstep < T) ? row0 + r * rstep : row0;
#pragma unroll
            for (int i = 0; i < 4; ++i) hw[r][i] = *(const u32x2*)(h1b + (size_t)row * D + 4 * (l + 64 * i)); }
#pragma unroll
        for (int r = 0; r < NR; ++r) { const int s1 = offr[ag[r][0].x] + (int)ag[r][0].y, s2 = offr[ag[r][1].y] + (int)ag[r][2].x;
#pragma unroll
            for (int i = 0; i < 4; ++i) { y1[r][i] = *(const u32x2*)(Y + (size_t)s1 * D + 4 * (l + 64 * i)); y2[r][i] = *(const u32x2*)(Y + (size_t)s2 * D + 4 * (l + 64 * i)); } }
#pragma unroll
        for (int r = 0; r < NR; ++r) { const int row = row0 + r * rstep; if (row >= T) break;
            const float w1 = __uint_as_float(ag[r][1].x), w2 = __uint_as_float(ag[r][2].y);
            f32x4 v[4]; float ss = 0.f;
#pragma unroll
            for (int i = 0; i < 4; ++i) {
                v[i][0] = bf_lo(hw[r][i].x) + w1 * bf_lo(y1[r][i].x) + w2 * bf_lo(y2[r][i].x); v[i][1] = bf_hi(hw[r][i].x) + w1 * bf_hi(y1[r][i].x) + w2 * bf_hi(y2[r][i].x);
                v[i][2] = bf_lo(hw[r][i].y) + w1 * bf_lo(y1[r][i].y) + w2 * bf_lo(y2[r][i].y); v[i][3] = bf_hi(hw[r][i].y) + w1 * bf_hi(y1[r][i].y) + w2 * bf_hi(y2[r][i].y);
                ss += v[i][0] * v[i][0] + v[i][1] * v[i][1] + v[i][2] * v[i][2] + v[i][3] * v[i][3]; }
            ss = wave_sum(ss);
            const float rstd = rsqrtf(ss * (1.0f / D) + EPS);
            f32x4* xr = (f32x4*)(out + (size_t)row * D);
#pragma unroll
            for (int i = 0; i < 4; ++i) xr[l + 64 * i] = v[i] * rstd * gv[i]; }
    }
}

__device__ __forceinline__ void run_dense(LAS unsigned char* lds, const char* A, unsigned lda2, int K, const char* Bt, int M, int N, int rowmap, int mode, void* o0, const void* i0, const float* aux) {
    SchedDense S; S.so.init(M, N, (int)gridDim.x, (int)blockIdx.x); S.A = A; S.lda2 = lda2; S.K = K; S.Bt = Bt; S.rowmap = rowmap;
    if (mode == 0) { EpiProj E{(bf16_t*)o0, (const float*)i0, aux}; pg8::gemm_phase<EpiProj, SchedDense>(lds, S, E); }
    else { EpiResid E{(const float*)i0, (bf16_t*)o0}; pg8::gemm_phase<EpiResid, SchedDense>(lds, S, E); }
}
__device__ __forceinline__ void run_moe(LAS unsigned char* lds, const char* A, unsigned lda2, int K, const char* Bt, size_t bstride, const int* cnt, const int* list, int mode, void* out, const float* rs) {
    LAS int* pref = (LAS int*)(lds + pg8::STAGE_BYTES);
    const bool setup = (mode == 0);
    if (setup) {
    __syncthreads();
    if (threadIdx.x < NEXP) pref[100 + threadIdx.x] = cnt[threadIdx.x];
    __syncthreads();
    if (threadIdx.x < 64) {
        const int e = threadIdx.x; const int n = e < NEXP ? pref[100 + e] : 0, nt_ = (n + 255) >> 8, rem = n & 255, hh = (rem != 0 && rem <= 128) ? 1 : 0;
        const int s = (int)wave_incl_scan((float)nt_) - nt_, sh = (int)wave_incl_scan((float)hh) - hh;
        if (e <= NEXP) { pref[e] = s; pref[33 + e] = s - sh; pref[66 + e] = sh; } }
    __syncthreads();
    }
    SchedMoe S; S.list = list; S.pref = pref; S.A = A; S.lda2 = lda2; S.K = K; S.Bt = Bt; S.bstride = bstride; S.gather = (mode == 0); S.G = (int)gridDim.x; S.c = ((gridDim.x & 7) == 0) ? (int)((blockIdx.x & 7) * (gridDim.x >> 3) + (blockIdx.x >> 3)) : (int)blockIdx.x;
    if (setup && threadIdx.x < 8) { pg8::Unit u{0, 0, 0, 0, 0}; const bool ok = S.compute((int)threadIdx.x, u); LAS int* q = pref + 136 + 8 * threadIdx.x; q[0] = ok ? 1 : 0; q[1] = u.pm; q[2] = u.pn; q[3] = u.e; q[4] = u.t; }
    __syncthreads();
    if (mode == 0) {
        for (int o = threadIdx.x; o < 8 * 256; o += NTHR) { const LAS int* q = pref + 136 + 8 * (o >> 8); int tok = 0; if (q[0]) { const int p = q[4] * 256 + (o & 255); if (p < pref[100 + q[3]]) tok = list[q[3] * ECAP + p]; } pref[256 + o] = tok; }
        __syncthreads(); }
    if (mode == 0) { EpiSwiglu E{(bf16_t*)out, rs}; pg8::gemm_phase<EpiSwiglu, SchedMoe>(lds, S, E); }
    else { EpiY E{(bf16_t*)out}; pg8::gemm_phase<EpiY, SchedMoe>(lds, S, E); }
}

__global__ void __launch_bounds__(NTHR, 2) mega(Args a) {
    extern __shared__ __attribute__((aligned(16))) unsigned char shm[];
    LAS unsigned char* lds = (LAS unsigned char*)shm;
    cg::grid_group grid = cg::this_grid();
    const float* x = a.in[0]; const float* meta = a.in[1]; const float* lbl = a.in[2]; const float* g1 = a.in[3];
    const float* w_in = a.in[4]; const float* convw = a.in[5]; const float* A_log = a.in[6]; const float* dt_bias = a.in[7];
    const float* hg_ng = a.in[8]; const float* gd_ng = a.in[9]; const float* hg_up = a.in[10]; const float* gd_up = a.in[11];
    const float* w_out = a.in[12]; const float* g2 = a.in[13]; const float* rgw = a.in[14]; const float* rgb = a.in[15];
    const float* rew = a.in[16]; const float* reb = a.in[17]; const float* w_gate = a.in[18]; const float* w_up = a.in[19];
    const float* w_down = a.in[20]; const float* gf = a.in[21];
    char* ws = a.ws; float* out = a.out;
    bf16_t* proj = (bf16_t*)(ws + OFF_PROJ); bf16_t* Win = (bf16_t*)(ws + OFF_WIN); bf16_t* Whg = (bf16_t*)(ws + OFF_WHG); bf16_t* Wgd = (bf16_t*)(ws + OFF_WGD); bf16_t* Wout = (bf16_t*)(ws + OFF_WOUT);
    float* gbf = (float*)(ws + OFF_GBF); float* lbt = (float*)(ws + OFF_MISC + MISC_LBT); int* cnt = (int*)(ws + OFF_MISC + MISC_CNT);
    bf16_t* tmp = (bf16_t*)(ws + OFF_TMP);
    bf16_t* xb = (bf16_t*)(ws + OFF_QKVN); float* rsx = (float*)(ws + OFF_RSX); float* mpb = (float*)(ws + OFF_MP);
    bf16_t* h1b = (bf16_t*)(ws + OFF_XN); float* rsl = (float*)(ws + OFF_RS); bf16_t* We1 = (bf16_t*)(ws + OFF_WE1); bf16_t* We2 = (bf16_t*)(ws + OFF_WE2); bf16_t* Hb = (bf16_t*)(ws + OFF_H); bf16_t* Yb = (bf16_t*)(ws + OFF_Y);
    int* list = (int*)(ws + OFF_LIST); int* asg = (int*)(ws + OFF_ASG);
    bf16_t* oab = (bf16_t*)((char*)a.out + DO_OA); bf16_t* obb = (bf16_t*)((char*)a.out + DO_OB); bf16_t* mgb = (bf16_t*)(ws + OFF_MG);
    float* arun = (float*)((char*)a.out + DO_ARUN); float* drun = arun + (size_t)256 * 16384;
    GdnBufs GB; GB.QT = (bf16_t*)(ws + OFF_QT); GB.AT = (bf16_t*)(ws + OFF_AT); GB.KHT = (bf16_t*)(ws + OFF_KHT); GB.GEND = (float*)(ws + OFF_GEND); GB.WP = (bf16_t*)((char*)a.out + DO_WP); GB.U0T = (bf16_t*)((char*)a.out + DO_U0T);
    const int lo = a.ph_lo, hi = a.ph_hi;
#define IN(k) (lo <= (k) && (k) < hi)
    LAS unsigned long long* tsw = (LAS unsigned long long*)(lds + LDS_BYTES - 256);
#define STAMP(k) do { if (PROBE_PH >= 0 && blockIdx.x == PROBE_BLK && threadIdx.x == 0) tsw[k] = __builtin_amdgcn_s_memrealtime(); } while (0)
    volatile LAS unsigned* xbst = (volatile LAS unsigned*)(lds + LDS_BYTES - 128);
    if (threadIdx.x == 0) { xbst[0] = 0u; xbst[1] = 0u; }
    __syncthreads();
    XcdBarrier xbar; xbar.bar = (unsigned*)(ws + OFF_BAR); xbar.x = 0u; xbar.st = xbst;
#define SEAM(k) do { if (IN(k) && IN((k) + 1)) { if ((k) == 0) grid.sync(); else xcd_barrier(xbar); } STAMP((k) + 1); } while (0)
    if (PROBE_PH >= 0 && threadIdx.x == 0) { tsw[14] = 0; tsw[15] = 0; }
    STAMP(0);
    if (IN(0)) {
        if (blockIdx.x == 0) {
            for (int i = threadIdx.x; i < XCD_BAR_WORDS; i += NTHR) ((unsigned*)(ws + OFF_BAR))[i] = 0u;
            const int i = threadIdx.x;
            { const float aa = lbl[i], bb = lbl[512 + i]; const float m = fmaxf(aa, bb); const float ea = __expf(aa - m), eb = __expf(bb - m); lbt[i] = ea / (ea + eb); }
            if (i < NEXP) cnt[i] = 0;
        }
        {
          const TrJob jw{w_in, nullptr, Win, 0, 1024, WIN_LD, NPROJ, 1, 0, 0, g1}, jh{hg_up, nullptr, Whg, 1, 512, 1024, 1024, 1, 0, 0, nullptr}, jg{gd_up, nullptr, Wgd, 1, 512, 1024, 1024, 1, 0, 0, nullptr}, jo{w_out, nullptr, Wout, 1, 1024, 1024, 1024, 1, 0, 0, nullptr};
          const int b_ = (int)blockIdx.x; const bool even = (gridDim.x == 256);
          int id0, id1, id2, id3;
          if (even) { if (b_ >= META_WG) { const int bb = b_ - META_WG, nw = 256 - META_WG; id0 = bb; id1 = bb + nw; id2 = bb + 2 * nw < 512 ? bb + 2 * nw : -1; id3 = bb + 3 * nw < 512 ? bb + 3 * nw : -1; } else { id0 = -1; id1 = -1; id2 = -1; id3 = -1; } }
          else { id0 = -1; id1 = -1; id2 = -1; id3 = -1; }
#define TR_LOAD_ID(v_, s_, id_) do { if ((id_) >= 0) { if ((id_) < 384) tr_load(v_, s_, jw, (id_)); else if ((id_) < 416) tr_load(v_, s_, jh, (id_) - 384); else if ((id_) < 448) tr_load(v_, s_, jg, (id_) - 416); else tr_load(v_, s_, jo, (id_) - 448); } } while (0)
#define TR_STORE_ID(v_, s_, id_) do { if ((id_) >= 0) { if ((id_) < 384) tr_store((LAS float*)lds, v_, s_, jw, (id_)); else if ((id_) < 416) tr_store((LAS float*)lds, v_, s_, jh, (id_) - 384); else if ((id_) < 448) tr_store((LAS float*)lds, v_, s_, jg, (id_) - 416); else tr_store((LAS float*)lds, v_, s_, jo, (id_) - 448); } } while (0)
          if (even && b_ < META_WG) p0_meta(lds, meta, g1, w_in, mpb);
          else if (even) {
              f32x4 t0[8], t1[8]; float s0[8], s1[8];
              TR_LOAD_ID(t0, s0, id0); TR_LOAD_ID(t1, s1, id1); TR_STORE_ID(t0, s0, id0); TR_LOAD_ID(t0, s0, id2); TR_STORE_ID(t1, s1, id1); TR_LOAD_ID(t1, s1, id3); TR_STORE_ID(t0, s0, id2); TR_STORE_ID(t1, s1, id3);
              __syncthreads(); }
          else p0_meta(lds, meta, g1, w_in, mpb);
          p0_zero(proj, gbf);
          if (!even) { run_tr(lds, jw, b_, (int)gridDim.x); run_tr(lds, jh, b_, (int)gridDim.x); run_tr(lds, jg, b_, (int)gridDim.x); run_tr(lds, jo, b_, (int)gridDim.x); }
#undef TR_LOAD_ID
#undef TR_STORE_ID
        }
        p0_prep_x(lds, x, g1, w_in, A_log, dt_bias, xb, gbf, rsx);
    }
    SEAM(0);
    xbar = xcd_barrier_post((unsigned*)(ws + OFF_BAR), xbst);
    if (IN(1)) run_dense(lds, (const char*)xb, D * 2, 1024, (const char*)Win, T, NPROJ, 0, 0, proj, lbt, rsx);
    if (IN(1)) meta_finalize((const float*)(ws + OFF_MP), lbl, A_log, dt_bias, proj, gbf);
    SEAM(1);
    if (IN(2)) {
        unsigned* q2 = (unsigned*)(ws + OFF_BAR) + 32;
        LAS int* qit = (LAS int*)(lds + LDS_BYTES - 64);
        unsigned tk = 0; if (threadIdx.x == 0) tk = atomicAdd(q2, 1u);
        for (int it = blockIdx.x; it < 256; it += gridDim.x) hgrn_run<false>(lds, proj, arun, drun, hg_ng, it, oab);
        for (int i = threadIdx.x; i < 6144 / 4; i += NTHR) *(LAS f32x4*)(lds + GB_CW + i * 16) = *(const f32x4*)(convw + 4 * i);
        if (threadIdx.x == 0) qit[0] = (int)tk;
        __syncthreads();
        int cur = qit[0];
        if (threadIdx.x == 0) tk = atomicAdd(q2, 1u);
        GdnBRegs R;
        if (cur < GD_NITEM) gdn_phaseB_load(R, proj, gbf, cur, threadIdx.x);
        while (cur < GD_NITEM) cur = gdn_phaseB(lds, proj, gbf, GB, cur, R, q2, tk);
    }
    SEAM(2);
    if (IN(3)) {
        unsigned* hq = (unsigned*)(ws + OFF_BAR);
        unsigned* scan_done = hq + 64;
        if (blockIdx.x < 128) { const int lab = blockIdx.x & 7, kk = blockIdx.x >> 3; gdn_scan(lds, proj, GB, (2 * lab + (kk >> 3)) * 8 + (kk & 7));
            asm volatile("s_waitcnt vmcnt(0)" ::: "memory");
            __syncthreads();
            if (threadIdx.x == 0) { __builtin_amdgcn_fence(__ATOMIC_RELEASE, "agent"); asm volatile("s_waitcnt vmcnt(0)" ::: "memory"); __hip_atomic_fetch_add(scan_done, 1u, __ATOMIC_RELAXED, __HIP_MEMORY_SCOPE_AGENT); } }
        {
          LAS int* qit = (LAS int*)(lds + LDS_BYTES - 64);
          bool acquired = false;
          for (;;) { __syncthreads(); if (threadIdx.x == 0) *qit = (int)atomicAdd(hq, 1u); __syncthreads(); const int it = *qit; if (it >= 512) break;
              if (it < 256) hgrn_run<true>(lds, proj, arun, drun, hg_ng, ((it & 15) * 16) + (it >> 4), oab);
              else {
                  if (!acquired) { if (threadIdx.x == 0) { while (__hip_atomic_load(scan_done, __ATOMIC_RELAXED, __HIP_MEMORY_SCOPE_AGENT) < 128u) __builtin_amdgcn_s_sleep(8);
                                       __builtin_amdgcn_fence(__ATOMIC_ACQUIRE, "agent"); asm volatile("s_waitcnt vmcnt(0)" ::: "memory"); }
                                   __syncthreads(); acquired = true; }
                  gdn_phaseD_all(lds, proj, GB, gd_ng, it - 256, 256, obb); } }
          if (PROBE_BLK != 0) STAMP(12); }
    }
    if (IN(3) && IN(4)) STAMP(4);
    SEAM(4);
    if (IN(5)) { SchedMerge S; S.so.init(T, 1024, (int)gridDim.x, (int)blockIdx.x); S.base = (const char*)a.out; S.offA = (unsigned)DO_OA; S.offB = (unsigned)DO_OB; S.K = 512; S.Whg = (const char*)Whg; S.Wgd = (const char*)Wgd;
        EpiMerge E{proj, mgb}; pg8::gemm_phase<EpiMerge, SchedMerge>(lds, S, E); }
    SEAM(5);
    if (IN(6)) run_dense(lds, (const char*)mgb, D * 2, 1024, (const char*)Wout, T, 1024, 0, 3, h1b, x, nullptr);
    SEAM(6);
    if (IN(7)) {
        const bool rfirst = ((blockIdx.x >> 3) & 1) != 0;
        if (rfirst) p_router(lds, h1b, g2, rgw, rgb, rew, reb, cnt, list, rsl, asg);
        { TrJob j{w_gate, w_up, We1, 2, 1024, 512, 1024, NEXP, (size_t)1024 * 512, (size_t)1024 * 1024, g2}; run_tr(lds, j, (int)blockIdx.x, (int)gridDim.x); }
        { TrJob j{w_down, nullptr, We2, 1, 512, 1024, 1024, NEXP, (size_t)512 * 1024, (size_t)1024 * 512}; run_tr(lds, j, (int)blockIdx.x, (int)gridDim.x); }
        if (!rfirst) p_router(lds, h1b, g2, rgw, rgb, rew, reb, cnt, list, rsl, asg);
    }
    SEAM(7);
    if (IN(8)) run_moe(lds, (const char*)h1b, D * 2, 1024, (const char*)We1, (size_t)1024 * 1024 * 2, cnt, list, 0, Hb, rsl);
    SEAM(8);
    if (IN(9)) run_moe(lds, (const char*)Hb, 512 * 2, 512, (const char*)We2, (size_t)1024 * 512 * 2, cnt, list, 1, Yb, nullptr);
    SEAM(9);
    if (IN(10)) p_final(lds, h1b, out, Yb, cnt, asg, gf);
    if (PROBE_PH >= 0) {
        __syncthreads();
        if (blockIdx.x == PROBE_BLK && threadIdx.x == 0) { const unsigned long long t1 = __builtin_amdgcn_s_memrealtime(); if (PROBE_PH == 10) tsw[11] = t1;
            const unsigned long long dt = (PROBE_PH == 14 ? tsw[14] : PROBE_PH == 15 ? tsw[15] : PROBE_PH == 13 ? (tsw[13] - tsw[12]) : PROBE_PH == 12 ? (tsw[12] - tsw[3]) : (tsw[PROBE_PH + 1] - tsw[PROBE_PH])) * PROBE_K; while (__builtin_amdgcn_s_memrealtime() - t1 < dt) __builtin_amdgcn_s_sleep(32); }
    }
#undef IN
#undef SEAM
}

#ifndef N_LAUNCH_SPLIT
#define N_LAUNCH_SPLIT 0
#endif
constexpr int NPHASE = 11;
extern "C" void kernel_launch(void* const* d_in, const int* in_sizes, int n_in, void* d_out, int out_size, void* d_ws, size_t ws_size, hipStream_t stream) {
    static int grid = 0;
    if (grid == 0) {
        if (n_in != 22 || in_sizes[0] != T * D || out_size != T * D || ws_size < WS_END) { fprintf(stderr, "kernel_launch: unexpected shapes (n_in %d in0 %d out %d ws %zu need %zu)\n", n_in, n_in > 0 ? in_sizes[0] : -1, out_size, ws_size, (size_t)WS_END); grid = -1; }
        else {
            int dev = 0, cus = 0, per_cu = 0;
            if (hipGetDevice(&dev) != hipSuccess || hipDeviceGetAttribute(&cus, hipDeviceAttributeMultiprocessorCount, dev) != hipSuccess) grid = -1;
            else if (hipFuncSetAttribute((const void*)mega, hipFuncAttributeMaxDynamicSharedMemorySize, LDS_BYTES) != hipSuccess) { fprintf(stderr, "kernel_launch: hipFuncSetAttribute failed\n"); grid = -1; }
            else if (hipOccupancyMaxActiveBlocksPerMultiprocessor(&per_cu, (const void*)mega, NTHR, LDS_BYTES) != hipSuccess || per_cu < 1) { fprintf(stderr, "kernel_launch: occupancy query says %d\n", per_cu); grid = -1; }
            else grid = cus;
            (void)hipGetLastError();
        }
    }
    if (grid < 0) return;
    Args a{};
    for (int i = 0; i < 22; ++i) a.in[i] = (const float*)d_in[i];
    a.out = (float*)d_out; a.ws = (char*)d_ws;
#if N_LAUNCH_SPLIT
    for (int p = 0; p < NPHASE; ++p) { a.ph_lo = p; a.ph_hi = p + 1; hipLaunchKernelGGL(mega, dim3(grid), dim3(NTHR), LDS_BYTES, stream, a); }
#else
    a.ph_lo = 0; a.ph_hi = NPHASE;
    void* args[] = {&a};
    hipError_t e = hipLaunchCooperativeKernel((const void*)mega, dim3(grid), dim3(NTHR), args, LDS_BYTES, stream);
    if (e != hipSuccess) fprintf(stderr, "cooperative launch failed: %s (grid %d)\n", hipGetErrorString(e), grid);
#endif
}
```
